# Optimizing an MI355X kernel written in HIP

```python
import jax, jax.numpy as jnp
from jax import lax
import numpy as np

D_MODEL = 1024
BATCH = 8
SEQ = 4096
DEPTH = 4

PLE_DIM = 256
D_FF = 2816
POOL_WINDOWS = (2, 4, 8, 16)
POOL_GROUP = D_MODEL // 8
POOL_WIDTH = len(POOL_WINDOWS) * POOL_GROUP
SGU_HEADS = 4
SGU_HEAD_DIM = D_MODEL // 8
SGU_WIDTH = SGU_HEADS * SGU_HEAD_DIM
CHUNK = 128
CONV_WIDTH = D_MODEL // 2
CONV_KERNEL = 31
N_BRANCH = 3
OFF_POOL = 0
OFF_U = OFF_POOL + POOL_WIDTH
OFF_V = OFF_U + SGU_WIDTH
OFF_GLU_A = OFF_V + SGU_WIDTH
OFF_GLU_B = OFF_GLU_A + CONV_WIDTH
OFF_GATES = OFF_GLU_B + CONV_WIDTH
IN_COLS = OFF_GATES + N_BRANCH * D_MODEL
EPS = 1e-6

kernel_name = "hybrid_pool_sgu_conformer_gated_trunk"


def rms_norm(x, g):
    xf = x.astype(jnp.float32)
    y = xf * lax.rsqrt(jnp.mean(xf * xf, axis=-1, keepdims=True) + EPS)
    return (y * g.astype(jnp.float32)).astype(x.dtype)


def layer_norm(x, g, b):
    xf = x.astype(jnp.float32)
    mu = jnp.mean(xf, axis=-1, keepdims=True)
    xc = xf - mu
    y = xc * lax.rsqrt(jnp.mean(xc * xc, axis=-1, keepdims=True) + EPS)
    return (y * g.astype(jnp.float32) + b.astype(jnp.float32)).astype(x.dtype)


def swiglu(x, w_gate, w_up, w_down):
    return (jax.nn.silu(x @ w_gate) * (x @ w_up)) @ w_down


def pool_mixer(xa, w_grp, scale):
    b_, s_, _ = xa.shape
    xf = xa.astype(jnp.float32).reshape(b_, s_, len(POOL_WINDOWS), POOL_GROUP)
    csum = jnp.cumsum(xf, axis=1)
    pos = jnp.arange(s_)
    outs = []
    for gi, w in enumerate(POOL_WINDOWS):
        cg = csum[:, :, gi]
        shifted = jnp.pad(cg, ((0, 0), (w, 0), (0, 0)))[:, :s_]
        count = jnp.minimum(pos + 1, w).astype(jnp.float32)[None, :, None]
        outs.append((cg - shifted) / count - xf[:, :, gi])
    pooled = jnp.stack(outs, axis=2).astype(xa.dtype)
    y = jnp.einsum('bsgi,gio->bsgo', pooled, w_grp)
    return y.reshape(b_, s_, POOL_WIDTH) * scale


def sgu_mixer(u, v, ln_g, ln_b, w_s, b_s):
    b_, s_, _ = u.shape
    u = jax.nn.gelu(u, approximate=False)
    v = layer_norm(jax.nn.gelu(v, approximate=False), ln_g, ln_b)
    vc = v.reshape(b_, s_ // CHUNK, CHUNK, SGU_HEADS, SGU_HEAD_DIM)
    causal = jnp.tril(jnp.ones((CHUNK, CHUNK), dtype=bool))
    w = jnp.where(causal[None], w_s, jnp.zeros_like(w_s))
    s = jnp.einsum('hts,bcshd->bcthd', w, vc) + b_s.T[None, None, :, :, None]
    return u * s.reshape(b_, s_, SGU_WIDTH)


def conv_mixer(a, gate, dw_k, dw_b, ln_g, ln_b):
    xg = a * jax.nn.sigmoid(gate)
    y = lax.conv_general_dilated(
        xg, dw_k, window_strides=(1,), padding=[(CONV_KERNEL - 1, 0)],
        dimension_numbers=('NWC', 'WIO', 'NWC'), feature_group_count=CONV_WIDTH) + dw_b
    return jax.nn.silu(layer_norm(y, ln_g, ln_b))


def setup_inputs(seed: int = 0) -> dict:
    key = jax.random.key(seed)
    ks = iter(jax.random.split(key, 40))
    L = DEPTH

    def w(shape, fan_in):
        return jax.random.normal(next(ks), shape, jnp.float32) * (fan_in ** -0.5)

    def gain(shape):
        return 1.0 + 0.05 * jax.random.normal(next(ks), shape, jnp.float32)

    def bias(shape):
        return 0.02 * jax.random.normal(next(ks), shape, jnp.float32)

    return {
        "x": jax.random.normal(next(ks), (BATCH, SEQ, D_MODEL), jnp.float32),
        "p": jax.random.normal(next(ks), (DEPTH, BATCH, SEQ, PLE_DIM), jnp.float32),
        "ffn1_pre_g": gain((L, D_MODEL)),
        "ffn1_w_gate": w((L, D_MODEL, D_FF), D_MODEL),
        "ffn1_w_up": w((L, D_MODEL, D_FF), D_MODEL),
        "ffn1_w_down": w((L, D_FF, D_MODEL), D_FF),
        "ffn1_post_g": gain((L, D_MODEL)),
        "mix_pre_g": gain((L, D_MODEL)),
        "w_in": w((L, D_MODEL, IN_COLS), D_MODEL),
        "pool_w": w((L, len(POOL_WINDOWS), POOL_GROUP, POOL_GROUP), POOL_GROUP),
        "pool_scale": gain((L, POOL_WIDTH)),
        "w_pool_out": w((L, POOL_WIDTH, D_MODEL), POOL_WIDTH),
        "sgu_ln_g": gain((L, SGU_WIDTH)),
        "sgu_ln_b": bias((L, SGU_WIDTH)),
        "sgu_w_s": w((L, SGU_HEADS, CHUNK, CHUNK), CHUNK),
        "sgu_b_s": 1.0 + 0.1 * jax.random.normal(next(ks), (L, SGU_HEADS, CHUNK), jnp.float32),
        "w_sgu_out": w((L, SGU_WIDTH, D_MODEL), SGU_WIDTH),
        "conv_dw_k": w((L, CONV_KERNEL, 1, CONV_WIDTH), CONV_KERNEL),
        "conv_dw_b": bias((L, CONV_WIDTH)),
        "conv_ln_g": gain((L, CONV_WIDTH)),
        "conv_ln_b": bias((L, CONV_WIDTH)),
        "w_conv_out": w((L, CONV_WIDTH, D_MODEL), CONV_WIDTH),
        "w_out": w((L, D_MODEL, D_MODEL), D_MODEL),
        "mix_post_g": gain((L, D_MODEL)),
        "ffn2_pre_g": gain((L, D_MODEL)),
        "ffn2_w_gate": w((L, D_MODEL, D_FF), D_MODEL),
        "ffn2_w_up": w((L, D_MODEL, D_FF), D_MODEL),
        "ffn2_w_down": w((L, D_FF, D_MODEL), D_FF),
        "ffn2_post_g": gain((L, D_MODEL)),
        "ple_w_proj": w((L, PLE_DIM, D_MODEL), PLE_DIM),
        "ple_pre_g": gain((L, D_MODEL)),
        "ple_w_gate": w((L, D_MODEL, D_MODEL), D_MODEL),
        "ple_post_g": gain((L, D_MODEL)),
    }


def reference(x, p, ffn1_pre_g, ffn1_w_gate, ffn1_w_up, ffn1_w_down, ffn1_post_g,
              mix_pre_g, w_in, pool_w, pool_scale, w_pool_out,
              sgu_ln_g, sgu_ln_b, sgu_w_s, sgu_b_s, w_sgu_out,
              conv_dw_k, conv_dw_b, conv_ln_g, conv_ln_b, w_conv_out,
              w_out, mix_post_g,
              ffn2_pre_g, ffn2_w_gate, ffn2_w_up, ffn2_w_down, ffn2_post_g,
              ple_w_proj, ple_pre_g, ple_w_gate, ple_post_g):
    h = x
    b_, s_, _ = x.shape
    for i in range(DEPTH):
        f = swiglu(rms_norm(h, ffn1_pre_g[i]), ffn1_w_gate[i], ffn1_w_up[i], ffn1_w_down[i])
        h = h + 0.5 * rms_norm(f, ffn1_post_g[i])

        n = rms_norm(h, mix_pre_g[i])
        z = n @ w_in[i]
        z_pool = z[..., OFF_POOL:OFF_U]
        z_u = z[..., OFF_U:OFF_V]
        z_v = z[..., OFF_V:OFF_GLU_A]
        z_a = z[..., OFF_GLU_A:OFF_GLU_B]
        z_b = z[..., OFF_GLU_B:OFF_GATES]
        gates = jax.nn.sigmoid(z[..., OFF_GATES:]).reshape(b_, s_, N_BRANCH, D_MODEL)

        y_pool = pool_mixer(z_pool, pool_w[i], pool_scale[i]) @ w_pool_out[i]
        y_sgu = sgu_mixer(z_u, z_v, sgu_ln_g[i], sgu_ln_b[i], sgu_w_s[i], sgu_b_s[i]) @ w_sgu_out[i]
        y_conv = conv_mixer(z_a, z_b, conv_dw_k[i], conv_dw_b[i],
                            conv_ln_g[i], conv_ln_b[i]) @ w_conv_out[i]
        merged = gates[:, :, 0] * y_pool + gates[:, :, 1] * y_sgu + gates[:, :, 2] * y_conv
        h = h + rms_norm(merged @ w_out[i], mix_post_g[i])

        f = swiglu(rms_norm(h, ffn2_pre_g[i]), ffn2_w_gate[i], ffn2_w_up[i], ffn2_w_down[i])
        h = h + 0.5 * rms_norm(f, ffn2_post_g[i])

        e = p[i] @ ple_w_proj[i]
        g = jax.nn.sigmoid(rms_norm(h, ple_pre_g[i]) @ ple_w_gate[i])
        h = h + rms_norm(g * e, ple_post_g[i])
    return h
```

```cpp
#include <hip/hip_runtime.h>
#include <hip/hip_cooperative_groups.h>
#include <cstdio>
namespace cg = cooperative_groups;

#ifndef PHASE_MASK
#define PHASE_MASK 0xffffu
#endif
#ifndef PROBE_DUP
#define PROBE_DUP 0
#endif
#ifndef MULTI_LAUNCH
#define MULTI_LAUNCH 0
#endif

#define LAS __attribute__((address_space(3)))
typedef unsigned short bf16_t;
typedef short bf16x8 __attribute__((ext_vector_type(8)));
typedef float f32x4 __attribute__((ext_vector_type(4)));
typedef float f32x2 __attribute__((ext_vector_type(2)));
typedef unsigned u32x4 __attribute__((ext_vector_type(4)));
typedef unsigned u32x2 __attribute__((ext_vector_type(2)));

constexpr int MTOK = 32768, DM = 1024, DFF = 2816, SEQ = 4096, NLAYER = 4, PLE = 256;
constexpr int NGU = 2 * DFF;
constexpr int NIN = 5632;
constexpr float EPS = 1e-6f;
constexpr int LDS_BYTES = 147456;
constexpr int NPHASE = 1 + 13 * NLAYER;

constexpr size_t WS_WGU1 = 0;
constexpr size_t WS_WD1 = WS_WGU1 + (size_t)NGU * DM * 2;
constexpr size_t WS_WGU2 = WS_WD1 + (size_t)DM * DFF * 2;
constexpr size_t WS_WD2 = WS_WGU2 + (size_t)NGU * DM * 2;
constexpr size_t WS_WIN = WS_WD2 + (size_t)DM * DFF * 2;
constexpr size_t WS_WBR = WS_WIN + (size_t)NIN * DM * 2;
constexpr size_t WS_WOUT = WS_WBR + (size_t)3 * DM * 512 * 2;
constexpr size_t WS_WPG = WS_WOUT + (size_t)DM * DM * 2;
constexpr size_t WS_WPP = WS_WPG + (size_t)DM * DM * 2;
constexpr size_t WS_WSPK = WS_WPP + (size_t)DM * PLE * 2;
constexpr size_t WS_HN = WS_WSPK + (size_t)4 * 128 * 128 * 2;
constexpr size_t WS_F = WS_HN + (size_t)MTOK * DM * 2;
constexpr size_t WS_BIG = WS_F + (size_t)MTOK * DM * 2;
constexpr size_t BIG_ACT = 0;
constexpr size_t BIG_ZP = 0, BIG_U = (size_t)MTOK * 512 * 2, BIG_V = 2 * BIG_U, BIG_XG = 3 * BIG_U;
constexpr size_t BIG_GATES = 4 * BIG_U;
constexpr size_t BIG_X3 = BIG_GATES + (size_t)MTOK * 3072 * 2;
constexpr size_t BIG_MERGED = 0;
constexpr size_t BIG_E = (size_t)192 * 1024 * 1024;
constexpr size_t BIG_PB = BIG_X3;
constexpr size_t WS_BAR = WS_BIG + BIG_X3 + (size_t)3 * MTOK * 512 * 2;
constexpr size_t WS_F2 = WS_BAR + 16384;
constexpr size_t WS_END = WS_F2 + (size_t)MTOK * DM * 2;

#define GAS __attribute__((address_space(1)))
struct Params { const GAS float* in[33]; GAS float* out; GAS unsigned char* ws; int ph_lo, ph_hi; };
#define PIN(i) ((const float*)P.in[i])

typedef __bf16 bf16x2_t __attribute__((ext_vector_type(2)));
__device__ __forceinline__ unsigned cvt_pk_bf16(float lo, float hi) { const f32x2 v = {lo, hi}; return __builtin_bit_cast(unsigned, __builtin_convertvector(v, bf16x2_t)); }
__device__ __forceinline__ float bf_lo(unsigned w) { return __uint_as_float(w << 16); }
__device__ __forceinline__ float bf_hi(unsigned w) { return __uint_as_float(w & 0xffff0000u); }
__device__ __forceinline__ float sigmoid_f(float x) { return __builtin_amdgcn_rcpf(1.0f + __builtin_amdgcn_exp2f(-1.44269504f * x)); }
__device__ __forceinline__ float wave_sum(float v) {
#pragma unroll
    for (int o = 32; o >= 1; o >>= 1) v += __shfl_xor(v, o);
    return v;
}
__device__ __forceinline__ f32x2 gelu_pk(f32x2 v) {
    const f32x2 av = __builtin_elementwise_abs(v), d = av * 0.2316418882f + 1.0f;
    f32x2 t; t.x = __builtin_amdgcn_rcpf(d.x); t.y = __builtin_amdgcn_rcpf(d.y);
    f32x2 q = t * 0.5307027145f + (-0.7265760135f); q = q * t + 0.7107068705f; q = q * t + (-0.142248368f); q = q * t + 0.127414796f; q = q * t;
    const f32x2 s = (v * v) * (-0.72134752044f);
    f32x2 e; e.x = __builtin_amdgcn_exp2f(s.x); e.y = __builtin_amdgcn_exp2f(s.y);
    const f32x2 m = v * (q * e), r = v - m;
    f32x2 o; o.x = v.x < 0.f ? m.x : r.x; o.y = v.y < 0.f ? m.y : r.y; return o;
}
__device__ __forceinline__ f32x4 gelu4(f32x4 v) { f32x2 a = gelu_pk((f32x2){v[0], v[1]}), b = gelu_pk((f32x2){v[2], v[3]}); return (f32x4){a.x, a.y, b.x, b.y}; }
__device__ __forceinline__ f32x4 sigmoid4(f32x4 v) { return (f32x4){sigmoid_f(v[0]), sigmoid_f(v[1]), sigmoid_f(v[2]), sigmoid_f(v[3])}; }
__device__ __forceinline__ u32x4 pack8(f32x4 a, f32x4 b) { u32x4 w; w.x = cvt_pk_bf16(a[0], a[1]); w.y = cvt_pk_bf16(a[2], a[3]); w.z = cvt_pk_bf16(b[0], b[1]); w.w = cvt_pk_bf16(b[2], b[3]); return w; }
__device__ __forceinline__ f32x4 unpack_lo4(u32x4 w) { return (f32x4){bf_lo(w.x), bf_hi(w.x), bf_lo(w.y), bf_hi(w.y)}; }
__device__ __forceinline__ f32x4 unpack_hi4(u32x4 w) { return (f32x4){bf_lo(w.z), bf_hi(w.z), bf_lo(w.w), bf_hi(w.w)}; }

namespace pg8 {
constexpr int BM = 256, BK = 64, HALF = 128, HTB = HALF * BK * 2, STAGE_BYTES = 8 * HTB, NXCD = 8, WGM = 8;
__device__ __forceinline__ int lds_byte(int r, int c) { const int st = (r >> 4) * 2 + (c >> 5), rr = r & 15, cc = c & 31, ob = rr * 64 + cc * 2; return st * 1024 + (ob ^ (((ob >> 9) & 1) << 5)); }
__device__ __forceinline__ void stage_rc(int b, int& R, int& C) { const int st = b / 1024, sb = b % 1024, swz = sb ^ (((sb >> 9) & 1) << 5); R = (st >> 1) * 16 + swz / 64; C = (st & 1) * 32 + (swz % 64) / 2; }
__device__ __forceinline__ int perm32(int rho) { const int n = rho >> 4, i = rho & 15; return 8 * (i >> 2) + 4 * n + (i & 3); }

struct Unit { int pm, pn; };
struct Gemm { const bf16_t* A; const bf16_t* Bt; int M, N, K; };

struct Order {
    int nM, nN, nwg, G, c, zn;
    __device__ void init(int M, int N, int G_, int c_, int zn_) { nM = M / BM; nN = N / BM; nwg = nM * nN; G = G_; c = c_; zn = zn_; }
    __device__ bool next(int i, Unit& u) const {
        const int ti = i / zn, z = i - ti * zn;
        const long L = (long)ti * G + c; if (L >= nwg) return false;
        int wgid = (int)L; { const int q = nwg / NXCD, r = nwg % NXCD, xcd = wgid % NXCD, off = wgid / NXCD; wgid = (xcd < r ? xcd * (q + 1) : r * (q + 1) + (xcd - r) * q) + off; }
        const int nig = WGM * nN, gid = wgid / nig, fm = gid * WGM, gsz = (nM - fm) < WGM ? (nM - fm) : WGM;
        u.pm = z * nM + fm + ((wgid % nig) % gsz); u.pn = z * nN + (wgid % nig) / gsz; return true;
    }
};

template <class Epi>
__device__ __forceinline__ void gemm_phase(LAS unsigned char* lds, const Gemm g, const Order& S, const Epi& E, const int tid) {
    const int wid = __builtin_amdgcn_readfirstlane(tid >> 6), lane = tid & 63, wr = wid >> 2, wc = wid & 3, fr = lane & 15, fq = lane >> 4;
    const int K = g.K, nt = K / BK;
    unsigned voffA[2], voffB[2];
#pragma unroll
    for (int i = 0; i < 2; ++i) { int R, C; stage_rc(tid * 16 + i * 8192, R, C); const int Rb = (R & ~31) + perm32(R & 31);
        voffA[i] = (unsigned)(R * K + C) * 2u; voffB[i] = (unsigned)(Rb * K + C) * 2u; }
    const size_t kstep = (size_t)(BK * 2);
    const size_t hstep = (size_t)HALF * K * 2;
    const size_t tstep = 2 * hstep;
    const unsigned ldsw = (unsigned)wid * 1024u;
    const int aoff = lds_byte(wr * 64 + fr, fq * 8), boff = lds_byte(wc * 32 + fr, fq * 8);
#define PG8_SA(b, h) (((b) * 2 + (h)) * HTB)
#define PG8_SB(b, h) ((4 + (b) * 2 + (h)) * HTB)
#define PG8_STAGE(bufoff, gbase, voff) do { _Pragma("unroll") for (int _i = 0; _i < 2; ++_i) \
        __builtin_amdgcn_global_load_lds((const unsigned*)((const char*)(gbase) + (voff)[_i]), (LAS unsigned*)(lds + (bufoff) + ldsw + _i * 8192), 16, 0, 0); } while (0)
#define PG8_LDA(dst, b, h) do { _Pragma("unroll") for (int m = 0; m < 4; ++m) _Pragma("unroll") for (int k = 0; k < 2; ++k) dst[m][k] = *(const LAS bf16x8*)(lds + PG8_SA(b, h) + aoff + m * 2048 + k * 1024); } while (0)
#define PG8_LDB(dst, b, h) do { _Pragma("unroll") for (int n = 0; n < 2; ++n) _Pragma("unroll") for (int k = 0; k < 2; ++k) dst[n][k] = *(const LAS bf16x8*)(lds + PG8_SB(b, h) + boff + n * 2048 + k * 1024); } while (0)
#define PG8_MMA(ai, bj, At, Bt) do { __builtin_amdgcn_s_setprio(1); _Pragma("unroll") for (int m = 0; m < 4; ++m) _Pragma("unroll") for (int n = 0; n < 2; ++n) _Pragma("unroll") for (int k = 0; k < 2; ++k) \
        acc[ai][bj][m][n] = __builtin_amdgcn_mfma_f32_16x16x32_bf16(Bt[n][k], At[m][k], acc[ai][bj][m][n], 0, 0, 0); __builtin_amdgcn_s_setprio(0); } while (0)
#define PG8_WAIT_V(n) asm volatile("s_waitcnt vmcnt(" #n ")" ::: "memory")
#define PG8_WAIT_L(n) asm volatile("s_waitcnt lgkmcnt(" #n ")" ::: "memory")
#define PG8_BAR __builtin_amdgcn_s_barrier()
#define PG8_SCHED __builtin_amdgcn_sched_barrier(0)
    Unit cur, nxt; int ui = 0;
    if (!S.next(0, cur)) return;
    f32x4 acc[2][2][4][2];
#pragma unroll
    for (int a = 0; a < 2; ++a)
#pragma unroll
        for (int b = 0; b < 2; ++b)
#pragma unroll
            for (int m = 0; m < 4; ++m)
#pragma unroll
                for (int n = 0; n < 2; ++n) acc[a][b][m][n] = (f32x4){0.f, 0.f, 0.f, 0.f};
    bf16x8 At[4][2], B0[2][2], B1[2][2];
    const char* cA = (const char*)g.A + (size_t)cur.pm * tstep; const char* cB = (const char*)g.Bt + (size_t)cur.pn * tstep;
    PG8_STAGE(PG8_SB(0, 0), cB, voffB); PG8_STAGE(PG8_SA(0, 0), cA, voffA); PG8_STAGE(PG8_SB(0, 1), cB + hstep, voffB); PG8_STAGE(PG8_SA(0, 1), cA + hstep, voffA);
    if (wr == 1) PG8_BAR;
    PG8_WAIT_V(4); PG8_BAR;
    PG8_STAGE(PG8_SB(1, 0), cB + kstep, voffB); PG8_STAGE(PG8_SA(1, 0), cA + kstep, voffA); PG8_STAGE(PG8_SB(1, 1), cB + hstep + kstep, voffB);
    PG8_WAIT_V(6); PG8_BAR;
    for (;;) {
        const bool has_next = S.next(ui + 1, nxt);
        const char* nA = has_next ? (const char*)g.A + (size_t)nxt.pm * tstep : cA; const char* nB = has_next ? (const char*)g.Bt + (size_t)nxt.pn * tstep : cB;
        for (int t = 0; t < nt; t += 2) {
            const bool last = (t == nt - 2);
            const char* a1 = cA + (size_t)(t + 1) * kstep;
            const char* a2 = last ? nA : cA + (size_t)(t + 2) * kstep; const char* b2 = last ? nB : cB + (size_t)(t + 2) * kstep;
            const char* a3 = a2 + kstep; const char* b3 = b2 + kstep;
            PG8_LDB(B0, 0, 0); PG8_SCHED; PG8_LDA(At, 0, 0); PG8_STAGE(PG8_SA(1, 1), a1 + hstep, voffA);
            PG8_WAIT_L(8); PG8_BAR; PG8_WAIT_L(0); PG8_MMA(0, 0, At, B0); PG8_BAR; PG8_SCHED;
            PG8_LDB(B1, 0, 1); PG8_STAGE(PG8_SB(0, 0), b2, voffB);
            PG8_BAR; PG8_WAIT_L(0); PG8_MMA(0, 1, At, B1); PG8_BAR;
            PG8_LDA(At, 0, 1); PG8_STAGE(PG8_SA(0, 0), a2, voffA);
            PG8_BAR; PG8_WAIT_L(0); PG8_MMA(1, 0, At, B0); PG8_BAR; PG8_SCHED;
            PG8_STAGE(PG8_SB(0, 1), b2 + hstep, voffB);
            PG8_WAIT_V(6); PG8_BAR; PG8_MMA(1, 1, At, B1); PG8_BAR;
            PG8_LDB(B0, 1, 0); PG8_SCHED; PG8_LDA(At, 1, 0); PG8_STAGE(PG8_SA(0, 1), a2 + hstep, voffA);
            PG8_WAIT_L(8); PG8_BAR; PG8_WAIT_L(0); PG8_MMA(0, 0, At, B0); PG8_BAR; PG8_SCHED;
            PG8_LDB(B1, 1, 1); PG8_STAGE(PG8_SB(1, 0), b3, voffB);
            PG8_BAR; PG8_WAIT_L(0); PG8_MMA(0, 1, At, B1); PG8_BAR;
            PG8_LDA(At, 1, 1); PG8_STAGE(PG8_SA(1, 0), a3, voffA);
            PG8_BAR; PG8_WAIT_L(0); PG8_MMA(1, 0, At, B0); PG8_BAR; PG8_SCHED;
            PG8_STAGE(PG8_SB(1, 1), b3 + hstep, voffB);
            PG8_WAIT_V(6); PG8_BAR; PG8_MMA(1, 1, At, B1); PG8_BAR;
        }
        bool zero_acc = true;
        if constexpr (Epi::CHAIN) zero_acc = E.chain(acc, cur, wr, wc, fr, fq);
        else E(acc, cur, wr, wc, fr, fq);
        if (!has_next) break;
        if (zero_acc)
#pragma unroll
        for (int a = 0; a < 2; ++a)
#pragma unroll
            for (int b = 0; b < 2; ++b)
#pragma unroll
                for (int m = 0; m < 4; ++m)
#pragma unroll
                    for (int n = 0; n < 2; ++n) acc[a][b][m][n] = (f32x4){0.f, 0.f, 0.f, 0.f};
        cur = nxt; cA = nA; cB = nB; ++ui;
    }
    PG8_WAIT_V(0);
    if (wr == 0) PG8_BAR;
    PG8_BAR;
#undef PG8_SA
#undef PG8_SB
#undef PG8_STAGE
#undef PG8_LDA
#undef PG8_LDB
#undef PG8_MMA
#undef PG8_WAIT_V
#undef PG8_WAIT_L
#undef PG8_BAR
#undef PG8_SCHED
}

typedef f32x4 Acc[2][2][4][2];
template <int ACT, int LDC> __device__ __forceinline__ void glu_store(const Acc& acc, char* ub, unsigned lane_off) {
#pragma unroll
    for (int ai = 0; ai < 2; ++ai)
#pragma unroll
        for (int m = 0; m < 4; ++m) {
            char* rp = ub + (size_t)(ai * HALF + m * 16) * LDC * 2;
            f32x4 v[2];
#pragma unroll
            for (int n = 0; n < 2; ++n) { const f32x4 a = acc[ai][0][m][n], b = acc[ai][1][m][n];
                if (ACT == 0) v[n] = a * sigmoid4(a) * b; else v[n] = a * sigmoid4(b); }
            *(u32x4*)(rp + lane_off) = pack8(v[0], v[1]);
        }
}
template <int LDC> __device__ __forceinline__ unsigned lane_off_of(int wr, int wc, int fr, int fq) { return (unsigned)((wr * 64 + fr) * LDC + wc * 32 + 8 * fq) * 2u; }
struct EpiGLU {
    static constexpr bool CHAIN = false;
    bf16_t* O;
    __device__ __forceinline__ void operator()(const Acc& acc, const Unit& u, int wr, int wc, int fr, int fq) const {
        glu_store<0, DFF>(acc, (char*)O + ((size_t)u.pm * BM * DFF + (size_t)u.pn * 128) * 2, lane_off_of<DFF>(wr, wc, fr, fq));
    }
};
template <int ACT, int LDC> __device__ __forceinline__ void plain_store(const Acc& acc, char* ub, unsigned lane_off) {
#pragma unroll
    for (int ai = 0; ai < 2; ++ai)
#pragma unroll
        for (int m = 0; m < 4; ++m) {
            char* rp = ub + (size_t)(ai * HALF + m * 16) * LDC * 2;
#pragma unroll
            for (int bj = 0; bj < 2; ++bj) { f32x4 v0 = acc[ai][bj][m][0], v1 = acc[ai][bj][m][1];
                if (ACT == 1) { v0 = gelu4(v0); v1 = gelu4(v1); }
                if (ACT == 2) { v0 = sigmoid4(v0); v1 = sigmoid4(v1); }
                *(u32x4*)(rp + bj * HALF * 2 + lane_off) = pack8(v0, v1); }
        }
}
struct EpiStore {
    static constexpr bool CHAIN = false;
    bf16_t* O;
    __device__ __forceinline__ void operator()(const Acc& acc, const Unit& u, int wr, int wc, int fr, int fq) const {
        plain_store<0, DM>(acc, (char*)O + ((size_t)u.pm * BM * DM + (size_t)u.pn * BM) * 2, lane_off_of<DM>(wr, wc, fr, fq));
    }
};
struct EpiIn {
    static constexpr bool CHAIN = false;
    bf16_t *ZP, *U, *V, *XG, *GATES;
    __device__ __forceinline__ void operator()(const Acc& acc, const Unit& u, int wr, int wc, int fr, int fq) const {
        const int pn = u.pn; const size_t rb = (size_t)u.pm * BM;
        if (pn >= 10) {
            char* ub = (char*)GATES + rb * 3072 + (size_t)(pn - 10) * 256; const unsigned lo = (unsigned)((wr * 64 + fr) * 3072 + wc * 32 + 8 * fq);
#pragma unroll
            for (int ai = 0; ai < 2; ++ai)
#pragma unroll
                for (int m = 0; m < 4; ++m)
#pragma unroll
                    for (int bj = 0; bj < 2; ++bj) {
                        const f32x4 v0 = sigmoid4(acc[ai][bj][m][0]) * 255.0f, v1 = sigmoid4(acc[ai][bj][m][1]) * 255.0f;
                        u32x2 w; w.x = 0u; w.y = 0u;
                        w.x = __builtin_amdgcn_cvt_pk_u8_f32(v0[0], 0, w.x); w.x = __builtin_amdgcn_cvt_pk_u8_f32(v0[1], 1, w.x); w.x = __builtin_amdgcn_cvt_pk_u8_f32(v0[2], 2, w.x); w.x = __builtin_amdgcn_cvt_pk_u8_f32(v0[3], 3, w.x);
                        w.y = __builtin_amdgcn_cvt_pk_u8_f32(v1[0], 0, w.y); w.y = __builtin_amdgcn_cvt_pk_u8_f32(v1[1], 1, w.y); w.y = __builtin_amdgcn_cvt_pk_u8_f32(v1[2], 2, w.y); w.y = __builtin_amdgcn_cvt_pk_u8_f32(v1[3], 3, w.y);
                        *(u32x2*)(ub + (size_t)(ai * HALF + m * 16) * 3072 + bj * HALF + lo) = w;
                    }
        }
        else {
            const unsigned lo = lane_off_of<512>(wr, wc, fr, fq);
            if (pn >= 6) glu_store<1, 512>(acc, (char*)XG + (rb * 512 + (size_t)(pn - 6) * 128) * 2, lo);
            else if (pn < 2) plain_store<0, 512>(acc, (char*)ZP + (rb * 512 + (size_t)pn * 256) * 2, lo);
            else { char* ub = (char*)(pn < 4 ? U : V) + (rb * 512 + (size_t)(pn & 1) * 256) * 2; plain_store<1, 512>(acc, ub, lo); }
        }
    }
};
struct EpiBranch {
    static constexpr bool CHAIN = true;
    const unsigned char* GATES; bf16_t* MG;
    static __device__ __forceinline__ f32x4 code4(unsigned w) { return (f32x4){__builtin_fmaxf((float)(w & 255u), 0.25f), __builtin_fmaxf((float)((w >> 8) & 255u), 0.25f), __builtin_fmaxf((float)((w >> 16) & 255u), 0.25f), __builtin_fmaxf((float)(w >> 24), 0.25f)}; }
    static __device__ __forceinline__ f32x4 rcp4(f32x4 v) { return (f32x4){__builtin_amdgcn_rcpf(v[0]), __builtin_amdgcn_rcpf(v[1]), __builtin_amdgcn_rcpf(v[2]), __builtin_amdgcn_rcpf(v[3])}; }
    __device__ __forceinline__ bool chain(Acc& acc, const Unit& u, int wr, int wc, int fr, int fq) const {
        const int z = u.pn >> 2, pn = u.pn & 3, pm = u.pm - z * 128;
        const bool fin = (z == 2);
        const char* gb = (const char*)GATES + (size_t)pm * BM * 3072 + (size_t)z * 1024 + (size_t)pn * BM;
        const char* gn = fin ? gb : gb + 1024;
        const unsigned glo = (unsigned)((wr * 64 + fr) * 3072 + wc * 32 + 8 * fq);
        char* mb = (char*)MG + ((size_t)pm * BM * DM + (size_t)pn * BM) * 2;
        const unsigned mlo = lane_off_of<DM>(wr, wc, fr, fq);
        constexpr float q = 1.0f / 255.0f;
#pragma unroll
        for (int ai = 0; ai < 2; ++ai) {
            u32x2 g0[4][2], g1[4][2];
#pragma unroll
            for (int m = 0; m < 4; ++m)
#pragma unroll
                for (int bj = 0; bj < 2; ++bj) {
                    g0[m][bj] = *(const u32x2*)(gb + (size_t)(ai * HALF + m * 16) * 3072 + bj * HALF + glo);
                    g1[m][bj] = *(const u32x2*)(gn + (size_t)(ai * HALF + m * 16) * 3072 + bj * HALF + glo);
                }
#pragma unroll
            for (int m = 0; m < 4; ++m)
#pragma unroll
                for (int bj = 0; bj < 2; ++bj) {
                    const f32x4 d0 = rcp4(code4(g1[m][bj].x)), d1 = rcp4(code4(g1[m][bj].y));
                    acc[ai][bj][m][0] *= code4(g0[m][bj].x) * (fin ? (f32x4){q, q, q, q} : d0);
                    acc[ai][bj][m][1] *= code4(g0[m][bj].y) * (fin ? (f32x4){q, q, q, q} : d1);
                    if (fin) *(u32x4*)(mb + (size_t)(ai * HALF + m * 16) * DM * 2 + bj * HALF * 2 + mlo) = pack8(acc[ai][bj][m][0], acc[ai][bj][m][1]);
                }
            asm volatile("" ::: "memory");
        }
        return fin;
    }
};
struct EpiPle {
    static constexpr bool CHAIN = false;
    const bf16_t* E; bf16_t* O;
    __device__ __forceinline__ void operator()(const Acc& acc, const Unit& u, int wr, int wc, int fr, int fq) const {
        const size_t uo = ((size_t)u.pm * BM * DM + (size_t)u.pn * BM) * 2;
        const char* eb = (const char*)E + uo; char* ob = (char*)O + uo;
        const unsigned lo = lane_off_of<DM>(wr, wc, fr, fq);
#pragma unroll
        for (int ai = 0; ai < 2; ++ai) {
            u32x4 ew[4][2];
#pragma unroll
            for (int m = 0; m < 4; ++m)
#pragma unroll
                for (int bj = 0; bj < 2; ++bj) ew[m][bj] = *(const u32x4*)(eb + (size_t)(ai * HALF + m * 16) * DM * 2 + bj * HALF * 2 + lo);
#pragma unroll
            for (int m = 0; m < 4; ++m)
#pragma unroll
                for (int bj = 0; bj < 2; ++bj) {
                    const f32x4 v0 = sigmoid4(acc[ai][bj][m][0]) * unpack_lo4(ew[m][bj]), v1 = sigmoid4(acc[ai][bj][m][1]) * unpack_hi4(ew[m][bj]);
                    *(u32x4*)(ob + (size_t)(ai * HALF + m * 16) * DM * 2 + bj * HALF * 2 + lo) = pack8(v0, v1);
                }
            asm volatile("" ::: "memory");
        }
    }
};
}

template <bool INIT>
__device__ __forceinline__ void row_phase(const float* hin, float* h, const bf16_t* F, float cscale, const float* ga, const float* gb, bf16_t* HN, bool write_hn, const int tid, const int bid) {
    const int wid = tid >> 6, lane = tid & 63;
    constexpr int R = 4;
    f32x4 gav[4], gbv[4];
#pragma unroll
    for (int k = 0; k < 4; ++k) {
        gav[k] = INIT ? (f32x4){0.f, 0.f, 0.f, 0.f} : *(const f32x4*)(ga + 256 * k + 4 * lane);
        gbv[k] = write_hn ? *(const f32x4*)(gb + 256 * k + 4 * lane) : (f32x4){0.f, 0.f, 0.f, 0.f};
    }
    for (int row0 = (bid * 8 + wid) * R; row0 < MTOK; row0 += gridDim.x * 8 * R) {
        f32x4 hv[R][4]; u32x2 fw[R][4];
#pragma unroll
        for (int r = 0; r < R; ++r) { const size_t ro = (size_t)(row0 + r) * DM + 4 * lane;
#pragma unroll
            for (int k = 0; k < 4; ++k) {
                hv[r][k] = *(const f32x4*)(hin + ro + 256 * k);
                if (!INIT) fw[r][k] = *(const u32x2*)(F + ro + 256 * k);
            } }
#pragma unroll
        for (int r = 0; r < R; ++r) { const size_t ro = (size_t)(row0 + r) * DM + 4 * lane;
            if (!INIT) {
                f32x4 fv[4];
#pragma unroll
                for (int k = 0; k < 4; ++k) fv[k] = (f32x4){bf_lo(fw[r][k].x), bf_hi(fw[r][k].x), bf_lo(fw[r][k].y), bf_hi(fw[r][k].y)};
                float ss = 0.f;
#pragma unroll
                for (int i = 0; i < 4; ++i) ss += fv[i][0] * fv[i][0] + fv[i][1] * fv[i][1] + fv[i][2] * fv[i][2] + fv[i][3] * fv[i][3];
                ss = wave_sum(ss);
                const float rs = cscale * __builtin_amdgcn_rsqf(ss * (1.0f / DM) + EPS);
#pragma unroll
                for (int i = 0; i < 4; ++i) hv[r][i] += fv[i] * gav[i] * rs;
            }
            float s2 = 0.f;
#pragma unroll
            for (int i = 0; i < 4; ++i) s2 += hv[r][i][0] * hv[r][i][0] + hv[r][i][1] * hv[r][i][1] + hv[r][i][2] * hv[r][i][2] + hv[r][i][3] * hv[r][i][3];
            s2 = wave_sum(s2);
            const float rs2 = __builtin_amdgcn_rsqf(s2 * (1.0f / DM) + EPS);
            if (!INIT) { _Pragma("unroll") for (int k = 0; k < 4; ++k) *(f32x4*)(h + ro + 256 * k) = hv[r][k]; }
            if (write_hn) {
#pragma unroll
                for (int k = 0; k < 4; ++k) { const f32x4 o = hv[r][k] * gbv[k] * rs2; u32x2 w; w.x = cvt_pk_bf16(o[0], o[1]); w.y = cvt_pk_bf16(o[2], o[3]); *(u32x2*)(HN + ro + 256 * k) = w; }
            }
        }
    }
}

__device__ __forceinline__ f32x4 bf4(u32x2 w) { return (f32x4){bf_lo(w.x), bf_hi(w.x), bf_lo(w.y), bf_hi(w.y)}; }
__device__ __forceinline__ float sumsq16(const f32x4 (&v)[4]) { float s = 0.f;
#pragma unroll
    for (int i = 0; i < 4; ++i) s += v[i][0] * v[i][0] + v[i][1] * v[i][1] + v[i][2] * v[i][2] + v[i][3] * v[i][3];
    return s; }
template <bool FULL>
__device__ __forceinline__ void row_phase2(const float* hin, float* h, const bf16_t* F1, float c1, const float* ga1, const bf16_t* F2, float c2, const float* ga2, const float* gb, bf16_t* HN, bool write_hn, const int tid, const int bid) {
    const int wid = tid >> 6, lane = tid & 63;
    constexpr int R = FULL ? 2 : 4;
    f32x4 g1v[4], g2v[4], gbv[4];
#pragma unroll
    for (int k = 0; k < 4; ++k) {
        g1v[k] = *(const f32x4*)(ga1 + 256 * k + 4 * lane);
        g2v[k] = FULL ? *(const f32x4*)(ga2 + 256 * k + 4 * lane) : (f32x4){0.f, 0.f, 0.f, 0.f};
        gbv[k] = write_hn ? *(const f32x4*)(gb + 256 * k + 4 * lane) : (f32x4){0.f, 0.f, 0.f, 0.f};
    }
    for (int row0 = (bid * 8 + wid) * R; row0 < MTOK; row0 += gridDim.x * 8 * R) {
        f32x4 hv[R][4]; u32x2 fa[R][4], fb[R][4];
#pragma unroll
        for (int r = 0; r < R; ++r) { const size_t ro = (size_t)(row0 + r) * DM + 4 * lane;
#pragma unroll
            for (int k = 0; k < 4; ++k) {
                hv[r][k] = *(const f32x4*)(hin + ro + 256 * k);
                fa[r][k] = *(const u32x2*)(F1 + ro + 256 * k);
                if (FULL) fb[r][k] = *(const u32x2*)(F2 + ro + 256 * k);
            } }
#pragma unroll
        for (int r = 0; r < R; ++r) { const size_t ro = (size_t)(row0 + r) * DM + 4 * lane;
            {
                f32x4 fv[4];
#pragma unroll
                for (int k = 0; k < 4; ++k) fv[k] = bf4(fa[r][k]);
                const float rs = c1 * __builtin_amdgcn_rsqf(wave_sum(sumsq16(fv)) * (1.0f / DM) + EPS);
#pragma unroll
                for (int i = 0; i < 4; ++i) hv[r][i] += fv[i] * g1v[i] * rs;
            }
            if (FULL) {
                f32x4 fv[4];
#pragma unroll
                for (int k = 0; k < 4; ++k) fv[k] = bf4(fb[r][k]);
                const float rs = c2 * __builtin_amdgcn_rsqf(wave_sum(sumsq16(fv)) * (1.0f / DM) + EPS);
#pragma unroll
                for (int i = 0; i < 4; ++i) hv[r][i] += fv[i] * g2v[i] * rs;
#pragma unroll
                for (int k = 0; k < 4; ++k) *(f32x4*)(h + ro + 256 * k) = hv[r][k];
            }
            if (write_hn) {
                const float rs2 = __builtin_amdgcn_rsqf(wave_sum(sumsq16(hv[r])) * (1.0f / DM) + EPS);
#pragma unroll
                for (int k = 0; k < 4; ++k) { const f32x4 o = hv[r][k] * gbv[k] * rs2; u32x2 w; w.x = cvt_pk_bf16(o[0], o[1]); w.y = cvt_pk_bf16(o[2], o[3]); *(u32x2*)(HN + ro + 256 * k) = w; }
            }
        }
    }
}

struct PrepJob { const float* src; bf16_t* dst; int ld, col0, k0, K, n0; };
__device__ __forceinline__ PrepJob prep_job(const Params& P, unsigned char* ws, int l, int tix) {
    constexpr int T_GU = (NGU / 64) * (DM / 64), T_D = (DM / 64) * (DFF / 64), T_IN = (NIN / 64) * (DM / 64), T_BR = (DM / 64) * (512 / 64), T_SQ = (DM / 64) * (DM / 64);
    int t = tix; const float* srcA; const float* srcB; int ld, mode, K; bf16_t* dst;
    if (t < T_GU) { srcA = PIN(3) + (size_t)l * DM * DFF; srcB = PIN(4) + (size_t)l * DM * DFF; ld = DFF; mode = 1; K = DM; dst = (bf16_t*)(ws + WS_WGU1); }
    else if ((t -= T_GU) < T_GU) { srcA = PIN(25) + (size_t)l * DM * DFF; srcB = PIN(26) + (size_t)l * DM * DFF; ld = DFF; mode = 1; K = DM; dst = (bf16_t*)(ws + WS_WGU2); }
    else if ((t -= T_GU) < T_D) { srcA = PIN(5) + (size_t)l * DFF * DM; srcB = srcA; ld = DM; mode = 0; K = DFF; dst = (bf16_t*)(ws + WS_WD1); }
    else if ((t -= T_D) < T_D) { srcA = PIN(27) + (size_t)l * DFF * DM; srcB = srcA; ld = DM; mode = 0; K = DFF; dst = (bf16_t*)(ws + WS_WD2); }
    else if ((t -= T_D) < T_IN) { srcA = PIN(8) + (size_t)l * DM * NIN; srcB = srcA; ld = NIN; mode = 2; K = DM; dst = (bf16_t*)(ws + WS_WIN); }
    else if ((t -= T_IN) < T_BR) { srcA = PIN(16) + (size_t)l * 512 * DM; srcB = srcA; ld = DM; mode = 0; K = 512; dst = (bf16_t*)(ws + WS_WBR) + (size_t)1 * DM * 512; }
    else if ((t -= T_BR) < T_BR) { srcA = PIN(21) + (size_t)l * 512 * DM; srcB = srcA; ld = DM; mode = 0; K = 512; dst = (bf16_t*)(ws + WS_WBR) + (size_t)2 * DM * 512; }
    else if ((t -= T_BR) < T_SQ) { srcA = PIN(22) + (size_t)l * DM * DM; srcB = srcA; ld = DM; mode = 0; K = DM; dst = (bf16_t*)(ws + WS_WOUT); }
    else if ((t -= T_SQ) < T_SQ) { srcA = PIN(31) + (size_t)l * DM * DM; srcB = srcA; ld = DM; mode = 0; K = DM; dst = (bf16_t*)(ws + WS_WPG); }
    else { t -= T_SQ; srcA = PIN(29) + (size_t)l * PLE * DM; srcB = srcA; ld = DM; mode = 0; K = PLE; dst = (bf16_t*)(ws + WS_WPP); }
    const int tk = K / 64, tn = t / tk, tkk = t - tn * tk, n0 = tn * 64, k0 = tkk * 64;
    const float* src = srcA; int col0 = n0;
    if (mode == 1) { const int tt = n0 >> 8, j = n0 & 255; if (j < 128) { col0 = 128 * tt + j; } else { src = srcB; col0 = 128 * tt + j - 128; } }
    else if (mode == 2) { if (n0 >= 1536 && n0 < 2560) { const int tt = (n0 - 1536) >> 8, j = (n0 - 1536) & 255; col0 = (j < 128) ? (1536 + 128 * tt + j) : (2048 + 128 * tt + j - 128); } }
    PrepJob J; J.src = src; J.dst = dst; J.ld = ld; J.col0 = col0; J.k0 = k0; J.K = K; J.n0 = n0; return J;
}

__device__ __forceinline__ void prep_weights(const Params& P, unsigned char* ws, int l, LAS unsigned char* lds, const int tid, const int bid) {
    LAS float* tile = (LAS float*)lds;
    constexpr int T_GU = (NGU / 64) * (DM / 64), T_D = (DM / 64) * (DFF / 64), T_IN = (NIN / 64) * (DM / 64), T_BR = (DM / 64) * (512 / 64), T_SQ = (DM / 64) * (DM / 64), T_PP = (DM / 64) * (PLE / 64);
    constexpr int TOTAL = 2 * T_GU + 2 * T_D + T_IN + 2 * T_BR + 2 * T_SQ + T_PP;
    {
        const int kk = tid >> 4, c4 = tid & 15, n = tid >> 3, k8 = tid & 7;
        f32x4 v0, v1; int tix = bid;
        if (tix < TOTAL) { const PrepJob J = prep_job(P, ws, l, tix); const float* sp = J.src + (size_t)(J.k0 + kk) * J.ld + J.col0 + 4 * c4; v0 = *(const f32x4*)sp; v1 = *(const f32x4*)(sp + (size_t)32 * J.ld); }
        for (; tix < TOTAL; tix += gridDim.x) {
            const PrepJob J = prep_job(P, ws, l, tix);
#pragma unroll
            for (int e = 0; e < 4; ++e) { tile[kk * 65 + 4 * c4 + e] = v0[e]; tile[(kk + 32) * 65 + 4 * c4 + e] = v1[e]; }
            __syncthreads();
            const int nx = tix + gridDim.x;
            if (nx < TOTAL) { const PrepJob Jn = prep_job(P, ws, l, nx); const float* sp = Jn.src + (size_t)(Jn.k0 + kk) * Jn.ld + Jn.col0 + 4 * c4; v0 = *(const f32x4*)sp; v1 = *(const f32x4*)(sp + (size_t)32 * Jn.ld); }
            float v[8];
#pragma unroll
            for (int i = 0; i < 8; ++i) v[i] = tile[(8 * k8 + i) * 65 + n];
            u32x4 w; w.x = cvt_pk_bf16(v[0], v[1]); w.y = cvt_pk_bf16(v[2], v[3]); w.z = cvt_pk_bf16(v[4], v[5]); w.w = cvt_pk_bf16(v[6], v[7]);
            *(u32x4*)(J.dst + (size_t)(J.n0 + n) * J.K + J.k0 + 8 * k8) = w;
            __syncthreads();
        }
    }
    {
        const float* pw = PIN(9) + (size_t)l * 4 * 128 * 128; const float* sc = PIN(10) + (size_t)l * 512; const float* wpo = PIN(11) + (size_t)l * 512 * DM;
        bf16_t* dst = (bf16_t*)(ws + WS_WBR);
        const int ol = tid & 63, i4 = __builtin_amdgcn_readfirstlane(tid >> 6);
        for (int tix = bid; tix < 16 * 16; tix += gridDim.x) {
            const int o = (tix >> 4) * 64 + ol, g = (tix >> 2) & 3, i0 = (tix & 3) * 32 + i4 * 4;
            float a[4] = {0.f, 0.f, 0.f, 0.f};
#pragma unroll 4
            for (int j = 0; j < 128; j += 4) {
                const f32x4 s4 = *(const f32x4*)(sc + g * 128 + j);
                float w[4];
#pragma unroll
                for (int jj = 0; jj < 4; ++jj) w[jj] = wpo[(size_t)(g * 128 + j + jj) * DM + o] * s4[jj];
#pragma unroll
                for (int ii = 0; ii < 4; ++ii) { const f32x4 p4 = *(const f32x4*)(pw + (size_t)(g * 128 + i0 + ii) * 128 + j);
                    a[ii] += p4[0] * w[0] + p4[1] * w[1] + p4[2] * w[2] + p4[3] * w[3]; }
            }
            u32x2 w2; w2.x = cvt_pk_bf16(a[0], a[1]); w2.y = cvt_pk_bf16(a[2], a[3]);
            *(u32x2*)(dst + (size_t)o * 512 + g * 128 + i0) = w2;
        }
    }
    {
        const float* wsrc = PIN(14) + (size_t)l * 4 * 128 * 128; bf16_t* dst = (bf16_t*)(ws + WS_WSPK);
        for (int idx = bid * 512 + tid; idx < 4 * 128 * 128 / 8; idx += gridDim.x * 512) {
            const int fq = idx & 3, kk = (idx >> 2) & 3, t = (idx >> 4) & 127, h = idx >> 11;
            float v[8];
#pragma unroll
            for (int i = 0; i < 8; ++i) { const int sp = 32 * kk + 4 * i + fq; v[i] = (sp <= t) ? wsrc[(size_t)(h * 128 + t) * 128 + sp] : 0.f; }
            u32x4 w4; w4.x = cvt_pk_bf16(v[0], v[1]); w4.y = cvt_pk_bf16(v[2], v[3]); w4.z = cvt_pk_bf16(v[4], v[5]); w4.w = cvt_pk_bf16(v[6], v[7]);
            *(u32x4*)(dst + (size_t)idx * 8) = w4;
        }
    }
}

__device__ __forceinline__ void convert_p(const float* p, bf16_t* PB, const int tid, const int bid) {
    for (size_t idx = (size_t)bid * 512 + tid; idx < (size_t)MTOK * PLE / 8; idx += (size_t)gridDim.x * 512) {
        const f32x4 a = *(const f32x4*)(p + idx * 8), b = *(const f32x4*)(p + idx * 8 + 4);
        *(u32x4*)(PB + idx * 8) = pack8(a, b);
    }
}

__device__ __forceinline__ void mixer_phase(const Params& P, unsigned char* ws, int l, LAS unsigned char* lds, const int tid, const int bid) {
    unsigned char* big = ws + WS_BIG;
    const bf16_t* ZP = (const bf16_t*)(big + BIG_ZP); const bf16_t* U = (const bf16_t*)(big + BIG_U); const bf16_t* V = (const bf16_t*)(big + BIG_V); const bf16_t* XG = (const bf16_t*)(big + BIG_XG);
    bf16_t* X3 = (bf16_t*)(big + BIG_X3);
    const int wid = __builtin_amdgcn_readfirstlane(tid >> 6), lane = tid & 63;

    {
        const float* lng = PIN(12) + (size_t)l * 512; const float* lnb = PIN(13) + (size_t)l * 512; const float* bsp = PIN(15) + (size_t)l * 4 * 128;
        const bf16_t* WSPK = (const bf16_t*)(ws + WS_WSPK);
        bf16_t* XS = X3 + (size_t)1 * MTOK * 512;
        const int fr = lane & 15, fq = lane >> 4, h = wid >> 1, th = wid & 1;
        constexpr int VP = 528;
        for (int ch = bid; ch < MTOK / 128; ch += gridDim.x) {
            const size_t tok0 = (size_t)ch * 128;
            {
                const f32x4 g0 = *(const f32x4*)(lng + 8 * lane), g1 = *(const f32x4*)(lng + 8 * lane + 4), b0 = *(const f32x4*)(lnb + 8 * lane), b1 = *(const f32x4*)(lnb + 8 * lane + 4);
#pragma unroll
                for (int i0 = 0; i0 < 16; i0 += 8) {
                    u32x4 wv[8];
#pragma unroll
                    for (int i = 0; i < 8; ++i) wv[i] = *(const u32x4*)(V + (tok0 + wid * 16 + i0 + i) * 512 + 8 * lane);
#pragma unroll
                    for (int i = 0; i < 8; ++i) {
                        const int sp = wid * 16 + i0 + i;
                        f32x4 x0 = unpack_lo4(wv[i]), x1 = unpack_hi4(wv[i]);
                        float s = (x0[0] + x0[1]) + (x0[2] + x0[3]) + (x1[0] + x1[1]) + (x1[2] + x1[3]);
                        s = wave_sum(s); const float mu = s * (1.0f / 512.0f);
                        x0 -= mu; x1 -= mu;
                        float q = x0[0] * x0[0] + x0[1] * x0[1] + x0[2] * x0[2] + x0[3] * x0[3] + x1[0] * x1[0] + x1[1] * x1[1] + x1[2] * x1[2] + x1[3] * x1[3];
                        q = wave_sum(q); const float rs = __builtin_amdgcn_rsqf(q * (1.0f / 512.0f) + EPS);
                        x0 = x0 * rs * g0 + b0; x1 = x1 * rs * g1 + b1;
                        *(LAS u32x4*)(lds + (size_t)sp * (VP * 2) + 16 * lane) = pack8(x0, x1);
                    }
                }
            }
            __syncthreads();
            {
                bf16x8 Wf[4][4]; float bs[4];
#pragma unroll
                for (int m = 0; m < 4; ++m) { const int t = 64 * th + 16 * m + fr; bs[m] = bsp[h * 128 + t];
#pragma unroll
                    for (int kk = 0; kk < 4; ++kk) Wf[m][kk] = *(const bf16x8*)(WSPK + ((size_t)((h * 128 + t) * 4 + kk) * 4 + fq) * 8); }
                const size_t ubase = (tok0 + 64 * th + fr) * 512 + 128 * h + 4 * fq;
                u32x2 uw[2][4];
#pragma unroll
                for (int m = 0; m < 4; ++m) uw[0][m] = *(const u32x2*)(U + ubase + (size_t)(16 * m) * 512);
#pragma unroll
                for (int n = 0; n < 8; ++n) {
                    if (n + 1 < 8) {
#pragma unroll
                        for (int m = 0; m < 4; ++m) uw[(n + 1) & 1][m] = *(const u32x2*)(U + ubase + (size_t)(16 * m) * 512 + 16 * (n + 1));
                    }
                    f32x4 acc[4];
#pragma unroll
                    for (int m = 0; m < 4; ++m) acc[m] = (f32x4){0.f, 0.f, 0.f, 0.f};
#pragma unroll
                    for (int kk = 0; kk < 4; ++kk) {
                        bf16x8 X;
#pragma unroll
                        for (int i = 0; i < 8; ++i) X[i] = *(const LAS short*)(lds + (size_t)(32 * kk + 4 * i + fq) * (VP * 2) + 2 * (128 * h + 16 * n + fr));
#pragma unroll
                        for (int m = 0; m < 4; ++m) acc[m] = __builtin_amdgcn_mfma_f32_16x16x32_bf16(X, Wf[m][kk], acc[m], 0, 0, 0);
                    }
#pragma unroll
                    for (int m = 0; m < 4; ++m) {
                        const u32x2 u2 = uw[n & 1][m];
                        const f32x4 sv = acc[m] + bs[m];
                        u32x2 o; o.x = cvt_pk_bf16(bf_lo(u2.x) * sv[0], bf_hi(u2.x) * sv[1]); o.y = cvt_pk_bf16(bf_lo(u2.y) * sv[2], bf_hi(u2.y) * sv[3]);
                        *(u32x2*)(XS + ubase + (size_t)(16 * m) * 512 + 16 * n) = o;
                    }
                }
            }
            __syncthreads();
        }
    }

    {
        const float* dwk = PIN(17) + (size_t)l * 31 * 512; const float* dwb = PIN(18) + (size_t)l * 512; const float* lng = PIN(19) + (size_t)l * 512; const float* lnb = PIN(20) + (size_t)l * 512;
        bf16_t* XC = X3 + (size_t)2 * MTOK * 512;
        LAS unsigned char* xs = lds;
        LAS float* ys = (LAS float*)(lds + 65536);
        const int c = tid; float wk[31];
#pragma unroll
        for (int k = 0; k < 31; ++k) wk[k] = dwk[k * 512 + c];
        const float bias = dwb[c];
        const f32x4 g0 = *(const f32x4*)(lng + 8 * lane), g1 = *(const f32x4*)(lng + 8 * lane + 4), b0 = *(const f32x4*)(lnb + 8 * lane), b1 = *(const f32x4*)(lnb + 8 * lane + 4);
        u32x4 pre[8];
#define CONV_LOAD(ct_) do { const int tok0_ = (ct_) * 32, t0_ = tok0_ & (SEQ - 1); _Pragma("unroll") for (int i = 0; i < 8; ++i) { const int idx = tid + 512 * i; const int r = idx >> 6, c8 = idx & 63; \
            pre[i] = (u32x4){0u, 0u, 0u, 0u}; if (idx < 62 * 64 && t0_ - 30 + r >= 0) pre[i] = *(const u32x4*)(XG + (size_t)(tok0_ - 30 + r) * 512 + 8 * c8); } } while (0)
        int ct = bid;
        if (ct < MTOK / 32) CONV_LOAD(ct);
        for (; ct < MTOK / 32; ct += gridDim.x) {
            const int tok0 = ct * 32;
#pragma unroll
            for (int i = 0; i < 8; ++i) { const int idx = tid + 512 * i; if (idx < 62 * 64) *(LAS u32x4*)(xs + (idx >> 6) * 1024 + 16 * (idx & 63)) = pre[i]; }
            __syncthreads();
            if (ct + (int)gridDim.x < MTOK / 32) CONV_LOAD(ct + gridDim.x);
#pragma unroll
            for (int hb = 0; hb < 2; ++hb) {
                float x[46];
#pragma unroll
                for (int r = 0; r < 46; ++r) x[r] = __uint_as_float(((unsigned)*(const LAS unsigned short*)(xs + (16 * hb + r) * 1024 + 2 * c)) << 16);
#pragma unroll
                for (int t = 0; t < 16; ++t) { float y = bias;
#pragma unroll
                    for (int k = 0; k < 31; ++k) y += wk[k] * x[t + k];
                    ys[(16 * hb + t) * 512 + c] = y; }
            }
            __syncthreads();
#pragma unroll
            for (int i = 0; i < 4; ++i) { const int t = wid * 4 + i;
                f32x4 x0 = *(const LAS f32x4*)(ys + t * 512 + 8 * lane), x1 = *(const LAS f32x4*)(ys + t * 512 + 8 * lane + 4);
                float s = (x0[0] + x0[1]) + (x0[2] + x0[3]) + (x1[0] + x1[1]) + (x1[2] + x1[3]);
                s = wave_sum(s); const float mu = s * (1.0f / 512.0f);
                x0 -= mu; x1 -= mu;
                float q = x0[0] * x0[0] + x0[1] * x0[1] + x0[2] * x0[2] + x0[3] * x0[3] + x1[0] * x1[0] + x1[1] * x1[1] + x1[2] * x1[2] + x1[3] * x1[3];
                q = wave_sum(q); const float rs = __builtin_amdgcn_rsqf(q * (1.0f / 512.0f) + EPS);
                x0 = x0 * rs * g0 + b0; x1 = x1 * rs * g1 + b1;
                x0 = x0 * sigmoid4(x0); x1 = x1 * sigmoid4(x1);
                *(u32x4*)(XC + (size_t)(tok0 + t) * 512 + 8 * lane) = pack8(x0, x1); }
            __syncthreads();
        }
#undef CONV_LOAD
    }

    {
        bf16_t* XP = X3;
        const int g = wid & 3, w = 2 << g, oct = g * 16 + (lane & 15), sub = (wid >> 2) * 4 + (lane >> 4);
        for (int it = bid; it < MTOK / 32; it += gridDim.x) {
            f32x4 s0[4], s1[4], c0[4], c1[4];
#pragma unroll
            for (int u = 0; u < 4; ++u) { s0[u] = (f32x4){0.f, 0.f, 0.f, 0.f}; s1[u] = s0[u]; c0[u] = s0[u]; c1[u] = s0[u]; }
            for (int j0 = 0; j0 < w; j0 += 4) {
                u32x4 wv[4][4];
#pragma unroll
                for (int jj = 0; jj < 4; ++jj)
#pragma unroll
                    for (int u = 0; u < 4; ++u) { const int j = j0 + jj, tok = it * 32 + 8 * u + sub, t = tok & (SEQ - 1); wv[jj][u] = (u32x4){0u, 0u, 0u, 0u};
                        if (j < w && j <= t) wv[jj][u] = *(const u32x4*)(ZP + (size_t)(tok - j) * 512 + 8 * oct); }
#pragma unroll
                for (int jj = 0; jj < 4; ++jj)
#pragma unroll
                    for (int u = 0; u < 4; ++u) { const f32x4 a = unpack_lo4(wv[jj][u]), b = unpack_hi4(wv[jj][u]); s0[u] += a; s1[u] += b; if (j0 + jj == 0) { c0[u] = a; c1[u] = b; } }
            }
#pragma unroll
            for (int u = 0; u < 4; ++u) { const int tok = it * 32 + 8 * u + sub, t = tok & (SEQ - 1);
                const float inv = 1.0f / (float)((t + 1) < w ? (t + 1) : w);
                *(u32x4*)(XP + (size_t)tok * 512 + 8 * oct) = pack8(s0[u] * inv - c0[u], s1[u] * inv - c1[u]); }
        }
    }
}

#define XB_TMO      128
#define XB_XCNT(j)  (256  + 64 * (j))
#define XB_XSUB(j)  (1280 + 64 * (j))
#define XB_XGEN(j)  (2304 + 64 * (j))
#define XB_TOP      3328
#define XB_TOPGEN   3392
#define XCD_BAR_WORDS 3456
#define XB_SPIN_CAP (1u << 18)
__device__ __forceinline__ unsigned xb_ld(unsigned* p)              { return __hip_atomic_load(p, __ATOMIC_RELAXED, __HIP_MEMORY_SCOPE_AGENT); }
__device__ __forceinline__ unsigned xb_add(unsigned* p, unsigned v) { return __hip_atomic_fetch_add(p, v, __ATOMIC_RELAXED, __HIP_MEMORY_SCOPE_AGENT); }
__device__ __forceinline__ unsigned xb_xcc_id() { return (unsigned)__builtin_amdgcn_s_getreg((3 << 11) | 20) & 0xFu; }
#define XB_SPIN(cond, bar) do { unsigned _sp = 0; while (cond) { __builtin_amdgcn_s_sleep(1); \
    if ((++_sp & 255u) == 0u) { if (xb_ld(&(bar)[XB_TMO])) break; if (_sp > XB_SPIN_CAP) { atomicAdd(&(bar)[XB_TMO], 1u); break; } } } } while (0)
struct XcdBarrier { unsigned* bar; unsigned x; volatile LAS unsigned* st; };
__device__ __forceinline__ XcdBarrier xcd_barrier_post(unsigned* bar, volatile LAS unsigned* st) {
    XcdBarrier b; b.bar = bar; b.x = xb_xcc_id(); b.st = st;
    if (threadIdx.x == 0) (void)xb_add(&bar[XB_XCNT(b.x)], 1u);
    return b;
}
__device__ __forceinline__ void xcd_barrier_complete(unsigned* bar, unsigned x, unsigned& nloc, unsigned& nx) {
    const unsigned G = gridDim.x * gridDim.y * gridDim.z;
    unsigned sum, cnt, mine, sp = 0u;
    for (;;) {
        sum = 0u; cnt = 0u; mine = 0u;
#pragma unroll
        for (unsigned j = 0; j < 16; ++j) { const unsigned c = xb_ld(&bar[XB_XCNT(j)]); sum += c; cnt += (c > 0u) ? 1u : 0u; mine = (j == x) ? c : mine; }
        if (sum == G) break;
        __builtin_amdgcn_s_sleep(1);
        if ((++sp & 255u) == 0u) { if (xb_ld(&bar[XB_TMO])) break; if (sp > XB_SPIN_CAP) { atomicAdd(&bar[XB_TMO], 1u); break; } }
    }
    nloc = mine > 0u ? mine : 1u; nx = cnt > 0u ? cnt : 1u;
}
__device__ __forceinline__ void xcd_barrier(const XcdBarrier& b) {
    asm volatile("s_waitcnt vmcnt(0)" ::: "memory");
    __syncthreads();
    if (threadIdx.x == 0) {
        unsigned* bar = b.bar;
        __builtin_amdgcn_s_waitcnt(0);
        unsigned nloc = b.st[0], nx = b.st[1];
        if (nloc == 0u) { xcd_barrier_complete(bar, b.x, nloc, nx); b.st[0] = nloc; b.st[1] = nx; }
        const unsigned old = xb_add(&bar[XB_XSUB(b.x)], 1u);
        const unsigned gen = old / nloc;
        if (old + 1u == (gen + 1u) * nloc) {
            __builtin_amdgcn_fence(__ATOMIC_RELEASE, "agent");
            asm volatile("s_waitcnt vmcnt(0)" ::: "memory");
            const unsigned og = xb_add(&bar[XB_TOP], 1u);
            const unsigned tg = og / nx;
            if (og + 1u == (tg + 1u) * nx) xb_add(&bar[XB_TOPGEN], 1u);
            else XB_SPIN(xb_ld(&bar[XB_TOPGEN]) == tg, bar);
            __builtin_amdgcn_fence(__ATOMIC_ACQUIRE, "agent");
            xb_add(&bar[XB_XGEN(b.x)], 1u);
            asm volatile("s_waitcnt vmcnt(0)" ::: "memory");
        } else {
            XB_SPIN(xb_ld(&bar[XB_XGEN(b.x)]) == gen, bar);
            __builtin_amdgcn_fence(__ATOMIC_ACQUIRE, "agent");
            asm volatile("s_waitcnt vmcnt(0)" ::: "memory");
        }
    }
    __syncthreads();
}

__device__ __forceinline__ void run_phase(const Params& P, int ph, LAS unsigned char* lds, const float rmul = 1.0f, const bool row_only = false) {
    GAS unsigned char* wsg = P.ws; GAS float* outg = P.out; int tid = threadIdx.x, bid = blockIdx.x;
    asm volatile("" : "+s"(wsg), "+s"(outg), "+v"(tid), "+s"(bid));
    unsigned char* ws = (unsigned char*)wsg; float* out = (float*)outg;
    unsigned char* big = ws + WS_BIG;
    bf16_t* HN = (bf16_t*)(ws + WS_HN); bf16_t* F = (bf16_t*)(ws + WS_F); bf16_t* F2 = (bf16_t*)(ws + WS_F2);
    const int G = gridDim.x, c = bid;
    constexpr unsigned PM = PHASE_MASK;
    if (ph == 0) {
        if (!(PM & (1u << 13))) return;
        prep_weights(P, ws, 0, lds, tid, bid);
        row_phase<true>(PIN(0), out, nullptr, 0.f, nullptr, PIN(2), HN, true, tid, bid);
        return;
    }
    const int l = (ph - 1) / 13, sub = (ph - 1) % 13;
    pg8::Order S;
    switch (sub) {
    case 0: case 8: if (PM & 1u) {
        pg8::Gemm g{HN, (const bf16_t*)(ws + (sub == 0 ? WS_WGU1 : WS_WGU2)), MTOK, NGU, DM}; S.init(MTOK, NGU, G, c, 1);
        pg8::EpiGLU E{(bf16_t*)(big + BIG_ACT)};
        pg8::gemm_phase(lds, g, S, E, tid);
        if (sub == 8) {
            pg8::Gemm g2{(const bf16_t*)(big + BIG_PB), (const bf16_t*)(ws + WS_WPP), MTOK, DM, PLE}; S.init(MTOK, DM, G, c, 1);
            pg8::EpiStore E2{(bf16_t*)(big + BIG_E)};
            pg8::gemm_phase(lds, g2, S, E2, tid);
        }
    } break;
    case 1: case 9: if (PM & 2u) {
        pg8::Gemm g{(const bf16_t*)(big + BIG_ACT), (const bf16_t*)(ws + (sub == 1 ? WS_WD1 : WS_WD2)), MTOK, DM, DFF}; S.init(MTOK, DM, G, c, 1);
        pg8::EpiStore E{F};
        pg8::gemm_phase(lds, g, S, E, tid);
    } break;
    case 2: if (PM & 4u) row_phase2<false>(l == 0 ? PIN(0) : (const float*)out, out, F, 0.5f, PIN(6) + l * DM, nullptr, 0.f, nullptr, PIN(7) + l * DM, HN, true, tid, bid); break;
    case 3: if (PM & 8u) {
        pg8::Gemm g{HN, (const bf16_t*)(ws + WS_WIN), MTOK, NIN, DM}; S.init(MTOK, NIN, G, c, 1);
        pg8::EpiIn E{(bf16_t*)(big + BIG_ZP), (bf16_t*)(big + BIG_U), (bf16_t*)(big + BIG_V), (bf16_t*)(big + BIG_XG), (bf16_t*)(big + BIG_GATES)};
        pg8::gemm_phase(lds, g, S, E, tid);
    } break;
    case 4: if (PM & 16u) mixer_phase(P, ws, l, lds, tid, bid); break;
    case 5: if (PM & 32u) {
        pg8::Gemm g{(const bf16_t*)(big + BIG_X3), (const bf16_t*)(ws + WS_WBR), MTOK, DM, 512}; S.init(MTOK, DM, G, c, 3);
        pg8::EpiBranch E{(const unsigned char*)(big + BIG_GATES), (bf16_t*)(big + BIG_MERGED)};
        pg8::gemm_phase(lds, g, S, E, tid);
    } break;
    case 6: if (PM & 64u) {
        pg8::Gemm g{(const bf16_t*)(big + BIG_MERGED), (const bf16_t*)(ws + WS_WOUT), MTOK, DM, DM}; S.init(MTOK, DM, G, c, 1);
        pg8::EpiStore E{F2};
        pg8::gemm_phase(lds, g, S, E, tid);
    } break;
    case 7: if (PM & 128u) {
        row_phase2<true>(l == 0 ? PIN(0) : (const float*)out, out, F, 0.5f, PIN(6) + l * DM, F2, 1.0f, PIN(23) + l * DM, PIN(24) + l * DM, HN, true, tid, bid);
        if (!row_only) convert_p(PIN(1) + (size_t)l * MTOK * PLE, (bf16_t*)(big + BIG_PB), tid, bid);
        } break;
    case 10: if (PM & 1024u) row_phase2<false>(out, out, F, 0.5f, PIN(28) + l * DM, nullptr, 0.f, nullptr, PIN(30) + l * DM, HN, true, tid, bid); break;
    case 11: if (PM & 2048u) {
        pg8::Gemm g{HN, (const bf16_t*)(ws + WS_WPG), MTOK, DM, DM}; S.init(MTOK, DM, G, c, 1);
        pg8::EpiPle E{(const bf16_t*)(big + BIG_E), F2};
        pg8::gemm_phase(lds, g, S, E, tid);
    } break;
    case 12: if (PM & 4096u) {
        row_phase2<true>(out, out, F, 0.5f, PIN(28) + l * DM, F2, 1.0f, PIN(32) + l * DM, PIN(2) + (l + 1 < NLAYER ? l + 1 : l) * DM, HN, l + 1 < NLAYER, tid, bid);
        if (l + 1 < NLAYER && !row_only) prep_weights(P, ws, l + 1, lds, tid, bid);
        } break;
    default: break;
    }
}

__global__ void __launch_bounds__(512, 2) mega(Params P) {
    extern __shared__ __attribute__((aligned(16))) unsigned char lds_raw[];
    LAS unsigned char* lds = (LAS unsigned char*)lds_raw;
    cg::grid_group grid = cg::this_grid();
#if !MULTI_LAUNCH
    volatile LAS unsigned* st = (volatile LAS unsigned*)(lds + LDS_BYTES - 16);
    if (threadIdx.x < 2) st[threadIdx.x] = 0u;
    __syncthreads();
    const XcdBarrier bar = xcd_barrier_post((unsigned*)((unsigned char*)P.ws + WS_BAR), st);
#endif
    for (int ph = P.ph_lo; ph < P.ph_hi; ++ph) {
        run_phase(P, ph, lds);
#if PROBE_DUP
        {
            const int sub = ph == 0 ? -1 : (ph - 1) % 13;
            const bool is_gemm = (sub == 0 || sub == 1 || sub == 3 || sub == 5 || sub == 6 || sub == 8 || sub == 9 || sub == 11);
            if (((PROBE_DUP & 1) && is_gemm) || ((PROBE_DUP & 2) && sub == 4)) { __syncthreads(); run_phase(P, ph, lds); }
#if !MULTI_LAUNCH
            if ((PROBE_DUP & 4) && ph > 0) xcd_barrier(bar);
#endif
        }
#endif
#if !MULTI_LAUNCH
        if (ph + 1 < P.ph_hi) { if (ph == 0) grid.sync(); else xcd_barrier(bar); }
#endif
    }
}

extern "C" void kernel_launch(void* const* d_in, const int* in_sizes, int n_in, void* d_out, int out_size, void* d_ws, size_t ws_size, hipStream_t stream) {
    static int grid = 0;
    if (grid == 0) {
        if (n_in != 33 || ws_size < WS_END) { fprintf(stderr, "kernel_launch: unexpected n_in %d or ws_size %zu (< %zu)\n", n_in, ws_size, (size_t)WS_END); grid = -1; return; }
        int dev = 0, cus = 0, per_cu = 0;
        hipGetDevice(&dev);
        hipDeviceGetAttribute(&cus, hipDeviceAttributeMultiprocessorCount, dev);
        if (hipFuncSetAttribute((const void*)mega, hipFuncAttributeMaxDynamicSharedMemorySize, LDS_BYTES) != hipSuccess) { fprintf(stderr, "kernel_launch: hipFuncSetAttribute failed\n"); grid = -1; return; }
        hipOccupancyMaxActiveBlocksPerMultiprocessor(&per_cu, (const void*)mega, 512, LDS_BYTES);
        if (per_cu < 1) per_cu = 1;
        (void)hipGetLastError();
        grid = cus * per_cu;
    }
    if (grid < 0) return;
    Params p{};
    for (int i = 0; i < 33; ++i) p.in[i] = (const GAS float*)d_in[i];
    p.out = (GAS float*)d_out; p.ws = (GAS unsigned char*)d_ws;
#if MULTI_LAUNCH
    for (int ph = 0; ph < NPHASE; ++ph) {
        p.ph_lo = ph; p.ph_hi = ph + 1;
        hipLaunchKernelGGL(mega, dim3(grid), dim3(512), LDS_BYTES, stream, p);
    }
#else
    p.ph_lo = 0; p.ph_hi = NPHASE;
    if (hipMemsetAsync((char*)d_ws + WS_BAR, 0, 16384, stream) != hipSuccess) { fprintf(stderr, "kernel_launch: memset of the barrier words failed\n"); return; }
    void* args[] = {&p};
    hipError_t e = hipLaunchCooperativeKernel((const void*)mega, dim3(grid), dim3(512), args, LDS_BYTES, stream);
    if (e != hipSuccess) fprintf(stderr, "cooperative launch failed: %s (grid %d)\n", hipGetErrorString(e), grid);
#endif
}
```

```cpp
#include <hip/hip_runtime.h>
#include <hip/hip_cooperative_groups.h>
#include <cstdio>
namespace cg = cooperative_groups;

#ifndef PHASE_MASK
#define PHASE_MASK 0xffffu
#endif
#ifndef PROBE_DUP
#define PROBE_DUP 0
#endif
#ifndef MULTI_LAUNCH
#define MULTI_LAUNCH 0
#endif

#define LAS __attribute__((address_space(3)))
typedef unsigned short bf16_t;
typedef short bf16x8 __attribute__((ext_vector_type(8)));
typedef float f32x4 __attribute__((ext_vector_type(4)));
typedef float f32x2 __attribute__((ext_vector_type(2)));
typedef unsigned u32x4 __attribute__((ext_vector_type(4)));
typedef unsigned u32x2 __attribute__((ext_vector_type(2)));

constexpr int MTOK = 32768, DM = 1024, DFF = 2816, SEQ = 4096, NLAYER = 4, PLE = 256;
constexpr int NGU = 2 * DFF;
constexpr int NIN = 5632;
constexpr float EPS = 1e-6f;
constexpr int LDS_BYTES = 147456;
constexpr int NPHASE = 1 + 13 * NLAYER;

constexpr size_t WS_WGU1 = 0;
constexpr size_t WS_WD1 = WS_WGU1 + (size_t)NGU * DM * 2;
constexpr size_t WS_WGU2 = WS_WD1 + (size_t)DM * DFF * 2;
constexpr size_t WS_WD2 = WS_WGU2 + (size_t)NGU * DM * 2;
constexpr size_t WS_WIN = WS_WD2 + (size_t)DM * DFF * 2;
constexpr size_t WS_WBR = WS_WIN + (size_t)NIN * DM * 2;
constexpr size_t WS_WOUT = WS_WBR + (size_t)3 * DM * 512 * 2;
constexpr size_t WS_WPG = WS_WOUT + (size_t)DM * DM * 2;
constexpr size_t WS_WPP = WS_WPG + (size_t)DM * DM * 2;
constexpr size_t WS_WSPK = WS_WPP + (size_t)DM * PLE * 2;
constexpr size_t WS_HN = WS_WSPK + (size_t)4 * 128 * 128 * 2;
constexpr size_t WS_F = WS_HN + (size_t)MTOK * DM * 2;
constexpr size_t WS_BIG = WS_F + (size_t)MTOK * DM * 2;
constexpr size_t BIG_ACT = 0;
constexpr size_t BIG_ZP = 0, BIG_U = (size_t)MTOK * 512 * 2, BIG_V = 2 * BIG_U, BIG_XG = 3 * BIG_U;
constexpr size_t BIG_GATES = 4 * BIG_U;
constexpr size_t BIG_X3 = BIG_GATES + (size_t)MTOK * 3072 * 2;
constexpr size_t BIG_MERGED = 0;
constexpr size_t BIG_E = (size_t)192 * 1024 * 1024;
constexpr size_t BIG_PB = BIG_X3;
constexpr size_t WS_BAR = WS_BIG + BIG_X3 + (size_t)3 * MTOK * 512 * 2;
constexpr size_t WS_F2 = WS_BAR + 16384;
constexpr size_t WS_END = WS_F2 + (size_t)MTOK * DM * 2;

#define GAS __attribute__((address_space(1)))
struct Params { const GAS float* in[33]; GAS float* out; GAS unsigned char* ws; int ph_lo, ph_hi; };
#define PIN(i) ((const float*)P.in[i])

typedef __bf16 bf16x2_t __attribute__((ext_vector_type(2)));
__device__ __forceinline__ unsigned cvt_pk_bf16(float lo, float hi) { const f32x2 v = {lo, hi}; return __builtin_bit_cast(unsigned, __builtin_convertvector(v, bf16x2_t)); }
__device__ __forceinline__ float bf_lo(unsigned w) { return __uint_as_float(w << 16); }
__device__ __forceinline__ float bf_hi(unsigned w) { return __uint_as_float(w & 0xffff0000u); }
__device__ __forceinline__ float sigmoid_f(float x) { return __builtin_amdgcn_rcpf(1.0f + __builtin_amdgcn_exp2f(-1.44269504f * x)); }
__device__ __forceinline__ float wave_sum(float v) {
#pragma unroll
    for (int o = 32; o >= 1; o >>= 1) v += __shfl_xor(v, o);
    return v;
}
__device__ __forceinline__ f32x2 gelu_pk(f32x2 v) {
    const f32x2 av = __builtin_elementwise_abs(v), d = av * 0.2316418882f + 1.0f;
    f32x2 t; t.x = __builtin_amdgcn_rcpf(d.x); t.y = __builtin_amdgcn_rcpf(d.y);
    f32x2 q = t * 0.5307027145f + (-0.7265760135f); q = q * t + 0.7107068705f; q = q * t + (-0.142248368f); q = q * t + 0.127414796f; q = q * t;
    const f32x2 s = (v * v) * (-0.72134752044f);
    f32x2 e; e.x = __builtin_amdgcn_exp2f(s.x); e.y = __builtin_amdgcn_exp2f(s.y);
    const f32x2 m = v * (q * e), r = v - m;
    f32x2 o; o.x = v.x < 0.f ? m.x : r.x; o.y = v.y < 0.f ? m.y : r.y; return o;
}
__device__ __forceinline__ f32x4 gelu4(f32x4 v) { f32x2 a = gelu_pk((f32x2){v[0], v[1]}), b = gelu_pk((f32x2){v[2], v[3]}); return (f32x4){a.x, a.y, b.x, b.y}; }
__device__ __forceinline__ f32x4 sigmoid4(f32x4 v) { return (f32x4){sigmoid_f(v[0]), sigmoid_f(v[1]), sigmoid_f(v[2]), sigmoid_f(v[3])}; }
__device__ __forceinline__ u32x4 pack8(f32x4 a, f32x4 b) { u32x4 w; w.x = cvt_pk_bf16(a[0], a[1]); w.y = cvt_pk_bf16(a[2], a[3]); w.z = cvt_pk_bf16(b[0], b[1]); w.w = cvt_pk_bf16(b[2], b[3]); return w; }
__device__ __forceinline__ f32x4 unpack_lo4(u32x4 w) { return (f32x4){bf_lo(w.x), bf_hi(w.x), bf_lo(w.y), bf_hi(w.y)}; }
__device__ __forceinline__ f32x4 unpack_hi4(u32x4 w) { return (f32x4){bf_lo(w.z), bf_hi(w.z), bf_lo(w.w), bf_hi(w.w)}; }

namespace pg8 {
constexpr int BM = 256, BK = 64, HALF = 128, HTB = HALF * BK * 2, STAGE_BYTES = 8 * HTB, NXCD = 8, WGM = 8;
__device__ __forceinline__ int lds_byte(int r, int c) { const int st = (r >> 4) * 2 + (c >> 5), rr = r & 15, cc = c & 31, ob = rr * 64 + cc * 2; return st * 1024 + (ob ^ (((ob >> 9) & 1) << 5)); }
__device__ __forceinline__ void stage_rc(int b, int& R, int& C) { const int st = b / 1024, sb = b % 1024, swz = sb ^ (((sb >> 9) & 1) << 5); R = (st >> 1) * 16 + swz / 64; C = (st & 1) * 32 + (swz % 64) / 2; }
__device__ __forceinline__ int perm32(int rho) { const int n = rho >> 4, i = rho & 15; return 8 * (i >> 2) + 4 * n + (i & 3); }

struct Unit { int pm, pn; };
struct Gemm { const bf16_t* A; const bf16_t* Bt; int M, N, K; };

struct Order {
    int nM, nN, nwg, G, c, zn;
    __device__ void init(int M, int N, int G_, int c_, int zn_) { nM = M / BM; nN = N / BM; nwg = nM * nN; G = G_; c = c_; zn = zn_; }
    __device__ bool next(int i, Unit& u) const {
        const int ti = i / zn, z = i - ti * zn;
        const long L = (long)ti * G + c; if (L >= nwg) return false;
        int wgid = (int)L; { const int q = nwg / NXCD, r = nwg % NXCD, xcd = wgid % NXCD, off = wgid / NXCD; wgid = (xcd < r ? xcd * (q + 1) : r * (q + 1) + (xcd - r) * q) + off; }
        const int nig = WGM * nN, gid = wgid / nig, fm = gid * WGM, gsz = (nM - fm) < WGM ? (nM - fm) : WGM;
        u.pm = z * nM + fm + ((wgid % nig) % gsz); u.pn = z * nN + (wgid % nig) / gsz; return true;
    }
};

template <class Epi>
__device__ __forceinline__ void gemm_phase(LAS unsigned char* lds, const Gemm g, const Order& S, const Epi& E, const int tid) {
    const int wid = __builtin_amdgcn_readfirstlane(tid >> 6), lane = tid & 63, wr = wid >> 2, wc = wid & 3, fr = lane & 15, fq = lane >> 4;
    const int K = g.K, nt = K / BK;
    unsigned voffA[2], voffB[2];
#pragma unroll
    for (int i = 0; i < 2; ++i) { int R, C; stage_rc(tid * 16 + i * 8192, R, C); const int Rb = (R & ~31) + perm32(R & 31);
        voffA[i] = (unsigned)(R * K + C) * 2u; voffB[i] = (unsigned)(Rb * K + C) * 2u; }
    const size_t kstep = (size_t)(BK * 2);
    const size_t hstep = (size_t)HALF * K * 2;
    const size_t tstep = 2 * hstep;
    const unsigned ldsw = (unsigned)wid * 1024u;
    const int aoff = lds_byte(wr * 64 + fr, fq * 8), boff = lds_byte(wc * 32 + fr, fq * 8);
#define PG8_SA(b, h) (((b) * 2 + (h)) * HTB)
#define PG8_SB(b, h) ((4 + (b) * 2 + (h)) * HTB)
#define PG8_STAGE(bufoff, gbase, voff) do { _Pragma("unroll") for (int _i = 0; _i < 2; ++_i) \
        __builtin_amdgcn_global_load_lds((const unsigned*)((const char*)(gbase) + (voff)[_i]), (LAS unsigned*)(lds + (bufoff) + ldsw + _i * 8192), 16, 0, 0); } while (0)
#define PG8_LDA(dst, b, h) do { _Pragma("unroll") for (int m = 0; m < 4; ++m) _Pragma("unroll") for (int k = 0; k < 2; ++k) dst[m][k] = *(const LAS bf16x8*)(lds + PG8_SA(b, h) + aoff + m * 2048 + k * 1024); } while (0)
#define PG8_LDB(dst, b, h) do { _Pragma("unroll") for (int n = 0; n < 2; ++n) _Pragma("unroll") for (int k = 0; k < 2; ++k) dst[n][k] = *(const LAS bf16x8*)(lds + PG8_SB(b, h) + boff + n * 2048 + k * 1024); } while (0)
#define PG8_MMA(ai, bj, At, Bt) do { __builtin_amdgcn_s_setprio(1); _Pragma("unroll") for (int m = 0; m < 4; ++m) _Pragma("unroll") for (int n = 0; n < 2; ++n) _Pragma("unroll") for (int k = 0; k < 2; ++k) \
        acc[ai][bj][m][n] = __builtin_amdgcn_mfma_f32_16x16x32_bf16(Bt[n][k], At[m][k], acc[ai][bj][m][n], 0, 0, 0); __builtin_amdgcn_s_setprio(0); } while (0)
#define PG8_WAIT_V(n) asm volatile("s_waitcnt vmcnt(" #n ")" ::: "memory")
#define PG8_WAIT_L(n) asm volatile("s_waitcnt lgkmcnt(" #n ")" ::: "memory")
#define PG8_BAR __builtin_amdgcn_s_barrier()
#define PG8_SCHED __builtin_amdgcn_sched_barrier(0)
    Unit cur, nxt; int ui = 0;
    if (!S.next(0, cur)) return;
    f32x4 acc[2][2][4][2];
#pragma unroll
    for (int a = 0; a < 2; ++a)
#pragma unroll
        for (int b = 0; b < 2; ++b)
#pragma unroll
            for (int m = 0; m < 4; ++m)
#pragma unroll
                for (int n = 0; n < 2; ++n) acc[a][b][m][n] = (f32x4){0.f, 0.f, 0.f, 0.f};
    bf16x8 At[4][2], B0[2][2], B1[2][2];
    const char* cA = (const char*)g.A + (size_t)cur.pm * tstep; const char* cB = (const char*)g.Bt + (size_t)cur.pn * tstep;
    PG8_STAGE(PG8_SB(0, 0), cB, voffB); PG8_STAGE(PG8_SA(0, 0), cA, voffA); PG8_STAGE(PG8_SB(0, 1), cB + hstep, voffB); PG8_STAGE(PG8_SA(0, 1), cA + hstep, voffA);
    if (wr == 1) PG8_BAR;
    PG8_WAIT_V(4); PG8_BAR;
    PG8_STAGE(PG8_SB(1, 0), cB + kstep, voffB); PG8_STAGE(PG8_SA(1, 0), cA + kstep, voffA); PG8_STAGE(PG8_SB(1, 1), cB + hstep + kstep, voffB);
    PG8_WAIT_V(6); PG8_BAR;
    for (;;) {
        const bool has_next = S.next(ui + 1, nxt);
        const char* nA = has_next ? (const char*)g.A + (size_t)nxt.pm * tstep : cA; const char* nB = has_next ? (const char*)g.Bt + (size_t)nxt.pn * tstep : cB;
        for (int t = 0; t < nt; t += 2) {
            const bool last = (t == nt - 2);
            const char* a1 = cA + (size_t)(t + 1) * kstep;
            const char* a2 = last ? nA : cA + (size_t)(t + 2) * kstep; const char* b2 = last ? nB : cB + (size_t)(t + 2) * kstep;
            const char* a3 = a2 + kstep; const char* b3 = b2 + kstep;
            PG8_LDB(B0, 0, 0); PG8_SCHED; PG8_LDA(At, 0, 0); PG8_STAGE(PG8_SA(1, 1), a1 + hstep, voffA);
            PG8_WAIT_L(8); PG8_BAR; PG8_WAIT_L(0); PG8_MMA(0, 0, At, B0); PG8_BAR; PG8_SCHED;
            PG8_LDB(B1, 0, 1); PG8_STAGE(PG8_SB(0, 0), b2, voffB);
            PG8_BAR; PG8_WAIT_L(0); PG8_MMA(0, 1, At, B1); PG8_BAR;
            PG8_LDA(At, 0, 1); PG8_STAGE(PG8_SA(0, 0), a2, voffA);
            PG8_BAR; PG8_WAIT_L(0); PG8_MMA(1, 0, At, B0); PG8_BAR; PG8_SCHED;
            PG8_STAGE(PG8_SB(0, 1), b2 + hstep, voffB);
            PG8_WAIT_V(6); PG8_BAR; PG8_MMA(1, 1, At, B1); PG8_BAR;
            PG8_LDB(B0, 1, 0); PG8_SCHED; PG8_LDA(At, 1, 0); PG8_STAGE(PG8_SA(0, 1), a2 + hstep, voffA);
            PG8_WAIT_L(8); PG8_BAR; PG8_WAIT_L(0); PG8_MMA(0, 0, At, B0); PG8_BAR; PG8_SCHED;
            PG8_LDB(B1, 1, 1); PG8_STAGE(PG8_SB(1, 0), b3, voffB);
            PG8_BAR; PG8_WAIT_L(0); PG8_MMA(0, 1, At, B1); PG8_BAR;
            PG8_LDA(At, 1, 1); PG8_STAGE(PG8_SA(1, 0), a3, voffA);
            PG8_BAR; PG8_WAIT_L(0); PG8_MMA(1, 0, At, B0); PG8_BAR; PG8_SCHED;
            PG8_STAGE(PG8_SB(1, 1), b3 + hstep, voffB);
            PG8_WAIT_V(6); PG8_BAR; PG8_MMA(1, 1, At, B1); PG8_BAR;
        }
        bool zero_acc = true;
        if constexpr (Epi::CHAIN) zero_acc = E.chain(acc, cur, wr, wc, fr, fq);
        else E(acc, cur, wr, wc, fr, fq);
        if (!has_next) break;
        if (zero_acc)
#pragma unroll
        for (int a = 0; a < 2; ++a)
#pragma unroll
            for (int b = 0; b < 2; ++b)
#pragma unroll
                for (int m = 0; m < 4; ++m)
#pragma unroll
                    for (int n = 0; n < 2; ++n) acc[a][b][m][n] = (f32x4){0.f, 0.f, 0.f, 0.f};
        cur = nxt; cA = nA; cB = nB; ++ui;
    }
    PG8_WAIT_V(0);
    if (wr == 0) PG8_BAR;
    PG8_BAR;
#undef PG8_SA
#undef PG8_SB
#undef PG8_STAGE
#undef PG8_LDA
#undef PG8_LDB
#undef PG8_MMA
#undef PG8_WAIT_V
#undef PG8_WAIT_L
#undef PG8_BAR
#undef PG8_SCHED
}

typedef f32x4 Acc[2][2][4][2];
template <int ACT, int LDC> __device__ __forceinline__ void glu_store(const Acc& acc, char* ub, unsigned lane_off) {
#pragma unroll
    for (int ai = 0; ai < 2; ++ai)
#pragma unroll
        for (int m = 0; m < 4; ++m) {
            char* rp = ub + (size_t)(ai * HALF + m * 16) * LDC * 2;
            f32x4 v[2];
#pragma unroll
            for (int n = 0; n < 2; ++n) { const f32x4 a = acc[ai][0][m][n], b = acc[ai][1][m][n];
                if (ACT == 0) v[n] = a * sigmoid4(a) * b; else v[n] = a * sigmoid4(b); }
            *(u32x4*)(rp + lane_off) = pack8(v[0], v[1]);
        }
}
template <int LDC> __device__ __forceinline__ unsigned lane_off_of(int wr, int wc, int fr, int fq) { return (unsigned)((wr * 64 + fr) * LDC + wc * 32 + 8 * fq) * 2u; }
struct EpiGLU {
    static constexpr bool CHAIN = false;
    bf16_t* O;
    __device__ __forceinline__ void operator()(const Acc& acc, const Unit& u, int wr, int wc, int fr, int fq) const {
        glu_store<0, DFF>(acc, (char*)O + ((size_t)u.pm * BM * DFF + (size_t)u.pn * 128) * 2, lane_off_of<DFF>(wr, wc, fr, fq));
    }
};
template <int ACT, int LDC> __device__ __forceinline__ void plain_store(const Acc& acc, char* ub, unsigned lane_off) {
#pragma unroll
    for (int ai = 0; ai < 2; ++ai)
#pragma unroll
        for (int m = 0; m < 4; ++m) {
            char* rp = ub + (size_t)(ai * HALF + m * 16) * LDC * 2;
#pragma unroll
            for (int bj = 0; bj < 2; ++bj) { f32x4 v0 = acc[ai][bj][m][0], v1 = acc[ai][bj][m][1];
                if (ACT == 1) { v0 = gelu4(v0); v1 = gelu4(v1); }
                if (ACT == 2) { v0 = sigmoid4(v0); v1 = sigmoid4(v1); }
                *(u32x4*)(rp + bj * HALF * 2 + lane_off) = pack8(v0, v1); }
        }
}
struct EpiStore {
    static constexpr bool CHAIN = false;
    bf16_t* O;
    __device__ __forceinline__ void operator()(const Acc& acc, const Unit& u, int wr, int wc, int fr, int fq) const {
        plain_store<0, DM>(acc, (char*)O + ((size_t)u.pm * BM * DM + (size_t)u.pn * BM) * 2, lane_off_of<DM>(wr, wc, fr, fq));
    }
};
struct EpiIn {
    static constexpr bool CHAIN = false;
    bf16_t *ZP, *U, *V, *XG, *GATES;
    __device__ __forceinline__ void operator()(const Acc& acc, const Unit& u, int wr, int wc, int fr, int fq) const {
        const int pn = u.pn; const size_t rb = (size_t)u.pm * BM;
        if (pn >= 10) {
            char* ub = (char*)GATES + rb * 3072 + (size_t)(pn - 10) * 256; const unsigned lo = (unsigned)((wr * 64 + fr) * 3072 + wc * 32 + 8 * fq);
#pragma unroll
            for (int ai = 0; ai < 2; ++ai)
#pragma unroll
                for (int m = 0; m < 4; ++m)
#pragma unroll
                    for (int bj = 0; bj < 2; ++bj) {
                        const f32x4 v0 = sigmoid4(acc[ai][bj][m][0]) * 255.0f, v1 = sigmoid4(acc[ai][bj][m][1]) * 255.0f;
                        u32x2 w; w.x = 0u; w.y = 0u;
                        w.x = __builtin_amdgcn_cvt_pk_u8_f32(v0[0], 0, w.x); w.x = __builtin_amdgcn_cvt_pk_u8_f32(v0[1], 1, w.x); w.x = __builtin_amdgcn_cvt_pk_u8_f32(v0[2], 2, w.x); w.x = __builtin_amdgcn_cvt_pk_u8_f32(v0[3], 3, w.x);
                        w.y = __builtin_amdgcn_cvt_pk_u8_f32(v1[0], 0, w.y); w.y = __builtin_amdgcn_cvt_pk_u8_f32(v1[1], 1, w.y); w.y = __builtin_amdgcn_cvt_pk_u8_f32(v1[2], 2, w.y); w.y = __builtin_amdgcn_cvt_pk_u8_f32(v1[3], 3, w.y);
                        *(u32x2*)(ub + (size_t)(ai * HALF + m * 16) * 3072 + bj * HALF + lo) = w;
                    }
        }
        else {
            const unsigned lo = lane_off_of<512>(wr, wc, fr, fq);
            if (pn >= 6) glu_store<1, 512>(acc, (char*)XG + (rb * 512 + (size_t)(pn - 6) * 128) * 2, lo);
            else if (pn < 2) plain_store<0, 512>(acc, (char*)ZP + (rb * 512 + (size_t)pn * 256) * 2, lo);
            else { char* ub = (char*)(pn < 4 ? U : V) + (rb * 512 + (size_t)(pn & 1) * 256) * 2; plain_store<1, 512>(acc, ub, lo); }
        }
    }
};
struct EpiBranch {
    static constexpr bool CHAIN = true;
    const unsigned char* GATES; bf16_t* MG;
    static __device__ __forceinline__ f32x4 code4(unsigned w) { return (f32x4){__builtin_fmaxf((float)(w & 255u), 0.25f), __builtin_fmaxf((float)((w >> 8) & 255u), 0.25f), __builtin_fmaxf((float)((w >> 16) & 255u), 0.25f), __builtin_fmaxf((float)(w >> 24), 0.25f)}; }
    static __device__ __forceinline__ f32x4 rcp4(f32x4 v) { return (f32x4){__builtin_amdgcn_rcpf(v[0]), __builtin_amdgcn_rcpf(v[1]), __builtin_amdgcn_rcpf(v[2]), __builtin_amdgcn_rcpf(v[3])}; }
    __device__ __forceinline__ bool chain(Acc& acc, const Unit& u, int wr, int wc, int fr, int fq) const {
        const int z = u.pn >> 2, pn = u.pn & 3, pm = u.pm - z * 128;
        const bool fin = (z == 2);
        const char* gb = (const char*)GATES + (size_t)pm * BM * 3072 + (size_t)z * 1024 + (size_t)pn * BM;
        const char* gn = fin ? gb : gb + 1024;
        const unsigned glo = (unsigned)((wr * 64 + fr) * 3072 + wc * 32 + 8 * fq);
        char* mb = (char*)MG + ((size_t)pm * BM * DM + (size_t)pn * BM) * 2;
        const unsigned mlo = lane_off_of<DM>(wr, wc, fr, fq);
        constexpr float q = 1.0f / 255.0f;
        u32x2 g0[2][4][2], g1[2][4][2];
#pragma unroll
        for (int ai = 0; ai < 2; ++ai)
#pragma unroll
            for (int m = 0; m < 4; ++m)
#pragma unroll
                for (int bj = 0; bj < 2; ++bj) {
                    g0[ai][m][bj] = *(const u32x2*)(gb + (size_t)(ai * HALF + m * 16) * 3072 + bj * HALF + glo);
                    g1[ai][m][bj] = *(const u32x2*)(gn + (size_t)(ai * HALF + m * 16) * 3072 + bj * HALF + glo);
                }
#pragma unroll
        for (int ai = 0; ai < 2; ++ai)
#pragma unroll
            for (int m = 0; m < 4; ++m)
#pragma unroll
                for (int bj = 0; bj < 2; ++bj) {
                    const f32x4 d0 = rcp4(code4(g1[ai][m][bj].x)), d1 = rcp4(code4(g1[ai][m][bj].y));
                    acc[ai][bj][m][0] *= code4(g0[ai][m][bj].x) * (fin ? (f32x4){q, q, q, q} : d0);
                    acc[ai][bj][m][1] *= code4(g0[ai][m][bj].y) * (fin ? (f32x4){q, q, q, q} : d1);
                    if (fin) *(u32x4*)(mb + (size_t)(ai * HALF + m * 16) * DM * 2 + bj * HALF * 2 + mlo) = pack8(acc[ai][bj][m][0], acc[ai][bj][m][1]);
                }
        return fin;
    }
};
struct EpiPle {
    static constexpr bool CHAIN = false;
    const bf16_t* E; bf16_t* O;
    __device__ __forceinline__ void operator()(const Acc& acc, const Unit& u, int wr, int wc, int fr, int fq) const {
        const size_t uo = ((size_t)u.pm * BM * DM + (size_t)u.pn * BM) * 2;
        const char* eb = (const char*)E + uo; char* ob = (char*)O + uo;
        const unsigned lo = lane_off_of<DM>(wr, wc, fr, fq);
#pragma unroll
        for (int ai = 0; ai < 2; ++ai) {
            u32x4 ew[4][2];
#pragma unroll
            for (int m = 0; m < 4; ++m)
#pragma unroll
                for (int bj = 0; bj < 2; ++bj) ew[m][bj] = *(const u32x4*)(eb + (size_t)(ai * HALF + m * 16) * DM * 2 + bj * HALF * 2 + lo);
#pragma unroll
            for (int m = 0; m < 4; ++m)
#pragma unroll
                for (int bj = 0; bj < 2; ++bj) {
                    const f32x4 v0 = sigmoid4(acc[ai][bj][m][0]) * unpack_lo4(ew[m][bj]), v1 = sigmoid4(acc[ai][bj][m][1]) * unpack_hi4(ew[m][bj]);
                    *(u32x4*)(ob + (size_t)(ai * HALF + m * 16) * DM * 2 + bj * HALF * 2 + lo) = pack8(v0, v1);
                }
            asm volatile("" ::: "memory");
        }
    }
};
}

template <bool INIT>
__device__ __forceinline__ void row_phase(const float* hin, float* h, const bf16_t* F, float cscale, const float* ga, const float* gb, bf16_t* HN, bool write_hn, const int tid, const int bid) {
    const int wid = tid >> 6, lane = tid & 63;
    constexpr int R = 4;
    f32x4 gav[4], gbv[4];
#pragma unroll
    for (int k = 0; k < 4; ++k) {
        gav[k] = INIT ? (f32x4){0.f, 0.f, 0.f, 0.f} : *(const f32x4*)(ga + 256 * k + 4 * lane);
        gbv[k] = write_hn ? *(const f32x4*)(gb + 256 * k + 4 * lane) : (f32x4){0.f, 0.f, 0.f, 0.f};
    }
    for (int row0 = (bid * 8 + wid) * R; row0 < MTOK; row0 += gridDim.x * 8 * R) {
        f32x4 hv[R][4]; u32x2 fw[R][4];
#pragma unroll
        for (int r = 0; r < R; ++r) { const size_t ro = (size_t)(row0 + r) * DM + 4 * lane;
#pragma unroll
            for (int k = 0; k < 4; ++k) {
                hv[r][k] = *(const f32x4*)(hin + ro + 256 * k);
                if (!INIT) fw[r][k] = *(const u32x2*)(F + ro + 256 * k);
            } }
#pragma unroll
        for (int r = 0; r < R; ++r) { const size_t ro = (size_t)(row0 + r) * DM + 4 * lane;
            if (!INIT) {
                f32x4 fv[4];
#pragma unroll
                for (int k = 0; k < 4; ++k) fv[k] = (f32x4){bf_lo(fw[r][k].x), bf_hi(fw[r][k].x), bf_lo(fw[r][k].y), bf_hi(fw[r][k].y)};
                float ss = 0.f;
#pragma unroll
                for (int i = 0; i < 4; ++i) ss += fv[i][0] * fv[i][0] + fv[i][1] * fv[i][1] + fv[i][2] * fv[i][2] + fv[i][3] * fv[i][3];
                ss = wave_sum(ss);
                const float rs = cscale * __builtin_amdgcn_rsqf(ss * (1.0f / DM) + EPS);
#pragma unroll
                for (int i = 0; i < 4; ++i) hv[r][i] += fv[i] * gav[i] * rs;
            }
            float s2 = 0.f;
#pragma unroll
            for (int i = 0; i < 4; ++i) s2 += hv[r][i][0] * hv[r][i][0] + hv[r][i][1] * hv[r][i][1] + hv[r][i][2] * hv[r][i][2] + hv[r][i][3] * hv[r][i][3];
            s2 = wave_sum(s2);
            const float rs2 = __builtin_amdgcn_rsqf(s2 * (1.0f / DM) + EPS);
            if (!INIT) { _Pragma("unroll") for (int k = 0; k < 4; ++k) *(f32x4*)(h + ro + 256 * k) = hv[r][k]; }
            if (write_hn) {
#pragma unroll
                for (int k = 0; k < 4; ++k) { const f32x4 o = hv[r][k] * gbv[k] * rs2; u32x2 w; w.x = cvt_pk_bf16(o[0], o[1]); w.y = cvt_pk_bf16(o[2], o[3]); *(u32x2*)(HN + ro + 256 * k) = w; }
            }
        }
    }
}

__device__ __forceinline__ f32x4 bf4(u32x2 w) { return (f32x4){bf_lo(w.x), bf_hi(w.x), bf_lo(w.y), bf_hi(w.y)}; }
__device__ __forceinline__ float sumsq16(const f32x4 (&v)[4]) { float s = 0.f;
#pragma unroll
    for (int i = 0; i < 4; ++i) s += v[i][0] * v[i][0] + v[i][1] * v[i][1] + v[i][2] * v[i][2] + v[i][3] * v[i][3];
    return s; }
template <bool FULL>
__device__ __forceinline__ void row_phase2(const float* hin, float* h, const bf16_t* F1, float c1, const float* ga1, const bf16_t* F2, float c2, const float* ga2, const float* gb, bf16_t* HN, bool write_hn, const int tid, const int bid) {
    const int wid = tid >> 6, lane = tid & 63;
    constexpr int R = FULL ? 2 : 4;
    f32x4 g1v[4], g2v[4], gbv[4];
#pragma unroll
    for (int k = 0; k < 4; ++k) {
        g1v[k] = *(const f32x4*)(ga1 + 256 * k + 4 * lane);
        g2v[k] = FULL ? *(const f32x4*)(ga2 + 256 * k + 4 * lane) : (f32x4){0.f, 0.f, 0.f, 0.f};
        gbv[k] = write_hn ? *(const f32x4*)(gb + 256 * k + 4 * lane) : (f32x4){0.f, 0.f, 0.f, 0.f};
    }
    for (int row0 = (bid * 8 + wid) * R; row0 < MTOK; row0 += gridDim.x * 8 * R) {
        f32x4 hv[R][4]; u32x2 fa[R][4], fb[R][4];
#pragma unroll
        for (int r = 0; r < R; ++r) { const size_t ro = (size_t)(row0 + r) * DM + 4 * lane;
#pragma unroll
            for (int k = 0; k < 4; ++k) {
                hv[r][k] = *(const f32x4*)(hin + ro + 256 * k);
                fa[r][k] = *(const u32x2*)(F1 + ro + 256 * k);
                if (FULL) fb[r][k] = *(const u32x2*)(F2 + ro + 256 * k);
            } }
#pragma unroll
        for (int r = 0; r < R; ++r) { const size_t ro = (size_t)(row0 + r) * DM + 4 * lane;
            {
                f32x4 fv[4];
#pragma unroll
                for (int k = 0; k < 4; ++k) fv[k] = bf4(fa[r][k]);
                const float rs = c1 * __builtin_amdgcn_rsqf(wave_sum(sumsq16(fv)) * (1.0f / DM) + EPS);
#pragma unroll
                for (int i = 0; i < 4; ++i) hv[r][i] += fv[i] * g1v[i] * rs;
            }
            if (FULL) {
                f32x4 fv[4];
#pragma unroll
                for (int k = 0; k < 4; ++k) fv[k] = bf4(fb[r][k]);
                const float rs = c2 * __builtin_amdgcn_rsqf(wave_sum(sumsq16(fv)) * (1.0f / DM) + EPS);
#pragma unroll
                for (int i = 0; i < 4; ++i) hv[r][i] += fv[i] * g2v[i] * rs;
#pragma unroll
                for (int k = 0; k < 4; ++k) *(f32x4*)(h + ro + 256 * k) = hv[r][k];
            }
            if (write_hn) {
                const float rs2 = __builtin_amdgcn_rsqf(wave_sum(sumsq16(hv[r])) * (1.0f / DM) + EPS);
#pragma unroll
                for (int k = 0; k < 4; ++k) { const f32x4 o = hv[r][k] * gbv[k] * rs2; u32x2 w; w.x = cvt_pk_bf16(o[0], o[1]); w.y = cvt_pk_bf16(o[2], o[3]); *(u32x2*)(HN + ro + 256 * k) = w; }
            }
        }
    }
}

struct PrepJob { const float* src; bf16_t* dst; int ld, col0, k0, K, n0; };
__device__ __forceinline__ PrepJob prep_job(const Params& P, unsigned char* ws, int l, int tix) {
    constexpr int T_GU = (NGU / 64) * (DM / 64), T_D = (DM / 64) * (DFF / 64), T_IN = (NIN / 64) * (DM / 64), T_BR = (DM / 64) * (512 / 64), T_SQ = (DM / 64) * (DM / 64);
    int t = tix; const float* srcA; const float* srcB; int ld, mode, K; bf16_t* dst;
    if (t < T_GU) { srcA = PIN(3) + (size_t)l * DM * DFF; srcB = PIN(4) + (size_t)l * DM * DFF; ld = DFF; mode = 1; K = DM; dst = (bf16_t*)(ws + WS_WGU1); }
    else if ((t -= T_GU) < T_GU) { srcA = PIN(25) + (size_t)l * DM * DFF; srcB = PIN(26) + (size_t)l * DM * DFF; ld = DFF; mode = 1; K = DM; dst = (bf16_t*)(ws + WS_WGU2); }
    else if ((t -= T_GU) < T_D) { srcA = PIN(5) + (size_t)l * DFF * DM; srcB = srcA; ld = DM; mode = 0; K = DFF; dst = (bf16_t*)(ws + WS_WD1); }
    else if ((t -= T_D) < T_D) { srcA = PIN(27) + (size_t)l * DFF * DM; srcB = srcA; ld = DM; mode = 0; K = DFF; dst = (bf16_t*)(ws + WS_WD2); }
    else if ((t -= T_D) < T_IN) { srcA = PIN(8) + (size_t)l * DM * NIN; srcB = srcA; ld = NIN; mode = 2; K = DM; dst = (bf16_t*)(ws + WS_WIN); }
    else if ((t -= T_IN) < T_BR) { srcA = PIN(16) + (size_t)l * 512 * DM; srcB = srcA; ld = DM; mode = 0; K = 512; dst = (bf16_t*)(ws + WS_WBR) + (size_t)1 * DM * 512; }
    else if ((t -= T_BR) < T_BR) { srcA = PIN(21) + (size_t)l * 512 * DM; srcB = srcA; ld = DM; mode = 0; K = 512; dst = (bf16_t*)(ws + WS_WBR) + (size_t)2 * DM * 512; }
    else if ((t -= T_BR) < T_SQ) { srcA = PIN(22) + (size_t)l * DM * DM; srcB = srcA; ld = DM; mode = 0; K = DM; dst = (bf16_t*)(ws + WS_WOUT); }
    else if ((t -= T_SQ) < T_SQ) { srcA = PIN(31) + (size_t)l * DM * DM; srcB = srcA; ld = DM; mode = 0; K = DM; dst = (bf16_t*)(ws + WS_WPG); }
    else { t -= T_SQ; srcA = PIN(29) + (size_t)l * PLE * DM; srcB = srcA; ld = DM; mode = 0; K = PLE; dst = (bf16_t*)(ws + WS_WPP); }
    const int tk = K / 64, tn = t / tk, tkk = t - tn * tk, n0 = tn * 64, k0 = tkk * 64;
    const float* src = srcA; int col0 = n0;
    if (mode == 1) { const int tt = n0 >> 8, j = n0 & 255; if (j < 128) { col0 = 128 * tt + j; } else { src = srcB; col0 = 128 * tt + j - 128; } }
    else if (mode == 2) { if (n0 >= 1536 && n0 < 2560) { const int tt = (n0 - 1536) >> 8, j = (n0 - 1536) & 255; col0 = (j < 128) ? (1536 + 128 * tt + j) : (2048 + 128 * tt + j - 128); } }
    PrepJob J; J.src = src; J.dst = dst; J.ld = ld; J.col0 = col0; J.k0 = k0; J.K = K; J.n0 = n0; return J;
}

__device__ __forceinline__ void prep_weights(const Params& P, unsigned char* ws, int l, LAS unsigned char* lds, const int tid, const int bid) {
    LAS float* tile = (LAS float*)lds;
    constexpr int T_GU = (NGU / 64) * (DM / 64), T_D = (DM / 64) * (DFF / 64), T_IN = (NIN / 64) * (DM / 64), T_BR = (DM / 64) * (512 / 64), T_SQ = (DM / 64) * (DM / 64), T_PP = (DM / 64) * (PLE / 64);
    constexpr int TOTAL = 2 * T_GU + 2 * T_D + T_IN + 2 * T_BR + 2 * T_SQ + T_PP;
    {
        const int kk = tid >> 4, c4 = tid & 15, n = tid >> 3, k8 = tid & 7;
        f32x4 v0, v1; int tix = bid;
        if (tix < TOTAL) { const PrepJob J = prep_job(P, ws, l, tix); const float* sp = J.src + (size_t)(J.k0 + kk) * J.ld + J.col0 + 4 * c4; v0 = *(const f32x4*)sp; v1 = *(const f32x4*)(sp + (size_t)32 * J.ld); }
        for (; tix < TOTAL; tix += gridDim.x) {
            const PrepJob J = prep_job(P, ws, l, tix);
#pragma unroll
            for (int e = 0; e < 4; ++e) { tile[kk * 65 + 4 * c4 + e] = v0[e]; tile[(kk + 32) * 65 + 4 * c4 + e] = v1[e]; }
            __syncthreads();
            const int nx = tix + gridDim.x;
            if (nx < TOTAL) { const PrepJob Jn = prep_job(P, ws, l, nx); const float* sp = Jn.src + (size_t)(Jn.k0 + kk) * Jn.ld + Jn.col0 + 4 * c4; v0 = *(const f32x4*)sp; v1 = *(const f32x4*)(sp + (size_t)32 * Jn.ld); }
            float v[8];
#pragma unroll
            for (int i = 0; i < 8; ++i) v[i] = tile[(8 * k8 + i) * 65 + n];
            u32x4 w; w.x = cvt_pk_bf16(v[0], v[1]); w.y = cvt_pk_bf16(v[2], v[3]); w.z = cvt_pk_bf16(v[4], v[5]); w.w = cvt_pk_bf16(v[6], v[7]);
            *(u32x4*)(J.dst + (size_t)(J.n0 + n) * J.K + J.k0 + 8 * k8) = w;
            __syncthreads();
        }
    }
    {
        const float* pw = PIN(9) + (size_t)l * 4 * 128 * 128; const float* sc = PIN(10) + (size_t)l * 512; const float* wpo = PIN(11) + (size_t)l * 512 * DM;
        bf16_t* dst = (bf16_t*)(ws + WS_WBR);
        const int ol = tid & 63, i4 = __builtin_amdgcn_readfirstlane(tid >> 6);
        for (int tix = bid; tix < 16 * 16; tix += gridDim.x) {
            const int o = (tix >> 4) * 64 + ol, g = (tix >> 2) & 3, i0 = (tix & 3) * 32 + i4 * 4;
            float a[4] = {0.f, 0.f, 0.f, 0.f};
#pragma unroll 4
            for (int j = 0; j < 128; j += 4) {
                const f32x4 s4 = *(const f32x4*)(sc + g * 128 + j);
                float w[4];
#pragma unroll
                for (int jj = 0; jj < 4; ++jj) w[jj] = wpo[(size_t)(g * 128 + j + jj) * DM + o] * s4[jj];
#pragma unroll
                for (int ii = 0; ii < 4; ++ii) { const f32x4 p4 = *(const f32x4*)(pw + (size_t)(g * 128 + i0 + ii) * 128 + j);
                    a[ii] += p4[0] * w[0] + p4[1] * w[1] + p4[2] * w[2] + p4[3] * w[3]; }
            }
            u32x2 w2; w2.x = cvt_pk_bf16(a[0], a[1]); w2.y = cvt_pk_bf16(a[2], a[3]);
            *(u32x2*)(dst + (size_t)o * 512 + g * 128 + i0) = w2;
        }
    }
    {
        const float* wsrc = PIN(14) + (size_t)l * 4 * 128 * 128; bf16_t* dst = (bf16_t*)(ws + WS_WSPK);
        for (int idx = bid * 512 + tid; idx < 4 * 128 * 128 / 8; idx += gridDim.x * 512) {
            const int fq = idx & 3, kk = (idx >> 2) & 3, t = (idx >> 4) & 127, h = idx >> 11;
            float v[8];
#pragma unroll
            for (int i = 0; i < 8; ++i) { const int sp = 32 * kk + 4 * i + fq; v[i] = (sp <= t) ? wsrc[(size_t)(h * 128 + t) * 128 + sp] : 0.f; }
            u32x4 w4; w4.x = cvt_pk_bf16(v[0], v[1]); w4.y = cvt_pk_bf16(v[2], v[3]); w4.z = cvt_pk_bf16(v[4], v[5]); w4.w = cvt_pk_bf16(v[6], v[7]);
            *(u32x4*)(dst + (size_t)idx * 8) = w4;
        }
    }
}

__device__ __forceinline__ void convert_p(const float* p, bf16_t* PB, const int tid, const int bid) {
    for (size_t idx = (size_t)bid * 512 + tid; idx < (size_t)MTOK * PLE / 8; idx += (size_t)gridDim.x * 512) {
        const f32x4 a = *(const f32x4*)(p + idx * 8), b = *(const f32x4*)(p + idx * 8 + 4);
        *(u32x4*)(PB + idx * 8) = pack8(a, b);
    }
}

__device__ __forceinline__ void mixer_phase(const Params& P, unsigned char* ws, int l, LAS unsigned char* lds, const int tid, const int bid) {
    unsigned char* big = ws + WS_BIG;
    const bf16_t* ZP = (const bf16_t*)(big + BIG_ZP); const bf16_t* U = (const bf16_t*)(big + BIG_U); const bf16_t* V = (const bf16_t*)(big + BIG_V); const bf16_t* XG = (const bf16_t*)(big + BIG_XG);
    bf16_t* X3 = (bf16_t*)(big + BIG_X3);
    const int wid = __builtin_amdgcn_readfirstlane(tid >> 6), lane = tid & 63;

    {
        const float* lng = PIN(12) + (size_t)l * 512; const float* lnb = PIN(13) + (size_t)l * 512; const float* bsp = PIN(15) + (size_t)l * 4 * 128;
        const bf16_t* WSPK = (const bf16_t*)(ws + WS_WSPK);
        bf16_t* XS = X3 + (size_t)1 * MTOK * 512;
        const int fr = lane & 15, fq = lane >> 4, h = wid >> 1, th = wid & 1;
        constexpr int VP = 528;
        for (int ch = bid; ch < MTOK / 128; ch += gridDim.x) {
            const size_t tok0 = (size_t)ch * 128;
            {
                const f32x4 g0 = *(const f32x4*)(lng + 8 * lane), g1 = *(const f32x4*)(lng + 8 * lane + 4), b0 = *(const f32x4*)(lnb + 8 * lane), b1 = *(const f32x4*)(lnb + 8 * lane + 4);
#pragma unroll
                for (int i0 = 0; i0 < 16; i0 += 8) {
                    u32x4 wv[8];
#pragma unroll
                    for (int i = 0; i < 8; ++i) wv[i] = *(const u32x4*)(V + (tok0 + wid * 16 + i0 + i) * 512 + 8 * lane);
#pragma unroll
                    for (int i = 0; i < 8; ++i) {
                        const int sp = wid * 16 + i0 + i;
                        f32x4 x0 = unpack_lo4(wv[i]), x1 = unpack_hi4(wv[i]);
                        float s = (x0[0] + x0[1]) + (x0[2] + x0[3]) + (x1[0] + x1[1]) + (x1[2] + x1[3]);
                        s = wave_sum(s); const float mu = s * (1.0f / 512.0f);
                        x0 -= mu; x1 -= mu;
                        float q = x0[0] * x0[0] + x0[1] * x0[1] + x0[2] * x0[2] + x0[3] * x0[3] + x1[0] * x1[0] + x1[1] * x1[1] + x1[2] * x1[2] + x1[3] * x1[3];
                        q = wave_sum(q); const float rs = __builtin_amdgcn_rsqf(q * (1.0f / 512.0f) + EPS);
                        x0 = x0 * rs * g0 + b0; x1 = x1 * rs * g1 + b1;
                        *(LAS u32x4*)(lds + (size_t)sp * (VP * 2) + 16 * lane) = pack8(x0, x1);
                    }
                }
            }
            __syncthreads();
            {
                bf16x8 Wf[4][4]; float bs[4];
#pragma unroll
                for (int m = 0; m < 4; ++m) { const int t = 64 * th + 16 * m + fr; bs[m] = bsp[h * 128 + t];
#pragma unroll
                    for (int kk = 0; kk < 4; ++kk) Wf[m][kk] = *(const bf16x8*)(WSPK + ((size_t)((h * 128 + t) * 4 + kk) * 4 + fq) * 8); }
                const size_t ubase = (tok0 + 64 * th + fr) * 512 + 128 * h + 4 * fq;
                u32x2 uw[2][4];
#pragma unroll
                for (int m = 0; m < 4; ++m) uw[0][m] = *(const u32x2*)(U + ubase + (size_t)(16 * m) * 512);
#pragma unroll
                for (int n = 0; n < 8; ++n) {
                    if (n + 1 < 8) {
#pragma unroll
                        for (int m = 0; m < 4; ++m) uw[(n + 1) & 1][m] = *(const u32x2*)(U + ubase + (size_t)(16 * m) * 512 + 16 * (n + 1));
                    }
                    f32x4 acc[4];
#pragma unroll
                    for (int m = 0; m < 4; ++m) acc[m] = (f32x4){0.f, 0.f, 0.f, 0.f};
#pragma unroll
                    for (int kk = 0; kk < 4; ++kk) {
                        bf16x8 X;
#pragma unroll
                        for (int i = 0; i < 8; ++i) X[i] = *(const LAS short*)(lds + (size_t)(32 * kk + 4 * i + fq) * (VP * 2) + 2 * (128 * h + 16 * n + fr));
#pragma unroll
                        for (int m = 0; m < 4; ++m) acc[m] = __builtin_amdgcn_mfma_f32_16x16x32_bf16(X, Wf[m][kk], acc[m], 0, 0, 0);
                    }
#pragma unroll
                    for (int m = 0; m < 4; ++m) {
                        const u32x2 u2 = uw[n & 1][m];
                        const f32x4 sv = acc[m] + bs[m];
                        u32x2 o; o.x = cvt_pk_bf16(bf_lo(u2.x) * sv[0], bf_hi(u2.x) * sv[1]); o.y = cvt_pk_bf16(bf_lo(u2.y) * sv[2], bf_hi(u2.y) * sv[3]);
                        *(u32x2*)(XS + ubase + (size_t)(16 * m) * 512 + 16 * n) = o;
                    }
                }
            }
            __syncthreads();
        }
    }

    {
        const float* dwk = PIN(17) + (size_t)l * 31 * 512; const float* dwb = PIN(18) + (size_t)l * 512; const float* lng = PIN(19) + (size_t)l * 512; const float* lnb = PIN(20) + (size_t)l * 512;
        bf16_t* XC = X3 + (size_t)2 * MTOK * 512;
        LAS unsigned char* xs = lds;
        LAS float* ys = (LAS float*)(lds + 65536);
        const int c = tid; float wk[31];
#pragma unroll
        for (int k = 0; k < 31; ++k) wk[k] = dwk[k * 512 + c];
        const float bias = dwb[c];
        const f32x4 g0 = *(const f32x4*)(lng + 8 * lane), g1 = *(const f32x4*)(lng + 8 * lane + 4), b0 = *(const f32x4*)(lnb + 8 * lane), b1 = *(const f32x4*)(lnb + 8 * lane + 4);
        u32x4 pre[8];
#define CONV_LOAD(ct_) do { const int tok0_ = (ct_) * 32, t0_ = tok0_ & (SEQ - 1); _Pragma("unroll") for (int i = 0; i < 8; ++i) { const int idx = tid + 512 * i; const int r = idx >> 6, c8 = idx & 63; \
            pre[i] = (u32x4){0u, 0u, 0u, 0u}; if (idx < 62 * 64 && t0_ - 30 + r >= 0) pre[i] = *(const u32x4*)(XG + (size_t)(tok0_ - 30 + r) * 512 + 8 * c8); } } while (0)
        int ct = bid;
        if (ct < MTOK / 32) CONV_LOAD(ct);
        for (; ct < MTOK / 32; ct += gridDim.x) {
            const int tok0 = ct * 32;
#pragma unroll
            for (int i = 0; i < 8; ++i) { const int idx = tid + 512 * i; if (idx < 62 * 64) *(LAS u32x4*)(xs + (idx >> 6) * 1024 + 16 * (idx & 63)) = pre[i]; }
            __syncthreads();
            if (ct + (int)gridDim.x < MTOK / 32) CONV_LOAD(ct + gridDim.x);
#pragma unroll
            for (int hb = 0; hb < 2; ++hb) {
                float x[46];
#pragma unroll
                for (int r = 0; r < 46; ++r) x[r] = __uint_as_float(((unsigned)*(const LAS unsigned short*)(xs + (16 * hb + r) * 1024 + 2 * c)) << 16);
#pragma unroll
                for (int t = 0; t < 16; ++t) { float y = bias;
#pragma unroll
                    for (int k = 0; k < 31; ++k) y += wk[k] * x[t + k];
                    ys[(16 * hb + t) * 512 + c] = y; }
            }
            __syncthreads();
#pragma unroll
            for (int i = 0; i < 4; ++i) { const int t = wid * 4 + i;
                f32x4 x0 = *(const LAS f32x4*)(ys + t * 512 + 8 * lane), x1 = *(const LAS f32x4*)(ys + t * 512 + 8 * lane + 4);
                float s = (x0[0] + x0[1]) + (x0[2] + x0[3]) + (x1[0] + x1[1]) + (x1[2] + x1[3]);
                s = wave_sum(s); const float mu = s * (1.0f / 512.0f);
                x0 -= mu; x1 -= mu;
                float q = x0[0] * x0[0] + x0[1] * x0[1] + x0[2] * x0[2] + x0[3] * x0[3] + x1[0] * x1[0] + x1[1] * x1[1] + x1[2] * x1[2] + x1[3] * x1[3];
                q = wave_sum(q); const float rs = __builtin_amdgcn_rsqf(q * (1.0f / 512.0f) + EPS);
                x0 = x0 * rs * g0 + b0; x1 = x1 * rs * g1 + b1;
                x0 = x0 * sigmoid4(x0); x1 = x1 * sigmoid4(x1);
                *(u32x4*)(XC + (size_t)(tok0 + t) * 512 + 8 * lane) = pack8(x0, x1); }
            __syncthreads();
        }
#undef CONV_LOAD
    }

    {
        bf16_t* XP = X3;
        const int g = wid & 3, w = 2 << g, oct = g * 16 + (lane & 15), sub = (wid >> 2) * 4 + (lane >> 4);
        for (int it = bid; it < MTOK / 32; it += gridDim.x) {
            f32x4 s0[4], s1[4], c0[4], c1[4];
#pragma unroll
            for (int u = 0; u < 4; ++u) { s0[u] = (f32x4){0.f, 0.f, 0.f, 0.f}; s1[u] = s0[u]; c0[u] = s0[u]; c1[u] = s0[u]; }
            for (int j0 = 0; j0 < w; j0 += 4) {
                u32x4 wv[4][4];
#pragma unroll
                for (int jj = 0; jj < 4; ++jj)
#pragma unroll
                    for (int u = 0; u < 4; ++u) { const int j = j0 + jj, tok = it * 32 + 8 * u + sub, t = tok & (SEQ - 1); wv[jj][u] = (u32x4){0u, 0u, 0u, 0u};
                        if (j < w && j <= t) wv[jj][u] = *(const u32x4*)(ZP + (size_t)(tok - j) * 512 + 8 * oct); }
#pragma unroll
                for (int jj = 0; jj < 4; ++jj)
#pragma unroll
                    for (int u = 0; u < 4; ++u) { const f32x4 a = unpack_lo4(wv[jj][u]), b = unpack_hi4(wv[jj][u]); s0[u] += a; s1[u] += b; if (j0 + jj == 0) { c0[u] = a; c1[u] = b; } }
            }
#pragma unroll
            for (int u = 0; u < 4; ++u) { const int tok = it * 32 + 8 * u + sub, t = tok & (SEQ - 1);
                const float inv = 1.0f / (float)((t + 1) < w ? (t + 1) : w);
                *(u32x4*)(XP + (size_t)tok * 512 + 8 * oct) = pack8(s0[u] * inv - c0[u], s1[u] * inv - c1[u]); }
        }
    }
}

#define XB_TMO      128
#define XB_XCNT(j)  (256  + 64 * (j))
#define XB_XSUB(j)  (1280 + 64 * (j))
#define XB_XGEN(j)  (2304 + 64 * (j))
#define XB_TOP      3328
#define XB_TOPGEN   3392
#define XCD_BAR_WORDS 3456
#define XB_SPIN_CAP (1u << 18)
__device__ __forceinline__ unsigned xb_ld(unsigned* p)              { return __hip_atomic_load(p, __ATOMIC_RELAXED, __HIP_MEMORY_SCOPE_AGENT); }
__device__ __forceinline__ unsigned xb_add(unsigned* p, unsigned v) { return __hip_atomic_fetch_add(p, v, __ATOMIC_RELAXED, __HIP_MEMORY_SCOPE_AGENT); }
__device__ __forceinline__ unsigned xb_xcc_id() { return (unsigned)__builtin_amdgcn_s_getreg((3 << 11) | 20) & 0xFu; }
#define XB_SPIN(cond, bar) do { unsigned _sp = 0; while (cond) { __builtin_amdgcn_s_sleep(1); \
    if ((++_sp & 255u) == 0u) { if (xb_ld(&(bar)[XB_TMO])) break; if (_sp > XB_SPIN_CAP) { atomicAdd(&(bar)[XB_TMO], 1u); break; } } } } while (0)
struct XcdBarrier { unsigned* bar; unsigned x; volatile LAS unsigned* st; };
__device__ __forceinline__ XcdBarrier xcd_barrier_post(unsigned* bar, volatile LAS unsigned* st) {
    XcdBarrier b; b.bar = bar; b.x = xb_xcc_id(); b.st = st;
    if (threadIdx.x == 0) (void)xb_add(&bar[XB_XCNT(b.x)], 1u);
    return b;
}
__device__ __forceinline__ void xcd_barrier_complete(unsigned* bar, unsigned x, unsigned& nloc, unsigned& nx) {
    const unsigned G = gridDim.x * gridDim.y * gridDim.z;
    unsigned sum, cnt, mine, sp = 0u;
    for (;;) {
        sum = 0u; cnt = 0u; mine = 0u;
#pragma unroll
        for (unsigned j = 0; j < 16; ++j) { const unsigned c = xb_ld(&bar[XB_XCNT(j)]); sum += c; cnt += (c > 0u) ? 1u : 0u; mine = (j == x) ? c : mine; }
        if (sum == G) break;
        __builtin_amdgcn_s_sleep(1);
        if ((++sp & 255u) == 0u) { if (xb_ld(&bar[XB_TMO])) break; if (sp > XB_SPIN_CAP) { atomicAdd(&bar[XB_TMO], 1u); break; } }
    }
    nloc = mine > 0u ? mine : 1u; nx = cnt > 0u ? cnt : 1u;
}
__device__ __forceinline__ void xcd_barrier(const XcdBarrier& b) {
    asm volatile("s_waitcnt vmcnt(0)" ::: "memory");
    __syncthreads();
    if (threadIdx.x == 0) {
        unsigned* bar = b.bar;
        __builtin_amdgcn_s_waitcnt(0);
        unsigned nloc = b.st[0], nx = b.st[1];
        if (nloc == 0u) { xcd_barrier_complete(bar, b.x, nloc, nx); b.st[0] = nloc; b.st[1] = nx; }
        const unsigned old = xb_add(&bar[XB_XSUB(b.x)], 1u);
        const unsigned gen = old / nloc;
        if (old + 1u == (gen + 1u) * nloc) {
            __builtin_amdgcn_fence(__ATOMIC_RELEASE, "agent");
            asm volatile("s_waitcnt vmcnt(0)" ::: "memory");
            const unsigned og = xb_add(&bar[XB_TOP], 1u);
            const unsigned tg = og / nx;
            if (og + 1u == (tg + 1u) * nx) xb_add(&bar[XB_TOPGEN], 1u);
            else XB_SPIN(xb_ld(&bar[XB_TOPGEN]) == tg, bar);
            __builtin_amdgcn_fence(__ATOMIC_ACQUIRE, "agent");
            xb_add(&bar[XB_XGEN(b.x)], 1u);
            asm volatile("s_waitcnt vmcnt(0)" ::: "memory");
        } else {
            XB_SPIN(xb_ld(&bar[XB_XGEN(b.x)]) == gen, bar);
            __builtin_amdgcn_fence(__ATOMIC_ACQUIRE, "agent");
            asm volatile("s_waitcnt vmcnt(0)" ::: "memory");
        }
    }
    __syncthreads();
}

__device__ __forceinline__ void run_phase(const Params& P, int ph, LAS unsigned char* lds, const float rmul = 1.0f, const bool row_only = false) {
    GAS unsigned char* wsg = P.ws; GAS float* outg = P.out; int tid = threadIdx.x, bid = blockIdx.x;
    asm volatile("" : "+s"(wsg), "+s"(outg), "+v"(tid), "+s"(bid));
    unsigned char* ws = (unsigned char*)wsg; float* out = (float*)outg;
    unsigned char* big = ws + WS_BIG;
    bf16_t* HN = (bf16_t*)(ws + WS_HN); bf16_t* F = (bf16_t*)(ws + WS_F); bf16_t* F2 = (bf16_t*)(ws + WS_F2);
    const int G = gridDim.x, c = bid;
    constexpr unsigned PM = PHASE_MASK;
    if (ph == 0) {
        if (!(PM & (1u << 13))) return;
        prep_weights(P, ws, 0, lds, tid, bid);
        row_phase<true>(PIN(0), out, nullptr, 0.f, nullptr, PIN(2), HN, true, tid, bid);
        return;
    }
    const int l = (ph - 1) / 13, sub = (ph - 1) % 13;
    pg8::Order S;
    switch (sub) {
    case 0: case 8: if (PM & 1u) {
        pg8::Gemm g{HN, (const bf16_t*)(ws + (sub == 0 ? WS_WGU1 : WS_WGU2)), MTOK, NGU, DM}; S.init(MTOK, NGU, G, c, 1);
        pg8::EpiGLU E{(bf16_t*)(big + BIG_ACT)};
        pg8::gemm_phase(lds, g, S, E, tid);
        if (sub == 8) {
            pg8::Gemm g2{(const bf16_t*)(big + BIG_PB), (const bf16_t*)(ws + WS_WPP), MTOK, DM, PLE}; S.init(MTOK, DM, G, c, 1);
            pg8::EpiStore E2{(bf16_t*)(big + BIG_E)};
            pg8::gemm_phase(lds, g2, S, E2, tid);
        }
    } break;
    case 1: case 9: if (PM & 2u) {
        pg8::Gemm g{(const bf16_t*)(big + BIG_ACT), (const bf16_t*)(ws + (sub == 1 ? WS_WD1 : WS_WD2)), MTOK, DM, DFF}; S.init(MTOK, DM, G, c, 1);
        pg8::EpiStore E{F};
        pg8::gemm_phase(lds, g, S, E, tid);
    } break;
    case 2: if (PM & 4u) row_phase2<false>(l == 0 ? PIN(0) : (const float*)out, out, F, 0.5f, PIN(6) + l * DM, nullptr, 0.f, nullptr, PIN(7) + l * DM, HN, true, tid, bid); break;
    case 3: if (PM & 8u) {
        pg8::Gemm g{HN, (const bf16_t*)(ws + WS_WIN), MTOK, NIN, DM}; S.init(MTOK, NIN, G, c, 1);
        pg8::EpiIn E{(bf16_t*)(big + BIG_ZP), (bf16_t*)(big + BIG_U), (bf16_t*)(big + BIG_V), (bf16_t*)(big + BIG_XG), (bf16_t*)(big + BIG_GATES)};
        pg8::gemm_phase(lds, g, S, E, tid);
    } break;
    case 4: if (PM & 16u) mixer_phase(P, ws, l, lds, tid, bid); break;
    case 5: if (PM & 32u) {
        pg8::Gemm g{(const bf16_t*)(big + BIG_X3), (const bf16_t*)(ws + WS_WBR), MTOK, DM, 512}; S.init(MTOK, DM, G, c, 3);
        pg8::EpiBranch E{(const unsigned char*)(big + BIG_GATES), (bf16_t*)(big + BIG_MERGED)};
        pg8::gemm_phase(lds, g, S, E, tid);
    } break;
    case 6: if (PM & 64u) {
        pg8::Gemm g{(const bf16_t*)(big + BIG_MERGED), (const bf16_t*)(ws + WS_WOUT), MTOK, DM, DM}; S.init(MTOK, DM, G, c, 1);
        pg8::EpiStore E{F2};
        pg8::gemm_phase(lds, g, S, E, tid);
    } break;
    case 7: if (PM & 128u) {
        row_phase2<true>(l == 0 ? PIN(0) : (const float*)out, out, F, 0.5f, PIN(6) + l * DM, F2, 1.0f, PIN(23) + l * DM, PIN(24) + l * DM, HN, true, tid, bid);
        if (!row_only) convert_p(PIN(1) + (size_t)l * MTOK * PLE, (bf16_t*)(big + BIG_PB), tid, bid);
        } break;
    case 10: if (PM & 1024u) row_phase2<false>(out, out, F, 0.5f, PIN(28) + l * DM, nullptr, 0.f, nullptr, PIN(30) + l * DM, HN, true, tid, bid); break;
    case 11: if (PM & 2048u) {
        pg8::Gemm g{HN, (const bf16_t*)(ws + WS_WPG), MTOK, DM, DM}; S.init(MTOK, DM, G, c, 1);
        pg8::EpiPle E{(const bf16_t*)(big + BIG_E), F2};
        pg8::gemm_phase(lds, g, S, E, tid);
    } break;
    case 12: if (PM & 4096u) {
        row_phase2<true>(out, out, F, 0.5f, PIN(28) + l * DM, F2, 1.0f, PIN(32) + l * DM, PIN(2) + (l + 1 < NLAYER ? l + 1 : l) * DM, HN, l + 1 < NLAYER, tid, bid);
        if (l + 1 < NLAYER && !row_only) prep_weights(P, ws, l + 1, lds, tid, bid);
        } break;
    default: break;
    }
}

__global__ void __launch_bounds__(512, 2) mega(Params P) {
    extern __shared__ __attribute__((aligned(16))) unsigned char lds_raw[];
    LAS unsigned char* lds = (LAS unsigned char*)lds_raw;
    cg::grid_group grid = cg::this_grid();
#if !MULTI_LAUNCH
    volatile LAS unsigned* st = (volatile LAS unsigned*)(lds + LDS_BYTES - 16);
    if (threadIdx.x < 2) st[threadIdx.x] = 0u;
    __syncthreads();
    const XcdBarrier bar = xcd_barrier_post((unsigned*)((unsigned char*)P.ws + WS_BAR), st);
#endif
    for (int ph = P.ph_lo; ph < P.ph_hi; ++ph) {
        run_phase(P, ph, lds);
#if PROBE_DUP
        {
            const int sub = ph == 0 ? -1 : (ph - 1) % 13;
            const bool is_gemm = (sub == 0 || sub == 1 || sub == 3 || sub == 5 || sub == 6 || sub == 8 || sub == 9 || sub == 11);
            if (((PROBE_DUP & 1) && is_gemm) || ((PROBE_DUP & 2) && sub == 4)) { __syncthreads(); run_phase(P, ph, lds); }
#if !MULTI_LAUNCH
            if ((PROBE_DUP & 4) && ph > 0) xcd_barrier(bar);
#endif
        }
#endif
#if !MULTI_LAUNCH
        if (ph + 1 < P.ph_hi) { if (ph == 0) grid.sync(); else xcd_barrier(bar); }
#endif
    }
}

extern "C" void kernel_launch(void* const* d_in, const int* in_sizes, int n_in, void* d_out, int out_size, void* d_ws, size_t ws_size, hipStream_t stream) {
    static int grid = 0;
    if (grid == 0) {
        if (n_in != 33 || ws_size < WS_END) { fprintf(stderr, "kernel_launch: unexpected n_in %d or ws_size %zu (< %zu)\n", n_in, ws_size, (size_t)WS_END); grid = -1; return; }
        int dev = 0, cus = 0, per_cu = 0;
        hipGetDevice(&dev);
        hipDeviceGetAttribute(&cus, hipDeviceAttributeMultiprocessorCount, dev);
        if (hipFuncSetAttribute((const void*)mega, hipFuncAttributeMaxDynamicSharedMemorySize, LDS_BYTES) != hipSuccess) { fprintf(stderr, "kernel_launch: hipFuncSetAttribute failed\n"); grid = -1; return; }
        hipOccupancyMaxActiveBlocksPerMultiprocessor(&per_cu, (const void*)mega, 512, LDS_BYTES);
        if (per_cu < 1) per_cu = 1;
        (void)hipGetLastError();
        grid = cus * per_cu;
    }
    if (grid < 0) return;
    Params p{};
    for (int i = 0; i < 33; ++i) p.in[i] = (const GAS float*)d_in[i];
    p.out = (GAS float*)d_out; p.ws = (GAS unsigned char*)d_ws;
#if MULTI_LAUNCH
    for (int ph = 0; ph < NPHASE; ++ph) {
        p.ph_lo = ph; p.ph_hi = ph + 1;
        hipLaunchKernelGGL(mega, dim3(grid), dim3(512), LDS_BYTES, stream, p);
    }
#else
    p.ph_lo = 0; p.ph_hi = NPHASE;
    if (hipMemsetAsync((char*)d_ws + WS_BAR, 0, 16384, stream) != hipSuccess) { fprintf(stderr, "kernel_launch: memset of the barrier words failed\n"); return; }
    void* args[] = {&p};
    hipError_t e = hipLaunchCooperativeKernel((const void*)mega, dim3(grid), dim3(512), args, LDS_BYTES, stream);
    if (e != hipSuccess) fprintf(stderr, "cooperative launch failed: %s (grid %d)\n", hipGetErrorString(e), grid);
#endif
}
```

```cpp
#include <hip/hip_runtime.h>
#include <hip/hip_cooperative_groups.h>
#include <cstdio>
namespace cg = cooperative_groups;

#ifndef PHASE_MASK
#define PHASE_MASK 0xffffu
#endif
#ifndef PROBE_DUP
#define PROBE_DUP 0
#endif
#ifndef MULTI_LAUNCH
#define MULTI_LAUNCH 0
#endif

#define LAS __attribute__((address_space(3)))
typedef unsigned short bf16_t;
typedef short bf16x8 __attribute__((ext_vector_type(8)));
typedef float f32x4 __attribute__((ext_vector_type(4)));
typedef float f32x2 __attribute__((ext_vector_type(2)));
typedef unsigned u32x4 __attribute__((ext_vector_type(4)));
typedef unsigned u32x2 __attribute__((ext_vector_type(2)));

constexpr int MTOK = 32768, DM = 1024, DFF = 2816, SEQ = 4096, NLAYER = 4, PLE = 256;
constexpr int NGU = 2 * DFF;
constexpr int NIN = 5632;
constexpr float EPS = 1e-6f;
constexpr int LDS_BYTES = 147456;
constexpr int NPHASE = 1 + 13 * NLAYER;

constexpr size_t WS_WGU1 = 0;
constexpr size_t WS_WD1 = WS_WGU1 + (size_t)NGU * DM * 2;
constexpr size_t WS_WGU2 = WS_WD1 + (size_t)DM * DFF * 2;
constexpr size_t WS_WD2 = WS_WGU2 + (size_t)NGU * DM * 2;
constexpr size_t WS_WIN = WS_WD2 + (size_t)DM * DFF * 2;
constexpr size_t WS_WBR = WS_WIN + (size_t)NIN * DM * 2;
constexpr size_t WS_WOUT = WS_WBR + (size_t)3 * DM * 512 * 2;
constexpr size_t WS_WPG = WS_WOUT + (size_t)DM * DM * 2;
constexpr size_t WS_WPP = WS_WPG + (size_t)DM * DM * 2;
constexpr size_t WS_WSPK = WS_WPP + (size_t)DM * PLE * 2;
constexpr size_t WS_HN = WS_WSPK + (size_t)4 * 128 * 128 * 2;
constexpr size_t WS_F = WS_HN + (size_t)MTOK * DM * 2;
constexpr size_t WS_BIG = WS_F + (size_t)MTOK * DM * 2;
constexpr size_t BIG_ACT = 0;
constexpr size_t BIG_ZP = 0, BIG_U = (size_t)MTOK * 512 * 2, BIG_V = 2 * BIG_U, BIG_XG = 3 * BIG_U;
constexpr size_t BIG_GATES = 4 * BIG_U;
constexpr size_t BIG_X3 = BIG_GATES + (size_t)MTOK * 3072 * 2;
constexpr size_t BIG_MERGED = 0;
constexpr size_t BIG_E = (size_t)192 * 1024 * 1024;
constexpr size_t BIG_PB = BIG_X3;
constexpr size_t WS_BAR = WS_BIG + BIG_X3 + (size_t)3 * MTOK * 512 * 2;
constexpr size_t WS_F2 = WS_BAR + 16384;
constexpr size_t WS_END = WS_F2 + (size_t)MTOK * DM * 2;

#define GAS __attribute__((address_space(1)))
struct Params { const GAS float* in[33]; GAS float* out; GAS unsigned char* ws; int ph_lo, ph_hi; };
#define PIN(i) ((const float*)P.in[i])

typedef __bf16 bf16x2_t __attribute__((ext_vector_type(2)));
__device__ __forceinline__ unsigned cvt_pk_bf16(float lo, float hi) { const f32x2 v = {lo, hi}; return __builtin_bit_cast(unsigned, __builtin_convertvector(v, bf16x2_t)); }
__device__ __forceinline__ float bf_lo(unsigned w) { return __uint_as_float(w << 16); }
__device__ __forceinline__ float bf_hi(unsigned w) { return __uint_as_float(w & 0xffff0000u); }
__device__ __forceinline__ float sigmoid_f(float x) { return __builtin_amdgcn_rcpf(1.0f + __builtin_amdgcn_exp2f(-1.44269504f * x)); }
__device__ __forceinline__ float wave_sum(float v) {
#pragma unroll
    for (int o = 32; o >= 1; o >>= 1) v += __shfl_xor(v, o);
    return v;
}
__device__ __forceinline__ f32x2 gelu_pk(f32x2 v) {
    const f32x2 av = __builtin_elementwise_abs(v), d = av * 0.2316418882f + 1.0f;
    f32x2 t; t.x = __builtin_amdgcn_rcpf(d.x); t.y = __builtin_amdgcn_rcpf(d.y);
    f32x2 q = t * 0.5307027145f + (-0.7265760135f); q = q * t + 0.7107068705f; q = q * t + (-0.142248368f); q = q * t + 0.127414796f; q = q * t;
    const f32x2 s = (v * v) * (-0.72134752044f);
    f32x2 e; e.x = __builtin_amdgcn_exp2f(s.x); e.y = __builtin_amdgcn_exp2f(s.y);
    const f32x2 m = v * (q * e), r = v - m;
    f32x2 o; o.x = v.x < 0.f ? m.x : r.x; o.y = v.y < 0.f ? m.y : r.y; return o;
}
__device__ __forceinline__ f32x4 gelu4(f32x4 v) { f32x2 a = gelu_pk((f32x2){v[0], v[1]}), b = gelu_pk((f32x2){v[2], v[3]}); return (f32x4){a.x, a.y, b.x, b.y}; }
__device__ __forceinline__ f32x4 sigmoid4(f32x4 v) { return (f32x4){sigmoid_f(v[0]), sigmoid_f(v[1]), sigmoid_f(v[2]), sigmoid_f(v[3])}; }
__device__ __forceinline__ u32x4 pack8(f32x4 a, f32x4 b) { u32x4 w; w.x = cvt_pk_bf16(a[0], a[1]); w.y = cvt_pk_bf16(a[2], a[3]); w.z = cvt_pk_bf16(b[0], b[1]); w.w = cvt_pk_bf16(b[2], b[3]); return w; }
__device__ __forceinline__ f32x4 unpack_lo4(u32x4 w) { return (f32x4){bf_lo(w.x), bf_hi(w.x), bf_lo(w.y), bf_hi(w.y)}; }
__device__ __forceinline__ f32x4 unpack_hi4(u32x4 w) { return (f32x4){bf_lo(w.z), bf_hi(w.z), bf_lo(w.w), bf_hi(w.w)}; }

namespace pg8 {
constexpr int BM = 256, BK = 64, HALF = 128, HTB = HALF * BK * 2, STAGE_BYTES = 8 * HTB, NXCD = 8, WGM = 8;
__device__ __forceinline__ int lds_byte(int r, int c) { const int st = (r >> 4) * 2 + (c >> 5), rr = r & 15, cc = c & 31, ob = rr * 64 + cc * 2; return st * 1024 + (ob ^ (((ob >> 9) & 1) << 5)); }
__device__ __forceinline__ void stage_rc(int b, int& R, int& C) { const int st = b / 1024, sb = b % 1024, swz = sb ^ (((sb >> 9) & 1) << 5); R = (st >> 1) * 16 + swz / 64; C = (st & 1) * 32 + (swz % 64) / 2; }
__device__ __forceinline__ int perm32(int rho) { const int n = rho >> 4, i = rho & 15; return 8 * (i >> 2) + 4 * n + (i & 3); }

struct Unit { int pm, pn; };
struct Gemm { const bf16_t* A; const bf16_t* Bt; int M, N, K; };

struct Order {
    int nM, nN, nwg, G, c, zn;
    __device__ void init(int M, int N, int G_, int c_, int zn_) { nM = M / BM; nN = N / BM; nwg = nM * nN; G = G_; c = c_; zn = zn_; }
    __device__ bool next(int i, Unit& u) const {
        const int ti = i / zn, z = i - ti * zn;
        const long L = (long)ti * G + c; if (L >= nwg) return false;
        int wgid = (int)L; { const int q = nwg / NXCD, r = nwg % NXCD, xcd = wgid % NXCD, off = wgid / NXCD; wgid = (xcd < r ? xcd * (q + 1) : r * (q + 1) + (xcd - r) * q) + off; }
        const int nig = WGM * nN, gid = wgid / nig, fm = gid * WGM, gsz = (nM - fm) < WGM ? (nM - fm) : WGM;
        u.pm = z * nM + fm + ((wgid % nig) % gsz); u.pn = z * nN + (wgid % nig) / gsz; return true;
    }
};

template <class Epi>
__device__ __forceinline__ void gemm_phase(LAS unsigned char* lds, const Gemm g, const Order& S, const Epi& E, const int tid) {
    const int wid = __builtin_amdgcn_readfirstlane(tid >> 6), lane = tid & 63, wr = wid >> 2, wc = wid & 3, fr = lane & 15, fq = lane >> 4;
    const int K = g.K, nt = K / BK;
    unsigned voffA[2], voffB[2];
#pragma unroll
    for (int i = 0; i < 2; ++i) { int R, C; stage_rc(tid * 16 + i * 8192, R, C); const int Rb = (R & ~31) + perm32(R & 31);
        voffA[i] = (unsigned)(R * K + C) * 2u; voffB[i] = (unsigned)(Rb * K + C) * 2u; }
    const size_t kstep = (size_t)(BK * 2);
    const size_t hstep = (size_t)HALF * K * 2;
    const size_t tstep = 2 * hstep;
    const unsigned ldsw = (unsigned)wid * 1024u;
    const int aoff = lds_byte(wr * 64 + fr, fq * 8), boff = lds_byte(wc * 32 + fr, fq * 8);
#define PG8_SA(b, h) (((b) * 2 + (h)) * HTB)
#define PG8_SB(b, h) ((4 + (b) * 2 + (h)) * HTB)
#define PG8_STAGE(bufoff, gbase, voff) do { _Pragma("unroll") for (int _i = 0; _i < 2; ++_i) \
        __builtin_amdgcn_global_load_lds((const unsigned*)((const char*)(gbase) + (voff)[_i]), (LAS unsigned*)(lds + (bufoff) + ldsw + _i * 8192), 16, 0, 0); } while (0)
#define PG8_LDA(dst, b, h) do { _Pragma("unroll") for (int m = 0; m < 4; ++m) _Pragma("unroll") for (int k = 0; k < 2; ++k) dst[m][k] = *(const LAS bf16x8*)(lds + PG8_SA(b, h) + aoff + m * 2048 + k * 1024); } while (0)
#define PG8_LDB(dst, b, h) do { _Pragma("unroll") for (int n = 0; n < 2; ++n) _Pragma("unroll") for (int k = 0; k < 2; ++k) dst[n][k] = *(const LAS bf16x8*)(lds + PG8_SB(b, h) + boff + n * 2048 + k * 1024); } while (0)
#define PG8_MMA(ai, bj, At, Bt) do { __builtin_amdgcn_s_setprio(1); _Pragma("unroll") for (int m = 0; m < 4; ++m) _Pragma("unroll") for (int n = 0; n < 2; ++n) _Pragma("unroll") for (int k = 0; k < 2; ++k) \
        acc[ai][bj][m][n] = __builtin_amdgcn_mfma_f32_16x16x32_bf16(Bt[n][k], At[m][k], acc[ai][bj][m][n], 0, 0, 0); __builtin_amdgcn_s_setprio(0); } while (0)
#define PG8_WAIT_V(n) asm volatile("s_waitcnt vmcnt(" #n ")" ::: "memory")
#define PG8_WAIT_L(n) asm volatile("s_waitcnt lgkmcnt(" #n ")" ::: "memory")
#define PG8_BAR __builtin_amdgcn_s_barrier()
#define PG8_SCHED __builtin_amdgcn_sched_barrier(0)
    Unit cur, nxt; int ui = 0;
    if (!S.next(0, cur)) return;
    f32x4 acc[2][2][4][2];
#pragma unroll
    for (int a = 0; a < 2; ++a)
#pragma unroll
        for (int b = 0; b < 2; ++b)
#pragma unroll
            for (int m = 0; m < 4; ++m)
#pragma unroll
                for (int n = 0; n < 2; ++n) acc[a][b][m][n] = (f32x4){0.f, 0.f, 0.f, 0.f};
    bf16x8 At[4][2], B0[2][2], B1[2][2];
    const char* cA = (const char*)g.A + (size_t)cur.pm * tstep; const char* cB = (const char*)g.Bt + (size_t)cur.pn * tstep;
    PG8_STAGE(PG8_SB(0, 0), cB, voffB); PG8_STAGE(PG8_SA(0, 0), cA, voffA); PG8_STAGE(PG8_SB(0, 1), cB + hstep, voffB); PG8_STAGE(PG8_SA(0, 1), cA + hstep, voffA);
    if (wr == 1) PG8_BAR;
    PG8_WAIT_V(4); PG8_BAR;
    PG8_STAGE(PG8_SB(1, 0), cB + kstep, voffB); PG8_STAGE(PG8_SA(1, 0), cA + kstep, voffA); PG8_STAGE(PG8_SB(1, 1), cB + hstep + kstep, voffB);
    PG8_WAIT_V(6); PG8_BAR;
    for (;;) {
        const bool has_next = S.next(ui + 1, nxt);
        const char* nA = has_next ? (const char*)g.A + (size_t)nxt.pm * tstep : cA; const char* nB = has_next ? (const char*)g.Bt + (size_t)nxt.pn * tstep : cB;
        for (int t = 0; t < nt; t += 2) {
            const bool last = (t == nt - 2);
            const char* a1 = cA + (size_t)(t + 1) * kstep;
            const char* a2 = last ? nA : cA + (size_t)(t + 2) * kstep; const char* b2 = last ? nB : cB + (size_t)(t + 2) * kstep;
            const char* a3 = a2 + kstep; const char* b3 = b2 + kstep;
            PG8_LDB(B0, 0, 0); PG8_SCHED; PG8_LDA(At, 0, 0); PG8_STAGE(PG8_SA(1, 1), a1 + hstep, voffA);
            PG8_WAIT_L(8); PG8_BAR; PG8_WAIT_L(0); PG8_MMA(0, 0, At, B0); PG8_BAR; PG8_SCHED;
            PG8_LDB(B1, 0, 1); PG8_STAGE(PG8_SB(0, 0), b2, voffB);
            PG8_BAR; PG8_WAIT_L(0); PG8_MMA(0, 1, At, B1); PG8_BAR;
            PG8_LDA(At, 0, 1); PG8_STAGE(PG8_SA(0, 0), a2, voffA);
            PG8_BAR; PG8_WAIT_L(0); PG8_MMA(1, 0, At, B0); PG8_BAR; PG8_SCHED;
            PG8_STAGE(PG8_SB(0, 1), b2 + hstep, voffB);
            PG8_WAIT_V(6); PG8_BAR; PG8_MMA(1, 1, At, B1); PG8_BAR;
            PG8_LDB(B0, 1, 0); PG8_SCHED; PG8_LDA(At, 1, 0); PG8_STAGE(PG8_SA(0, 1), a2 + hstep, voffA);
            PG8_WAIT_L(8); PG8_BAR; PG8_WAIT_L(0); PG8_MMA(0, 0, At, B0); PG8_BAR; PG8_SCHED;
            PG8_LDB(B1, 1, 1); PG8_STAGE(PG8_SB(1, 0), b3, voffB);
            PG8_BAR; PG8_WAIT_L(0); PG8_MMA(0, 1, At, B1); PG8_BAR;
            PG8_LDA(At, 1, 1); PG8_STAGE(PG8_SA(1, 0), a3, voffA);
            PG8_BAR; PG8_WAIT_L(0); PG8_MMA(1, 0, At, B0); PG8_BAR; PG8_SCHED;
            PG8_STAGE(PG8_SB(1, 1), b3 + hstep, voffB);
            PG8_WAIT_V(6); PG8_BAR; PG8_MMA(1, 1, At, B1); PG8_BAR;
        }
        bool zero_acc = true;
        if constexpr (Epi::CHAIN) zero_acc = E.chain(acc, cur, wr, wc, fr, fq);
        else E(acc, cur, wr, wc, fr, fq);
        if (!has_next) break;
        if (zero_acc)
#pragma unroll
        for (int a = 0; a < 2; ++a)
#pragma unroll
            for (int b = 0; b < 2; ++b)
#pragma unroll
                for (int m = 0; m < 4; ++m)
#pragma unroll
                    for (int n = 0; n < 2; ++n) acc[a][b][m][n] = (f32x4){0.f, 0.f, 0.f, 0.f};
        cur = nxt; cA = nA; cB = nB; ++ui;
    }
    PG8_WAIT_V(0);
    if (wr == 0) PG8_BAR;
    PG8_BAR;
#undef PG8_SA
#undef PG8_SB
#undef PG8_STAGE
#undef PG8_LDA
#undef PG8_LDB
#undef PG8_MMA
#undef PG8_WAIT_V
#undef PG8_WAIT_L
#undef PG8_BAR
#undef PG8_SCHED
}

typedef f32x4 Acc[2][2][4][2];
template <int ACT, int LDC> __device__ __forceinline__ void glu_store(const Acc& acc, char* ub, unsigned lane_off) {
#pragma unroll
    for (int ai = 0; ai < 2; ++ai)
#pragma unroll
        for (int m = 0; m < 4; ++m) {
            char* rp = ub + (size_t)(ai * HALF + m * 16) * LDC * 2;
            f32x4 v[2];
#pragma unroll
            for (int n = 0; n < 2; ++n) { const f32x4 a = acc[ai][0][m][n], b = acc[ai][1][m][n];
                if (ACT == 0) v[n] = a * sigmoid4(a) * b; else v[n] = a * sigmoid4(b); }
            *(u32x4*)(rp + lane_off) = pack8(v[0], v[1]);
        }
}
template <int LDC> __device__ __forceinline__ unsigned lane_off_of(int wr, int wc, int fr, int fq) { return (unsigned)((wr * 64 + fr) * LDC + wc * 32 + 8 * fq) * 2u; }
struct EpiGLU {
    static constexpr bool CHAIN = false;
    bf16_t* O;
    __device__ __forceinline__ void operator()(const Acc& acc, const Unit& u, int wr, int wc, int fr, int fq) const {
        glu_store<0, DFF>(acc, (char*)O + ((size_t)u.pm * BM * DFF + (size_t)u.pn * 128) * 2, lane_off_of<DFF>(wr, wc, fr, fq));
    }
};
template <int ACT, int LDC> __device__ __forceinline__ void plain_store(const Acc& acc, char* ub, unsigned lane_off) {
#pragma unroll
    for (int ai = 0; ai < 2; ++ai)
#pragma unroll
        for (int m = 0; m < 4; ++m) {
            char* rp = ub + (size_t)(ai * HALF + m * 16) * LDC * 2;
#pragma unroll
            for (int bj = 0; bj < 2; ++bj) { f32x4 v0 = acc[ai][bj][m][0], v1 = acc[ai][bj][m][1];
                if (ACT == 1) { v0 = gelu4(v0); v1 = gelu4(v1); }
                if (ACT == 2) { v0 = sigmoid4(v0); v1 = sigmoid4(v1); }
                *(u32x4*)(rp + bj * HALF * 2 + lane_off) = pack8(v0, v1); }
        }
}
struct EpiStore {
    static constexpr bool CHAIN = false;
    bf16_t* O;
    __device__ __forceinline__ void operator()(const Acc& acc, const Unit& u, int wr, int wc, int fr, int fq) const {
        plain_store<0, DM>(acc, (char*)O + ((size_t)u.pm * BM * DM + (size_t)u.pn * BM) * 2, lane_off_of<DM>(wr, wc, fr, fq));
    }
};
struct EpiIn {
    static constexpr bool CHAIN = false;
    bf16_t *ZP, *U, *V, *XG, *GATES;
    __device__ __forceinline__ void operator()(const Acc& acc, const Unit& u, int wr, int wc, int fr, int fq) const {
        const int pn = u.pn; const size_t rb = (size_t)u.pm * BM;
        if (pn >= 10) {
            char* ub = (char*)GATES + rb * 3072 + (size_t)(pn - 10) * 256; const unsigned lo = (unsigned)((wr * 64 + fr) * 3072 + wc * 32 + 8 * fq);
#pragma unroll
            for (int ai = 0; ai < 2; ++ai)
#pragma unroll
                for (int m = 0; m < 4; ++m)
#pragma unroll
                    for (int bj = 0; bj < 2; ++bj) {
                        const f32x4 v0 = sigmoid4(acc[ai][bj][m][0]) * 255.0f, v1 = sigmoid4(acc[ai][bj][m][1]) * 255.0f;
                        u32x2 w; w.x = 0u; w.y = 0u;
                        w.x = __builtin_amdgcn_cvt_pk_u8_f32(v0[0], 0, w.x); w.x = __builtin_amdgcn_cvt_pk_u8_f32(v0[1], 1, w.x); w.x = __builtin_amdgcn_cvt_pk_u8_f32(v0[2], 2, w.x); w.x = __builtin_amdgcn_cvt_pk_u8_f32(v0[3], 3, w.x);
                        w.y = __builtin_amdgcn_cvt_pk_u8_f32(v1[0], 0, w.y); w.y = __builtin_amdgcn_cvt_pk_u8_f32(v1[1], 1, w.y); w.y = __builtin_amdgcn_cvt_pk_u8_f32(v1[2], 2, w.y); w.y = __builtin_amdgcn_cvt_pk_u8_f32(v1[3], 3, w.y);
                        *(u32x2*)(ub + (size_t)(ai * HALF + m * 16) * 3072 + bj * HALF + lo) = w;
                    }
        }
        else {
            const unsigned lo = lane_off_of<512>(wr, wc, fr, fq);
            if (pn >= 6) glu_store<1, 512>(acc, (char*)XG + (rb * 512 + (size_t)(pn - 6) * 128) * 2, lo);
            else if (pn < 2) plain_store<0, 512>(acc, (char*)ZP + (rb * 512 + (size_t)pn * 256) * 2, lo);
            else { char* ub = (char*)(pn < 4 ? U : V) + (rb * 512 + (size_t)(pn & 1) * 256) * 2; plain_store<1, 512>(acc, ub, lo); }
        }
    }
};
struct EpiBranch {
    static constexpr bool CHAIN = true;
    const unsigned char* GATES; bf16_t* MG;
    static __device__ __forceinline__ f32x4 code4(unsigned w) { return (f32x4){__builtin_fmaxf((float)(w & 255u), 0.25f), __builtin_fmaxf((float)((w >> 8) & 255u), 0.25f), __builtin_fmaxf((float)((w >> 16) & 255u), 0.25f), __builtin_fmaxf((float)(w >> 24), 0.25f)}; }
    static __device__ __forceinline__ f32x4 rcp4(f32x4 v) { return (f32x4){__builtin_amdgcn_rcpf(v[0]), __builtin_amdgcn_rcpf(v[1]), __builtin_amdgcn_rcpf(v[2]), __builtin_amdgcn_rcpf(v[3])}; }
    __device__ __forceinline__ bool chain(Acc& acc, const Unit& u, int wr, int wc, int fr, int fq) const {
        const int z = u.pn >> 2, pn = u.pn & 3, pm = u.pm - z * 128;
        const bool fin = (z == 2);
        const char* gb = (const char*)GATES + (size_t)pm * BM * 3072 + (size_t)z * 1024 + (size_t)pn * BM;
        const char* gn = fin ? gb : gb + 1024;
        const unsigned glo = (unsigned)((wr * 64 + fr) * 3072 + wc * 32 + 8 * fq);
        char* mb = (char*)MG + ((size_t)pm * BM * DM + (size_t)pn * BM) * 2;
        const unsigned mlo = lane_off_of<DM>(wr, wc, fr, fq);
        constexpr float q = 1.0f / 255.0f;
        u32x2 g0[2][4][2], g1[2][4][2];
#pragma unroll
        for (int ai = 0; ai < 2; ++ai)
#pragma unroll
            for (int m = 0; m < 4; ++m)
#pragma unroll
                for (int bj = 0; bj < 2; ++bj) {
                    g0[ai][m][bj] = *(const u32x2*)(gb + (size_t)(ai * HALF + m * 16) * 3072 + bj * HALF + glo);
                    g1[ai][m][bj] = *(const u32x2*)(gn + (size_t)(ai * HALF + m * 16) * 3072 + bj * HALF + glo);
                }
#pragma unroll
        for (int ai = 0; ai < 2; ++ai)
#pragma unroll
            for (int m = 0; m < 4; ++m)
#pragma unroll
                for (int bj = 0; bj < 2; ++bj) {
                    const f32x4 d0 = rcp4(code4(g1[ai][m][bj].x)), d1 = rcp4(code4(g1[ai][m][bj].y));
                    acc[ai][bj][m][0] *= code4(g0[ai][m][bj].x) * (fin ? (f32x4){q, q, q, q} : d0);
                    acc[ai][bj][m][1] *= code4(g0[ai][m][bj].y) * (fin ? (f32x4){q, q, q, q} : d1);
                    if (fin) *(u32x4*)(mb + (size_t)(ai * HALF + m * 16) * DM * 2 + bj * HALF * 2 + mlo) = pack8(acc[ai][bj][m][0], acc[ai][bj][m][1]);
                }
        return fin;
    }
};
struct EpiPle {
    static constexpr bool CHAIN = false;
    const bf16_t* E; bf16_t* O;
    __device__ __forceinline__ void operator()(const Acc& acc, const Unit& u, int wr, int wc, int fr, int fq) const {
        const size_t uo = ((size_t)u.pm * BM * DM + (size_t)u.pn * BM) * 2;
        const char* eb = (const char*)E + uo; char* ob = (char*)O + uo;
        const unsigned lo = lane_off_of<DM>(wr, wc, fr, fq);
        u32x4 ew[2][4][2];
#pragma unroll
        for (int ai = 0; ai < 2; ++ai)
#pragma unroll
            for (int m = 0; m < 4; ++m)
#pragma unroll
                for (int bj = 0; bj < 2; ++bj) ew[ai][m][bj] = *(const u32x4*)(eb + (size_t)(ai * HALF + m * 16) * DM * 2 + bj * HALF * 2 + lo);
#pragma unroll
        for (int ai = 0; ai < 2; ++ai)
#pragma unroll
            for (int m = 0; m < 4; ++m)
#pragma unroll
                for (int bj = 0; bj < 2; ++bj) {
                    const f32x4 v0 = sigmoid4(acc[ai][bj][m][0]) * unpack_lo4(ew[ai][m][bj]), v1 = sigmoid4(acc[ai][bj][m][1]) * unpack_hi4(ew[ai][m][bj]);
                    *(u32x4*)(ob + (size_t)(ai * HALF + m * 16) * DM * 2 + bj * HALF * 2 + lo) = pack8(v0, v1);
                }
    }
};
}

template <bool INIT>
__device__ __forceinline__ void row_phase(const float* hin, float* h, const bf16_t* F, float cscale, const float* ga, const float* gb, bf16_t* HN, bool write_hn, const int tid, const int bid) {
    const int wid = tid >> 6, lane = tid & 63;
    constexpr int R = 4;
    f32x4 gav[4], gbv[4];
#pragma unroll
    for (int k = 0; k < 4; ++k) {
        gav[k] = INIT ? (f32x4){0.f, 0.f, 0.f, 0.f} : *(const f32x4*)(ga + 256 * k + 4 * lane);
        gbv[k] = write_hn ? *(const f32x4*)(gb + 256 * k + 4 * lane) : (f32x4){0.f, 0.f, 0.f, 0.f};
    }
    for (int row0 = (bid * 8 + wid) * R; row0 < MTOK; row0 += gridDim.x * 8 * R) {
        f32x4 hv[R][4]; u32x2 fw[R][4];
#pragma unroll
        for (int r = 0; r < R; ++r) { const size_t ro = (size_t)(row0 + r) * DM + 4 * lane;
#pragma unroll
            for (int k = 0; k < 4; ++k) {
                hv[r][k] = *(const f32x4*)(hin + ro + 256 * k);
                if (!INIT) fw[r][k] = *(const u32x2*)(F + ro + 256 * k);
            } }
#pragma unroll
        for (int r = 0; r < R; ++r) { const size_t ro = (size_t)(row0 + r) * DM + 4 * lane;
            if (!INIT) {
                f32x4 fv[4];
#pragma unroll
                for (int k = 0; k < 4; ++k) fv[k] = (f32x4){bf_lo(fw[r][k].x), bf_hi(fw[r][k].x), bf_lo(fw[r][k].y), bf_hi(fw[r][k].y)};
                float ss = 0.f;
#pragma unroll
                for (int i = 0; i < 4; ++i) ss += fv[i][0] * fv[i][0] + fv[i][1] * fv[i][1] + fv[i][2] * fv[i][2] + fv[i][3] * fv[i][3];
                ss = wave_sum(ss);
                const float rs = cscale * __builtin_amdgcn_rsqf(ss * (1.0f / DM) + EPS);
#pragma unroll
                for (int i = 0; i < 4; ++i) hv[r][i] += fv[i] * gav[i] * rs;
            }
            float s2 = 0.f;
#pragma unroll
            for (int i = 0; i < 4; ++i) s2 += hv[r][i][0] * hv[r][i][0] + hv[r][i][1] * hv[r][i][1] + hv[r][i][2] * hv[r][i][2] + hv[r][i][3] * hv[r][i][3];
            s2 = wave_sum(s2);
            const float rs2 = __builtin_amdgcn_rsqf(s2 * (1.0f / DM) + EPS);
            if (!INIT) { _Pragma("unroll") for (int k = 0; k < 4; ++k) *(f32x4*)(h + ro + 256 * k) = hv[r][k]; }
            if (write_hn) {
#pragma unroll
                for (int k = 0; k < 4; ++k) { const f32x4 o = hv[r][k] * gbv[k] * rs2; u32x2 w; w.x = cvt_pk_bf16(o[0], o[1]); w.y = cvt_pk_bf16(o[2], o[3]); *(u32x2*)(HN + ro + 256 * k) = w; }
            }
        }
    }
}

__device__ __forceinline__ f32x4 bf4(u32x2 w) { return (f32x4){bf_lo(w.x), bf_hi(w.x), bf_lo(w.y), bf_hi(w.y)}; }
__device__ __forceinline__ float sumsq16(const f32x4 (&v)[4]) { float s = 0.f;
#pragma unroll
    for (int i = 0; i < 4; ++i) s += v[i][0] * v[i][0] + v[i][1] * v[i][1] + v[i][2] * v[i][2] + v[i][3] * v[i][3];
    return s; }
template <bool FULL>
__device__ __forceinline__ void row_phase2(const float* hin, float* h, const bf16_t* F1, float c1, const float* ga1, const bf16_t* F2, float c2, const float* ga2, const float* gb, bf16_t* HN, bool write_hn, const int tid, const int bid) {
    const int wid = tid >> 6, lane = tid & 63;
    constexpr int R = FULL ? 2 : 4;
    f32x4 g1v[4], g2v[4], gbv[4];
#pragma unroll
    for (int k = 0; k < 4; ++k) {
        g1v[k] = *(const f32x4*)(ga1 + 256 * k + 4 * lane);
        g2v[k] = FULL ? *(const f32x4*)(ga2 + 256 * k + 4 * lane) : (f32x4){0.f, 0.f, 0.f, 0.f};
        gbv[k] = write_hn ? *(const f32x4*)(gb + 256 * k + 4 * lane) : (f32x4){0.f, 0.f, 0.f, 0.f};
    }
    for (int row0 = (bid * 8 + wid) * R; row0 < MTOK; row0 += gridDim.x * 8 * R) {
        f32x4 hv[R][4]; u32x2 fa[R][4], fb[R][4];
#pragma unroll
        for (int r = 0; r < R; ++r) { const size_t ro = (size_t)(row0 + r) * DM + 4 * lane;
#pragma unroll
            for (int k = 0; k < 4; ++k) {
                hv[r][k] = *(const f32x4*)(hin + ro + 256 * k);
                fa[r][k] = *(const u32x2*)(F1 + ro + 256 * k);
                if (FULL) fb[r][k] = *(const u32x2*)(F2 + ro + 256 * k);
            } }
#pragma unroll
        for (int r = 0; r < R; ++r) { const size_t ro = (size_t)(row0 + r) * DM + 4 * lane;
            {
                f32x4 fv[4];
#pragma unroll
                for (int k = 0; k < 4; ++k) fv[k] = bf4(fa[r][k]);
                const float rs = c1 * __builtin_amdgcn_rsqf(wave_sum(sumsq16(fv)) * (1.0f / DM) + EPS);
#pragma unroll
                for (int i = 0; i < 4; ++i) hv[r][i] += fv[i] * g1v[i] * rs;
            }
            if (FULL) {
                f32x4 fv[4];
#pragma unroll
                for (int k = 0; k < 4; ++k) fv[k] = bf4(fb[r][k]);
                const float rs = c2 * __builtin_amdgcn_rsqf(wave_sum(sumsq16(fv)) * (1.0f / DM) + EPS);
#pragma unroll
                for (int i = 0; i < 4; ++i) hv[r][i] += fv[i] * g2v[i] * rs;
#pragma unroll
                for (int k = 0; k < 4; ++k) *(f32x4*)(h + ro + 256 * k) = hv[r][k];
            }
            if (write_hn) {
                const float rs2 = __builtin_amdgcn_rsqf(wave_sum(sumsq16(hv[r])) * (1.0f / DM) + EPS);
#pragma unroll
                for (int k = 0; k < 4; ++k) { const f32x4 o = hv[r][k] * gbv[k] * rs2; u32x2 w; w.x = cvt_pk_bf16(o[0], o[1]); w.y = cvt_pk_bf16(o[2], o[3]); *(u32x2*)(HN + ro + 256 * k) = w; }
            }
        }
    }
}

struct PrepJob { const float* src; bf16_t* dst; int ld, col0, k0, K, n0; };
__device__ __forceinline__ PrepJob prep_job(const Params& P, unsigned char* ws, int l, int tix) {
    constexpr int T_GU = (NGU / 64) * (DM / 64), T_D = (DM / 64) * (DFF / 64), T_IN = (NIN / 64) * (DM / 64), T_BR = (DM / 64) * (512 / 64), T_SQ = (DM / 64) * (DM / 64);
    int t = tix; const float* srcA; const float* srcB; int ld, mode, K; bf16_t* dst;
    if (t < T_GU) { srcA = PIN(3) + (size_t)l * DM * DFF; srcB = PIN(4) + (size_t)l * DM * DFF; ld = DFF; mode = 1; K = DM; dst = (bf16_t*)(ws + WS_WGU1); }
    else if ((t -= T_GU) < T_GU) { srcA = PIN(25) + (size_t)l * DM * DFF; srcB = PIN(26) + (size_t)l * DM * DFF; ld = DFF; mode = 1; K = DM; dst = (bf16_t*)(ws + WS_WGU2); }
    else if ((t -= T_GU) < T_D) { srcA = PIN(5) + (size_t)l * DFF * DM; srcB = srcA; ld = DM; mode = 0; K = DFF; dst = (bf16_t*)(ws + WS_WD1); }
    else if ((t -= T_D) < T_D) { srcA = PIN(27) + (size_t)l * DFF * DM; srcB = srcA; ld = DM; mode = 0; K = DFF; dst = (bf16_t*)(ws + WS_WD2); }
    else if ((t -= T_D) < T_IN) { srcA = PIN(8) + (size_t)l * DM * NIN; srcB = srcA; ld = NIN; mode = 2; K = DM; dst = (bf16_t*)(ws + WS_WIN); }
    else if ((t -= T_IN) < T_BR) { srcA = PIN(16) + (size_t)l * 512 * DM; srcB = srcA; ld = DM; mode = 0; K = 512; dst = (bf16_t*)(ws + WS_WBR) + (size_t)1 * DM * 512; }
    else if ((t -= T_BR) < T_BR) { srcA = PIN(21) + (size_t)l * 512 * DM; srcB = srcA; ld = DM; mode = 0; K = 512; dst = (bf16_t*)(ws + WS_WBR) + (size_t)2 * DM * 512; }
    else if ((t -= T_BR) < T_SQ) { srcA = PIN(22) + (size_t)l * DM * DM; srcB = srcA; ld = DM; mode = 0; K = DM; dst = (bf16_t*)(ws + WS_WOUT); }
    else if ((t -= T_SQ) < T_SQ) { srcA = PIN(31) + (size_t)l * DM * DM; srcB = srcA; ld = DM; mode = 0; K = DM; dst = (bf16_t*)(ws + WS_WPG); }
    else { t -= T_SQ; srcA = PIN(29) + (size_t)l * PLE * DM; srcB = srcA; ld = DM; mode = 0; K = PLE; dst = (bf16_t*)(ws + WS_WPP); }
    const int tk = K / 64, tn = t / tk, tkk = t - tn * tk, n0 = tn * 64, k0 = tkk * 64;
    const float* src = srcA; int col0 = n0;
    if (mode == 1) { const int tt = n0 >> 8, j = n0 & 255; if (j < 128) { col0 = 128 * tt + j; } else { src = srcB; col0 = 128 * tt + j - 128; } }
    else if (mode == 2) { if (n0 >= 1536 && n0 < 2560) { const int tt = (n0 - 1536) >> 8, j = (n0 - 1536) & 255; col0 = (j < 128) ? (1536 + 128 * tt + j) : (2048 + 128 * tt + j - 128); } }
    PrepJob J; J.src = src; J.dst = dst; J.ld = ld; J.col0 = col0; J.k0 = k0; J.K = K; J.n0 = n0; return J;
}

__device__ __forceinline__ void prep_weights(const Params& P, unsigned char* ws, int l, LAS unsigned char* lds, const int tid, const int bid) {
    LAS float* tile = (LAS float*)lds;
    constexpr int T_GU = (NGU / 64) * (DM / 64), T_D = (DM / 64) * (DFF / 64), T_IN = (NIN / 64) * (DM / 64), T_BR = (DM / 64) * (512 / 64), T_SQ = (DM / 64) * (DM / 64), T_PP = (DM / 64) * (PLE / 64);
    constexpr int TOTAL = 2 * T_GU + 2 * T_D + T_IN + 2 * T_BR + 2 * T_SQ + T_PP;
    {
        const int kk = tid >> 4, c4 = tid & 15, n = tid >> 3, k8 = tid & 7;
        f32x4 v0, v1; int tix = bid;
        if (tix < TOTAL) { const PrepJob J = prep_job(P, ws, l, tix); const float* sp = J.src + (size_t)(J.k0 + kk) * J.ld + J.col0 + 4 * c4; v0 = *(const f32x4*)sp; v1 = *(const f32x4*)(sp + (size_t)32 * J.ld); }
        for (; tix < TOTAL; tix += gridDim.x) {
            const PrepJob J = prep_job(P, ws, l, tix);
#pragma unroll
            for (int e = 0; e < 4; ++e) { tile[kk * 65 + 4 * c4 + e] = v0[e]; tile[(kk + 32) * 65 + 4 * c4 + e] = v1[e]; }
            __syncthreads();
            const int nx = tix + gridDim.x;
            if (nx < TOTAL) { const PrepJob Jn = prep_job(P, ws, l, nx); const float* sp = Jn.src + (size_t)(Jn.k0 + kk) * Jn.ld + Jn.col0 + 4 * c4; v0 = *(const f32x4*)sp; v1 = *(const f32x4*)(sp + (size_t)32 * Jn.ld); }
            float v[8];
#pragma unroll
            for (int i = 0; i < 8; ++i) v[i] = tile[(8 * k8 + i) * 65 + n];
            u32x4 w; w.x = cvt_pk_bf16(v[0], v[1]); w.y = cvt_pk_bf16(v[2], v[3]); w.z = cvt_pk_bf16(v[4], v[5]); w.w = cvt_pk_bf16(v[6], v[7]);
            *(u32x4*)(J.dst + (size_t)(J.n0 + n) * J.K + J.k0 + 8 * k8) = w;
            __syncthreads();
        }
    }
    {
        const float* pw = PIN(9) + (size_t)l * 4 * 128 * 128; const float* sc = PIN(10) + (size_t)l * 512; const float* wpo = PIN(11) + (size_t)l * 512 * DM;
        bf16_t* dst = (bf16_t*)(ws + WS_WBR);
        const int ol = tid & 63, i4 = __builtin_amdgcn_readfirstlane(tid >> 6);
        for (int tix = bid; tix < 16 * 16; tix += gridDim.x) {
            const int o = (tix >> 4) * 64 + ol, g = (tix >> 2) & 3, i0 = (tix & 3) * 32 + i4 * 4;
            float a[4] = {0.f, 0.f, 0.f, 0.f};
#pragma unroll 4
            for (int j = 0; j < 128; j += 4) {
                const f32x4 s4 = *(const f32x4*)(sc + g * 128 + j);
                float w[4];
#pragma unroll
                for (int jj = 0; jj < 4; ++jj) w[jj] = wpo[(size_t)(g * 128 + j + jj) * DM + o] * s4[jj];
#pragma unroll
                for (int ii = 0; ii < 4; ++ii) { const f32x4 p4 = *(const f32x4*)(pw + (size_t)(g * 128 + i0 + ii) * 128 + j);
                    a[ii] += p4[0] * w[0] + p4[1] * w[1] + p4[2] * w[2] + p4[3] * w[3]; }
            }
            u32x2 w2; w2.x = cvt_pk_bf16(a[0], a[1]); w2.y = cvt_pk_bf16(a[2], a[3]);
            *(u32x2*)(dst + (size_t)o * 512 + g * 128 + i0) = w2;
        }
    }
    {
        const float* wsrc = PIN(14) + (size_t)l * 4 * 128 * 128; bf16_t* dst = (bf16_t*)(ws + WS_WSPK);
        for (int idx = bid * 512 + tid; idx < 4 * 128 * 128 / 8; idx += gridDim.x * 512) {
            const int fq = idx & 3, kk = (idx >> 2) & 3, t = (idx >> 4) & 127, h = idx >> 11;
            float v[8];
#pragma unroll
            for (int i = 0; i < 8; ++i) { const int sp = 32 * kk + 4 * i + fq; v[i] = (sp <= t) ? wsrc[(size_t)(h * 128 + t) * 128 + sp] : 0.f; }
            u32x4 w4; w4.x = cvt_pk_bf16(v[0], v[1]); w4.y = cvt_pk_bf16(v[2], v[3]); w4.z = cvt_pk_bf16(v[4], v[5]); w4.w = cvt_pk_bf16(v[6], v[7]);
            *(u32x4*)(dst + (size_t)idx * 8) = w4;
        }
    }
}

__device__ __forceinline__ void convert_p(const float* p, bf16_t* PB, const int tid, const int bid) {
    for (size_t idx = (size_t)bid * 512 + tid; idx < (size_t)MTOK * PLE / 8; idx += (size_t)gridDim.x * 512) {
        const f32x4 a = *(const f32x4*)(p + idx * 8), b = *(const f32x4*)(p + idx * 8 + 4);
        *(u32x4*)(PB + idx * 8) = pack8(a, b);
    }
}

__device__ __forceinline__ void mixer_phase(const Params& P, unsigned char* ws, int l, LAS unsigned char* lds, const int tid, const int bid) {
    unsigned char* big = ws + WS_BIG;
    const bf16_t* ZP = (const bf16_t*)(big + BIG_ZP); const bf16_t* U = (const bf16_t*)(big + BIG_U); const bf16_t* V = (const bf16_t*)(big + BIG_V); const bf16_t* XG = (const bf16_t*)(big + BIG_XG);
    bf16_t* X3 = (bf16_t*)(big + BIG_X3);
    const int wid = __builtin_amdgcn_readfirstlane(tid >> 6), lane = tid & 63;

    {
        const float* lng = PIN(12) + (size_t)l * 512; const float* lnb = PIN(13) + (size_t)l * 512; const float* bsp = PIN(15) + (size_t)l * 4 * 128;
        const bf16_t* WSPK = (const bf16_t*)(ws + WS_WSPK);
        bf16_t* XS = X3 + (size_t)1 * MTOK * 512;
        const int fr = lane & 15, fq = lane >> 4, h = wid >> 1, th = wid & 1;
        constexpr int VP = 528;
        for (int ch = bid; ch < MTOK / 128; ch += gridDim.x) {
            const size_t tok0 = (size_t)ch * 128;
            {
                const f32x4 g0 = *(const f32x4*)(lng + 8 * lane), g1 = *(const f32x4*)(lng + 8 * lane + 4), b0 = *(const f32x4*)(lnb + 8 * lane), b1 = *(const f32x4*)(lnb + 8 * lane + 4);
#pragma unroll
                for (int i0 = 0; i0 < 16; i0 += 8) {
                    u32x4 wv[8];
#pragma unroll
                    for (int i = 0; i < 8; ++i) wv[i] = *(const u32x4*)(V + (tok0 + wid * 16 + i0 + i) * 512 + 8 * lane);
#pragma unroll
                    for (int i = 0; i < 8; ++i) {
                        const int sp = wid * 16 + i0 + i;
                        f32x4 x0 = unpack_lo4(wv[i]), x1 = unpack_hi4(wv[i]);
                        float s = (x0[0] + x0[1]) + (x0[2] + x0[3]) + (x1[0] + x1[1]) + (x1[2] + x1[3]);
                        s = wave_sum(s); const float mu = s * (1.0f / 512.0f);
                        x0 -= mu; x1 -= mu;
                        float q = x0[0] * x0[0] + x0[1] * x0[1] + x0[2] * x0[2] + x0[3] * x0[3] + x1[0] * x1[0] + x1[1] * x1[1] + x1[2] * x1[2] + x1[3] * x1[3];
                        q = wave_sum(q); const float rs = __builtin_amdgcn_rsqf(q * (1.0f / 512.0f) + EPS);
                        x0 = x0 * rs * g0 + b0; x1 = x1 * rs * g1 + b1;
                        *(LAS u32x4*)(lds + (size_t)sp * (VP * 2) + 16 * lane) = pack8(x0, x1);
                    }
                }
            }
            __syncthreads();
            {
                bf16x8 Wf[4][4]; float bs[4];
#pragma unroll
                for (int m = 0; m < 4; ++m) { const int t = 64 * th + 16 * m + fr; bs[m] = bsp[h * 128 + t];
#pragma unroll
                    for (int kk = 0; kk < 4; ++kk) Wf[m][kk] = *(const bf16x8*)(WSPK + ((size_t)((h * 128 + t) * 4 + kk) * 4 + fq) * 8); }
                const size_t ubase = (tok0 + 64 * th + fr) * 512 + 128 * h + 4 * fq;
                u32x2 uw[2][4];
#pragma unroll
                for (int m = 0; m < 4; ++m) uw[0][m] = *(const u32x2*)(U + ubase + (size_t)(16 * m) * 512);
#pragma unroll
                for (int n = 0; n < 8; ++n) {
                    if (n + 1 < 8) {
#pragma unroll
                        for (int m = 0; m < 4; ++m) uw[(n + 1) & 1][m] = *(const u32x2*)(U + ubase + (size_t)(16 * m) * 512 + 16 * (n + 1));
                    }
                    f32x4 acc[4];
#pragma unroll
                    for (int m = 0; m < 4; ++m) acc[m] = (f32x4){0.f, 0.f, 0.f, 0.f};
#pragma unroll
                    for (int kk = 0; kk < 4; ++kk) {
                        bf16x8 X;
#pragma unroll
                        for (int i = 0; i < 8; ++i) X[i] = *(const LAS short*)(lds + (size_t)(32 * kk + 4 * i + fq) * (VP * 2) + 2 * (128 * h + 16 * n + fr));
#pragma unroll
                        for (int m = 0; m < 4; ++m) acc[m] = __builtin_amdgcn_mfma_f32_16x16x32_bf16(X, Wf[m][kk], acc[m], 0, 0, 0);
                    }
#pragma unroll
                    for (int m = 0; m < 4; ++m) {
                        const u32x2 u2 = uw[n & 1][m];
                        const f32x4 sv = acc[m] + bs[m];
                        u32x2 o; o.x = cvt_pk_bf16(bf_lo(u2.x) * sv[0], bf_hi(u2.x) * sv[1]); o.y = cvt_pk_bf16(bf_lo(u2.y) * sv[2], bf_hi(u2.y) * sv[3]);
                        *(u32x2*)(XS + ubase + (size_t)(16 * m) * 512 + 16 * n) = o;
                    }
                }
            }
            __syncthreads();
        }
    }

    {
        const float* dwk = PIN(17) + (size_t)l * 31 * 512; const float* dwb = PIN(18) + (size_t)l * 512; const float* lng = PIN(19) + (size_t)l * 512; const float* lnb = PIN(20) + (size_t)l * 512;
        bf16_t* XC = X3 + (size_t)2 * MTOK * 512;
        LAS unsigned char* xs = lds;
        LAS float* ys = (LAS float*)(lds + 65536);
        const int c = tid; float wk[31];
#pragma unroll
        for (int k = 0; k < 31; ++k) wk[k] = dwk[k * 512 + c];
        const float bias = dwb[c];
        const f32x4 g0 = *(const f32x4*)(lng + 8 * lane), g1 = *(const f32x4*)(lng + 8 * lane + 4), b0 = *(const f32x4*)(lnb + 8 * lane), b1 = *(const f32x4*)(lnb + 8 * lane + 4);
        u32x4 pre[8];
#define CONV_LOAD(ct_) do { const int tok0_ = (ct_) * 32, t0_ = tok0_ & (SEQ - 1); _Pragma("unroll") for (int i = 0; i < 8; ++i) { const int idx = tid + 512 * i; const int r = idx >> 6, c8 = idx & 63; \
            pre[i] = (u32x4){0u, 0u, 0u, 0u}; if (idx < 62 * 64 && t0_ - 30 + r >= 0) pre[i] = *(const u32x4*)(XG + (size_t)(tok0_ - 30 + r) * 512 + 8 * c8); } } while (0)
        int ct = bid;
        if (ct < MTOK / 32) CONV_LOAD(ct);
        for (; ct < MTOK / 32; ct += gridDim.x) {
            const int tok0 = ct * 32;
#pragma unroll
            for (int i = 0; i < 8; ++i) { const int idx = tid + 512 * i; if (idx < 62 * 64) *(LAS u32x4*)(xs + (idx >> 6) * 1024 + 16 * (idx & 63)) = pre[i]; }
            __syncthreads();
            if (ct + (int)gridDim.x < MTOK / 32) CONV_LOAD(ct + gridDim.x);
#pragma unroll
            for (int hb = 0; hb < 2; ++hb) {
                float x[46];
#pragma unroll
                for (int r = 0; r < 46; ++r) x[r] = __uint_as_float(((unsigned)*(const LAS unsigned short*)(xs + (16 * hb + r) * 1024 + 2 * c)) << 16);
#pragma unroll
                for (int t = 0; t < 16; ++t) { float y = bias;
#pragma unroll
                    for (int k = 0; k < 31; ++k) y += wk[k] * x[t + k];
                    ys[(16 * hb + t) * 512 + c] = y; }
            }
            __syncthreads();
#pragma unroll
            for (int i = 0; i < 4; ++i) { const int t = wid * 4 + i;
                f32x4 x0 = *(const LAS f32x4*)(ys + t * 512 + 8 * lane), x1 = *(const LAS f32x4*)(ys + t * 512 + 8 * lane + 4);
                float s = (x0[0] + x0[1]) + (x0[2] + x0[3]) + (x1[0] + x1[1]) + (x1[2] + x1[3]);
                s = wave_sum(s); const float mu = s * (1.0f / 512.0f);
                x0 -= mu; x1 -= mu;
                float q = x0[0] * x0[0] + x0[1] * x0[1] + x0[2] * x0[2] + x0[3] * x0[3] + x1[0] * x1[0] + x1[1] * x1[1] + x1[2] * x1[2] + x1[3] * x1[3];
                q = wave_sum(q); const float rs = __builtin_amdgcn_rsqf(q * (1.0f / 512.0f) + EPS);
                x0 = x0 * rs * g0 + b0; x1 = x1 * rs * g1 + b1;
                x0 = x0 * sigmoid4(x0); x1 = x1 * sigmoid4(x1);
                *(u32x4*)(XC + (size_t)(tok0 + t) * 512 + 8 * lane) = pack8(x0, x1); }
            __syncthreads();
        }
#undef CONV_LOAD
    }

    {
        bf16_t* XP = X3;
        const int g = wid & 3, w = 2 << g, oct = g * 16 + (lane & 15), sub = (wid >> 2) * 4 + (lane >> 4);
        for (int it = bid; it < MTOK / 32; it += gridDim.x) {
            f32x4 s0[4], s1[4], c0[4], c1[4];
#pragma unroll
            for (int u = 0; u < 4; ++u) { s0[u] = (f32x4){0.f, 0.f, 0.f, 0.f}; s1[u] = s0[u]; c0[u] = s0[u]; c1[u] = s0[u]; }
            for (int j0 = 0; j0 < w; j0 += 4) {
                u32x4 wv[4][4];
#pragma unroll
                for (int jj = 0; jj < 4; ++jj)
#pragma unroll
                    for (int u = 0; u < 4; ++u) { const int j = j0 + jj, tok = it * 32 + 8 * u + sub, t = tok & (SEQ - 1); wv[jj][u] = (u32x4){0u, 0u, 0u, 0u};
                        if (j < w && j <= t) wv[jj][u] = *(const u32x4*)(ZP + (size_t)(tok - j) * 512 + 8 * oct); }
#pragma unroll
                for (int jj = 0; jj < 4; ++jj)
#pragma unroll
                    for (int u = 0; u < 4; ++u) { const f32x4 a = unpack_lo4(wv[jj][u]), b = unpack_hi4(wv[jj][u]); s0[u] += a; s1[u] += b; if (j0 + jj == 0) { c0[u] = a; c1[u] = b; } }
            }
#pragma unroll
            for (int u = 0; u < 4; ++u) { const int tok = it * 32 + 8 * u + sub, t = tok & (SEQ - 1);
                const float inv = 1.0f / (float)((t + 1) < w ? (t + 1) : w);
                *(u32x4*)(XP + (size_t)tok * 512 + 8 * oct) = pack8(s0[u] * inv - c0[u], s1[u] * inv - c1[u]); }
        }
    }
}

#define XB_TMO      128
#define XB_XCNT(j)  (256  + 64 * (j))
#define XB_XSUB(j)  (1280 + 64 * (j))
#define XB_XGEN(j)  (2304 + 64 * (j))
#define XB_TOP      3328
#define XB_TOPGEN   3392
#define XCD_BAR_WORDS 3456
#define XB_SPIN_CAP (1u << 18)
__device__ __forceinline__ unsigned xb_ld(unsigned* p)              { return __hip_atomic_load(p, __ATOMIC_RELAXED, __HIP_MEMORY_SCOPE_AGENT); }
__device__ __forceinline__ unsigned xb_add(unsigned* p, unsigned v) { return __hip_atomic_fetch_add(p, v, __ATOMIC_RELAXED, __HIP_MEMORY_SCOPE_AGENT); }
__device__ __forceinline__ unsigned xb_xcc_id() { return (unsigned)__builtin_amdgcn_s_getreg((3 << 11) | 20) & 0xFu; }
#define XB_SPIN(cond, bar) do { unsigned _sp = 0; while (cond) { __builtin_amdgcn_s_sleep(1); \
    if ((++_sp & 255u) == 0u) { if (xb_ld(&(bar)[XB_TMO])) break; if (_sp > XB_SPIN_CAP) { atomicAdd(&(bar)[XB_TMO], 1u); break; } } } } while (0)
struct XcdBarrier { unsigned* bar; unsigned x; volatile LAS unsigned* st; };
__device__ __forceinline__ XcdBarrier xcd_barrier_post(unsigned* bar, volatile LAS unsigned* st) {
    XcdBarrier b; b.bar = bar; b.x = xb_xcc_id(); b.st = st;
    if (threadIdx.x == 0) (void)xb_add(&bar[XB_XCNT(b.x)], 1u);
    return b;
}
__device__ __forceinline__ void xcd_barrier_complete(unsigned* bar, unsigned x, unsigned& nloc, unsigned& nx) {
    const unsigned G = gridDim.x * gridDim.y * gridDim.z;
    unsigned sum, cnt, mine, sp = 0u;
    for (;;) {
        sum = 0u; cnt = 0u; mine = 0u;
#pragma unroll
        for (unsigned j = 0; j < 16; ++j) { const unsigned c = xb_ld(&bar[XB_XCNT(j)]); sum += c; cnt += (c > 0u) ? 1u : 0u; mine = (j == x) ? c : mine; }
        if (sum == G) break;
        __builtin_amdgcn_s_sleep(1);
        if ((++sp & 255u) == 0u) { if (xb_ld(&bar[XB_TMO])) break; if (sp > XB_SPIN_CAP) { atomicAdd(&bar[XB_TMO], 1u); break; } }
    }
    nloc = mine > 0u ? mine : 1u; nx = cnt > 0u ? cnt : 1u;
}
__device__ __forceinline__ void xcd_barrier(const XcdBarrier& b) {
    asm volatile("s_waitcnt vmcnt(0)" ::: "memory");
    __syncthreads();
    if (threadIdx.x == 0) {
        unsigned* bar = b.bar;
        __builtin_amdgcn_s_waitcnt(0);
        unsigned nloc = b.st[0], nx = b.st[1];
        if (nloc == 0u) { xcd_barrier_complete(bar, b.x, nloc, nx); b.st[0] = nloc; b.st[1] = nx; }
        const unsigned old = xb_add(&bar[XB_XSUB(b.x)], 1u);
        const unsigned gen = old / nloc;
        if (old + 1u == (gen + 1u) * nloc) {
            __builtin_amdgcn_fence(__ATOMIC_RELEASE, "agent");
            asm volatile("s_waitcnt vmcnt(0)" ::: "memory");
            const unsigned og = xb_add(&bar[XB_TOP], 1u);
            const unsigned tg = og / nx;
            if (og + 1u == (tg + 1u) * nx) xb_add(&bar[XB_TOPGEN], 1u);
            else XB_SPIN(xb_ld(&bar[XB_TOPGEN]) == tg, bar);
            __builtin_amdgcn_fence(__ATOMIC_ACQUIRE, "agent");
            xb_add(&bar[XB_XGEN(b.x)], 1u);
            asm volatile("s_waitcnt vmcnt(0)" ::: "memory");
        } else {
            XB_SPIN(xb_ld(&bar[XB_XGEN(b.x)]) == gen, bar);
            __builtin_amdgcn_fence(__ATOMIC_ACQUIRE, "agent");
            asm volatile("s_waitcnt vmcnt(0)" ::: "memory");
        }
    }
    __syncthreads();
}

__device__ __forceinline__ void run_phase(const Params& P, int ph, LAS unsigned char* lds, const float rmul = 1.0f, const bool row_only = false) {
    GAS unsigned char* wsg = P.ws; GAS float* outg = P.out; int tid = threadIdx.x, bid = blockIdx.x;
    asm volatile("" : "+s"(wsg), "+s"(outg), "+v"(tid), "+s"(bid));
    unsigned char* ws = (unsigned char*)wsg; float* out = (float*)outg;
    unsigned char* big = ws + WS_BIG;
    bf16_t* HN = (bf16_t*)(ws + WS_HN); bf16_t* F = (bf16_t*)(ws + WS_F); bf16_t* F2 = (bf16_t*)(ws + WS_F2);
    const int G = gridDim.x, c = bid;
    constexpr unsigned PM = PHASE_MASK;
    if (ph == 0) {
        if (!(PM & (1u << 13))) return;
        prep_weights(P, ws, 0, lds, tid, bid);
        row_phase<true>(PIN(0), out, nullptr, 0.f, nullptr, PIN(2), HN, true, tid, bid);
        return;
    }
    const int l = (ph - 1) / 13, sub = (ph - 1) % 13;
    pg8::Order S;
    switch (sub) {
    case 0: case 8: if (PM & 1u) {
        pg8::Gemm g{HN, (const bf16_t*)(ws + (sub == 0 ? WS_WGU1 : WS_WGU2)), MTOK, NGU, DM}; S.init(MTOK, NGU, G, c, 1);
        pg8::EpiGLU E{(bf16_t*)(big + BIG_ACT)};
        pg8::gemm_phase(lds, g, S, E, tid);
        if (sub == 8) {
            pg8::Gemm g2{(const bf16_t*)(big + BIG_PB), (const bf16_t*)(ws + WS_WPP), MTOK, DM, PLE}; S.init(MTOK, DM, G, c, 1);
            pg8::EpiStore E2{(bf16_t*)(big + BIG_E)};
            pg8::gemm_phase(lds, g2, S, E2, tid);
        }
    } break;
    case 1: case 9: if (PM & 2u) {
        pg8::Gemm g{(const bf16_t*)(big + BIG_ACT), (const bf16_t*)(ws + (sub == 1 ? WS_WD1 : WS_WD2)), MTOK, DM, DFF}; S.init(MTOK, DM, G, c, 1);
        pg8::EpiStore E{F};
        pg8::gemm_phase(lds, g, S, E, tid);
    } break;
    case 2: if (PM & 4u) row_phase2<false>(l == 0 ? PIN(0) : (const float*)out, out, F, 0.5f, PIN(6) + l * DM, nullptr, 0.f, nullptr, PIN(7) + l * DM, HN, true, tid, bid); break;
    case 3: if (PM & 8u) {
        pg8::Gemm g{HN, (const bf16_t*)(ws + WS_WIN), MTOK, NIN, DM}; S.init(MTOK, NIN, G, c, 1);
        pg8::EpiIn E{(bf16_t*)(big + BIG_ZP), (bf16_t*)(big + BIG_U), (bf16_t*)(big + BIG_V), (bf16_t*)(big + BIG_XG), (bf16_t*)(big + BIG_GATES)};
        pg8::gemm_phase(lds, g, S, E, tid);
    } break;
    case 4: if (PM & 16u) mixer_phase(P, ws, l, lds, tid, bid); break;
    case 5: if (PM & 32u) {
        pg8::Gemm g{(const bf16_t*)(big + BIG_X3), (const bf16_t*)(ws + WS_WBR), MTOK, DM, 512}; S.init(MTOK, DM, G, c, 3);
        pg8::EpiBranch E{(const unsigned char*)(big + BIG_GATES), (bf16_t*)(big + BIG_MERGED)};
        pg8::gemm_phase(lds, g, S, E, tid);
    } break;
    case 6: if (PM & 64u) {
        pg8::Gemm g{(const bf16_t*)(big + BIG_MERGED), (const bf16_t*)(ws + WS_WOUT), MTOK, DM, DM}; S.init(MTOK, DM, G, c, 1);
        pg8::EpiStore E{F2};
        pg8::gemm_phase(lds, g, S, E, tid);
    } break;
    case 7: if (PM & 128u) {
        row_phase2<true>(l == 0 ? PIN(0) : (const float*)out, out, F, 0.5f, PIN(6) + l * DM, F2, 1.0f, PIN(23) + l * DM, PIN(24) + l * DM, HN, true, tid, bid);
        if (!row_only) convert_p(PIN(1) + (size_t)l * MTOK * PLE, (bf16_t*)(big + BIG_PB), tid, bid);
        } break;
    case 10: if (PM & 1024u) row_phase2<false>(out, out, F, 0.5f, PIN(28) + l * DM, nullptr, 0.f, nullptr, PIN(30) + l * DM, HN, true, tid, bid); break;
    case 11: if (PM & 2048u) {
        pg8::Gemm g{HN, (const bf16_t*)(ws + WS_WPG), MTOK, DM, DM}; S.init(MTOK, DM, G, c, 1);
        pg8::EpiPle E{(const bf16_t*)(big + BIG_E), F2};
        pg8::gemm_phase(lds, g, S, E, tid);
    } break;
    case 12: if (PM & 4096u) {
        row_phase2<true>(out, out, F, 0.5f, PIN(28) + l * DM, F2, 1.0f, PIN(32) + l * DM, PIN(2) + (l + 1 < NLAYER ? l + 1 : l) * DM, HN, l + 1 < NLAYER, tid, bid);
        if (l + 1 < NLAYER && !row_only) prep_weights(P, ws, l + 1, lds, tid, bid);
        } break;
    default: break;
    }
}

__global__ void __launch_bounds__(512, 2) mega(Params P) {
    extern __shared__ __attribute__((aligned(16))) unsigned char lds_raw[];
    LAS unsigned char* lds = (LAS unsigned char*)lds_raw;
    cg::grid_group grid = cg::this_grid();
#if !MULTI_LAUNCH
    volatile LAS unsigned* st = (volatile LAS unsigned*)(lds + LDS_BYTES - 16);
    if (threadIdx.x < 2) st[threadIdx.x] = 0u;
    __syncthreads();
    const XcdBarrier bar = xcd_barrier_post((unsigned*)((unsigned char*)P.ws + WS_BAR), st);
#endif
    for (int ph = P.ph_lo; ph < P.ph_hi; ++ph) {
        run_phase(P, ph, lds);
#if PROBE_DUP
        {
            const int sub = ph == 0 ? -1 : (ph - 1) % 13;
            const bool is_gemm = (sub == 0 || sub == 1 || sub == 3 || sub == 5 || sub == 6 || sub == 8 || sub == 9 || sub == 11);
            if (((PROBE_DUP & 1) && is_gemm) || ((PROBE_DUP & 2) && sub == 4)) { __syncthreads(); run_phase(P, ph, lds); }
#if !MULTI_LAUNCH
            if ((PROBE_DUP & 4) && ph > 0) xcd_barrier(bar);
#endif
        }
#endif
#if !MULTI_LAUNCH
        if (ph + 1 < P.ph_hi) { if (ph == 0) grid.sync(); else xcd_barrier(bar); }
#endif
    }
}

extern "C" void kernel_launch(void* const* d_in, const int* in_sizes, int n_in, void* d_out, int out_size, void* d_ws, size_t ws_size, hipStream_t stream) {
    static int grid = 0;
    if (grid == 0) {
        if (n_in != 33 || ws_size < WS_END) { fprintf(stderr, "kernel_launch: unexpected n_in %d or ws_size %zu (< %zu)\n", n_in, ws_size, (size_t)WS_END); grid = -1; return; }
        int dev = 0, cus = 0, per_cu = 0;
        hipGetDevice(&dev);
        hipDeviceGetAttribute(&cus, hipDeviceAttributeMultiprocessorCount, dev);
        if (hipFuncSetAttribute((const void*)mega, hipFuncAttributeMaxDynamicSharedMemorySize, LDS_BYTES) != hipSuccess) { fprintf(stderr, "kernel_launch: hipFuncSetAttribute failed\n"); grid = -1; return; }
        hipOccupancyMaxActiveBlocksPerMultiprocessor(&per_cu, (const void*)mega, 512, LDS_BYTES);
        if (per_cu < 1) per_cu = 1;
        (void)hipGetLastError();
        grid = cus * per_cu;
    }
    if (grid < 0) return;
    Params p{};
    for (int i = 0; i < 33; ++i) p.in[i] = (const GAS float*)d_in[i];
    p.out = (GAS float*)d_out; p.ws = (GAS unsigned char*)d_ws;
#if MULTI_LAUNCH
    for (int ph = 0; ph < NPHASE; ++ph) {
        p.ph_lo = ph; p.ph_hi = ph + 1;
        hipLaunchKernelGGL(mega, dim3(grid), dim3(512), LDS_BYTES, stream, p);
    }
#else
    p.ph_lo = 0; p.ph_hi = NPHASE;
    if (hipMemsetAsync((char*)d_ws + WS_BAR, 0, 16384, stream) != hipSuccess) { fprintf(stderr, "kernel_launch: memset of the barrier words failed\n"); return; }
    void* args[] = {&p};
    hipError_t e = hipLaunchCooperativeKernel((const void*)mega, dim3(grid), dim3(512), args, LDS_BYTES, stream);
    if (e != hipSuccess) fprintf(stderr, "cooperative launch failed: %s (grid %d)\n", hipGetErrorString(e), grid);
#endif
}
```

```cpp
#include <hip/hip_runtime.h>
#include <hip/hip_cooperative_groups.h>
#include <cstdio>
namespace cg = cooperative_groups;

#ifndef PHASE_MASK
#define PHASE_MASK 0xffffu
#endif
#ifndef PROBE_DUP
#define PROBE_DUP 0
#endif
#ifndef MULTI_LAUNCH
#define MULTI_LAUNCH 0
#endif

#define LAS __attribute__((address_space(3)))
typedef unsigned short bf16_t;
typedef short bf16x8 __attribute__((ext_vector_type(8)));
typedef float f32x4 __attribute__((ext_vector_type(4)));
typedef float f32x2 __attribute__((ext_vector_type(2)));
typedef unsigned u32x4 __attribute__((ext_vector_type(4)));
typedef unsigned u32x2 __attribute__((ext_vector_type(2)));

constexpr int MTOK = 32768, DM = 1024, DFF = 2816, SEQ = 4096, NLAYER = 4, PLE = 256;
constexpr int NGU = 2 * DFF;
constexpr int NIN = 5632;
constexpr float EPS = 1e-6f;
constexpr int LDS_BYTES = 147456;
constexpr int NPHASE = 1 + 13 * NLAYER;

constexpr size_t WS_WGU1 = 0;
constexpr size_t WS_WD1 = WS_WGU1 + (size_t)NGU * DM * 2;
constexpr size_t WS_WGU2 = WS_WD1 + (size_t)DM * DFF * 2;
constexpr size_t WS_WD2 = WS_WGU2 + (size_t)NGU * DM * 2;
constexpr size_t WS_WIN = WS_WD2 + (size_t)DM * DFF * 2;
constexpr size_t WS_WBR = WS_WIN + (size_t)NIN * DM * 2;
constexpr size_t WS_WOUT = WS_WBR + (size_t)3 * DM * 512 * 2;
constexpr size_t WS_WPG = WS_WOUT + (size_t)DM * DM * 2;
constexpr size_t WS_WPP = WS_WPG + (size_t)DM * DM * 2;
constexpr size_t WS_WSPK = WS_WPP + (size_t)DM * PLE * 2;
constexpr size_t WS_HN = WS_WSPK + (size_t)4 * 128 * 128 * 2;
constexpr size_t WS_F = WS_HN + (size_t)MTOK * DM * 2;
constexpr size_t WS_BIG = WS_F + (size_t)MTOK * DM * 2;
constexpr size_t BIG_ACT = 0;
constexpr size_t BIG_ZP = 0, BIG_U = (size_t)MTOK * 512 * 2, BIG_V = 2 * BIG_U, BIG_XG = 3 * BIG_U;
constexpr size_t BIG_GATES = 4 * BIG_U;
constexpr size_t BIG_X3 = BIG_GATES + (size_t)MTOK * 3072 * 2;
constexpr size_t BIG_MERGED = 0;
constexpr size_t BIG_E = (size_t)192 * 1024 * 1024;
constexpr size_t BIG_PB = BIG_X3;
constexpr size_t WS_BAR = WS_BIG + BIG_X3 + (size_t)3 * MTOK * 512 * 2;
constexpr size_t WS_F2 = WS_BAR + 16384;
constexpr size_t WS_END = WS_F2 + (size_t)MTOK * DM * 2;

#define GAS __attribute__((address_space(1)))
struct Params { const GAS float* in[33]; GAS float* out; GAS unsigned char* ws; int ph_lo, ph_hi; };
#define PIN(i) ((const float*)P.in[i])

typedef __bf16 bf16x2_t __attribute__((ext_vector_type(2)));
__device__ __forceinline__ unsigned cvt_pk_bf16(float lo, float hi) { const f32x2 v = {lo, hi}; return __builtin_bit_cast(unsigned, __builtin_convertvector(v, bf16x2_t)); }
__device__ __forceinline__ float bf_lo(unsigned w) { return __uint_as_float(w << 16); }
__device__ __forceinline__ float bf_hi(unsigned w) { return __uint_as_float(w & 0xffff0000u); }
__device__ __forceinline__ float sigmoid_f(float x) { return __builtin_amdgcn_rcpf(1.0f + __builtin_amdgcn_exp2f(-1.44269504f * x)); }
__device__ __forceinline__ float wave_sum(float v) {
#pragma unroll
    for (int o = 32; o >= 1; o >>= 1) v += __shfl_xor(v, o);
    return v;
}
__device__ __forceinline__ f32x2 gelu_pk(f32x2 v) {
    const f32x2 av = __builtin_elementwise_abs(v), d = av * 0.2316418882f + 1.0f;
    f32x2 t; t.x = __builtin_amdgcn_rcpf(d.x); t.y = __builtin_amdgcn_rcpf(d.y);
    f32x2 q = t * 0.5307027145f + (-0.7265760135f); q = q * t + 0.7107068705f; q = q * t + (-0.142248368f); q = q * t + 0.127414796f; q = q * t;
    const f32x2 s = (v * v) * (-0.72134752044f);
    f32x2 e; e.x = __builtin_amdgcn_exp2f(s.x); e.y = __builtin_amdgcn_exp2f(s.y);
    const f32x2 m = v * (q * e), r = v - m;
    f32x2 o; o.x = v.x < 0.f ? m.x : r.x; o.y = v.y < 0.f ? m.y : r.y; return o;
}
__device__ __forceinline__ f32x4 gelu4(f32x4 v) { f32x2 a = gelu_pk((f32x2){v[0], v[1]}), b = gelu_pk((f32x2){v[2], v[3]}); return (f32x4){a.x, a.y, b.x, b.y}; }
__device__ __forceinline__ f32x4 sigmoid4(f32x4 v) { return (f32x4){sigmoid_f(v[0]), sigmoid_f(v[1]), sigmoid_f(v[2]), sigmoid_f(v[3])}; }
__device__ __forceinline__ u32x4 pack8(f32x4 a, f32x4 b) { u32x4 w; w.x = cvt_pk_bf16(a[0], a[1]); w.y = cvt_pk_bf16(a[2], a[3]); w.z = cvt_pk_bf16(b[0], b[1]); w.w = cvt_pk_bf16(b[2], b[3]); return w; }
__device__ __forceinline__ f32x4 unpack_lo4(u32x4 w) { return (f32x4){bf_lo(w.x), bf_hi(w.x), bf_lo(w.y), bf_hi(w.y)}; }
__device__ __forceinline__ f32x4 unpack_hi4(u32x4 w) { return (f32x4){bf_lo(w.z), bf_hi(w.z), bf_lo(w.w), bf_hi(w.w)}; }

namespace pg8 {
constexpr int BM = 256, BK = 64, HALF = 128, HTB = HALF * BK * 2, STAGE_BYTES = 8 * HTB, NXCD = 8, WGM = 8;
__device__ __forceinline__ int lds_byte(int r, int c) { const int st = (r >> 4) * 2 + (c >> 5), rr = r & 15, cc = c & 31, ob = rr * 64 + cc * 2; return st * 1024 + (ob ^ (((ob >> 9) & 1) << 5)); }
__device__ __forceinline__ void stage_rc(int b, int& R, int& C) { const int st = b / 1024, sb = b % 1024, swz = sb ^ (((sb >> 9) & 1) << 5); R = (st >> 1) * 16 + swz / 64; C = (st & 1) * 32 + (swz % 64) / 2; }
__device__ __forceinline__ int perm32(int rho) { const int n = rho >> 4, i = rho & 15; return 8 * (i >> 2) + 4 * n + (i & 3); }

struct Unit { int pm, pn; };
struct Gemm { const bf16_t* A; const bf16_t* Bt; int M, N, K; };

struct Order {
    int nM, nN, nwg, G, c, zn;
    __device__ void init(int M, int N, int G_, int c_, int zn_) { nM = M / BM; nN = N / BM; nwg = nM * nN; G = G_; c = c_; zn = zn_; }
    __device__ bool next(int i, Unit& u) const {
        const int ti = i / zn, z = i - ti * zn;
        const long L = (long)ti * G + c; if (L >= nwg) return false;
        int wgid = (int)L; { const int q = nwg / NXCD, r = nwg % NXCD, xcd = wgid % NXCD, off = wgid / NXCD; wgid = (xcd < r ? xcd * (q + 1) : r * (q + 1) + (xcd - r) * q) + off; }
        const int nig = WGM * nN, gid = wgid / nig, fm = gid * WGM, gsz = (nM - fm) < WGM ? (nM - fm) : WGM;
        u.pm = z * nM + fm + ((wgid % nig) % gsz); u.pn = z * nN + (wgid % nig) / gsz; return true;
    }
};

template <class Epi>
__device__ __forceinline__ void gemm_phase(LAS unsigned char* lds, const Gemm g, const Order& S, const Epi& E, const int tid) {
    const int wid = __builtin_amdgcn_readfirstlane(tid >> 6), lane = tid & 63, wr = wid >> 2, wc = wid & 3, fr = lane & 15, fq = lane >> 4;
    const int K = g.K, nt = K / BK;
    unsigned voffA[2], voffB[2];
#pragma unroll
    for (int i = 0; i < 2; ++i) { int R, C; stage_rc(tid * 16 + i * 8192, R, C); const int Rb = (R & ~31) + perm32(R & 31);
        voffA[i] = (unsigned)(R * K + C) * 2u; voffB[i] = (unsigned)(Rb * K + C) * 2u; }
    const size_t kstep = (size_t)(BK * 2);
    const size_t hstep = (size_t)HALF * K * 2;
    const size_t tstep = 2 * hstep;
    const unsigned ldsw = (unsigned)wid * 1024u;
    const int aoff = lds_byte(wr * 64 + fr, fq * 8), boff = lds_byte(wc * 32 + fr, fq * 8);
#define PG8_SA(b, h) (((b) * 2 + (h)) * HTB)
#define PG8_SB(b, h) ((4 + (b) * 2 + (h)) * HTB)
#define PG8_STAGE(bufoff, gbase, voff) do { _Pragma("unroll") for (int _i = 0; _i < 2; ++_i) \
        __builtin_amdgcn_global_load_lds((const unsigned*)((const char*)(gbase) + (voff)[_i]), (LAS unsigned*)(lds + (bufoff) + ldsw + _i * 8192), 16, 0, 0); } while (0)
#define PG8_LDA(dst, b, h) do { _Pragma("unroll") for (int m = 0; m < 4; ++m) _Pragma("unroll") for (int k = 0; k < 2; ++k) dst[m][k] = *(const LAS bf16x8*)(lds + PG8_SA(b, h) + aoff + m * 2048 + k * 1024); } while (0)
#define PG8_LDB(dst, b, h) do { _Pragma("unroll") for (int n = 0; n < 2; ++n) _Pragma("unroll") for (int k = 0; k < 2; ++k) dst[n][k] = *(const LAS bf16x8*)(lds + PG8_SB(b, h) + boff + n * 2048 + k * 1024); } while (0)
#define PG8_MMA(ai, bj, At, Bt) do { __builtin_amdgcn_s_setprio(1); _Pragma("unroll") for (int m = 0; m < 4; ++m) _Pragma("unroll") for (int n = 0; n < 2; ++n) _Pragma("unroll") for (int k = 0; k < 2; ++k) \
        acc[ai][bj][m][n] = __builtin_amdgcn_mfma_f32_16x16x32_bf16(Bt[n][k], At[m][k], acc[ai][bj][m][n], 0, 0, 0); __builtin_amdgcn_s_setprio(0); } while (0)
#define PG8_WAIT_V(n) asm volatile("s_waitcnt vmcnt(" #n ")" ::: "memory")
#define PG8_WAIT_L(n) asm volatile("s_waitcnt lgkmcnt(" #n ")" ::: "memory")
#define PG8_BAR __builtin_amdgcn_s_barrier()
#define PG8_SCHED __builtin_amdgcn_sched_barrier(0)
    Unit cur, nxt; int ui = 0;
    if (!S.next(0, cur)) return;
    f32x4 acc[2][2][4][2];
#pragma unroll
    for (int a = 0; a < 2; ++a)
#pragma unroll
        for (int b = 0; b < 2; ++b)
#pragma unroll
            for (int m = 0; m < 4; ++m)
#pragma unroll
                for (int n = 0; n < 2; ++n) acc[a][b][m][n] = (f32x4){0.f, 0.f, 0.f, 0.f};
    bf16x8 At[4][2], B0[2][2], B1[2][2];
    const char* cA = (const char*)g.A + (size_t)cur.pm * tstep; const char* cB = (const char*)g.Bt + (size_t)cur.pn * tstep;
    PG8_STAGE(PG8_SB(0, 0), cB, voffB); PG8_STAGE(PG8_SA(0, 0), cA, voffA); PG8_STAGE(PG8_SB(0, 1), cB + hstep, voffB); PG8_STAGE(PG8_SA(0, 1), cA + hstep, voffA);
    if (wr == 1) PG8_BAR;
    PG8_WAIT_V(4); PG8_BAR;
    PG8_STAGE(PG8_SB(1, 0), cB + kstep, voffB); PG8_STAGE(PG8_SA(1, 0), cA + kstep, voffA); PG8_STAGE(PG8_SB(1, 1), cB + hstep + kstep, voffB);
    PG8_WAIT_V(6); PG8_BAR;
    for (;;) {
        const bool has_next = S.next(ui + 1, nxt);
        const char* nA = has_next ? (const char*)g.A + (size_t)nxt.pm * tstep : cA; const char* nB = has_next ? (const char*)g.Bt + (size_t)nxt.pn * tstep : cB;
        for (int t = 0; t < nt; t += 2) {
            const bool last = (t == nt - 2);
            const char* a1 = cA + (size_t)(t + 1) * kstep;
            const char* a2 = last ? nA : cA + (size_t)(t + 2) * kstep; const char* b2 = last ? nB : cB + (size_t)(t + 2) * kstep;
            const char* a3 = a2 + kstep; const char* b3 = b2 + kstep;
            PG8_LDB(B0, 0, 0); PG8_SCHED; PG8_LDA(At, 0, 0); PG8_STAGE(PG8_SA(1, 1), a1 + hstep, voffA);
            PG8_WAIT_L(8); PG8_BAR; PG8_WAIT_L(0); PG8_MMA(0, 0, At, B0); PG8_BAR; PG8_SCHED;
            PG8_LDB(B1, 0, 1); PG8_STAGE(PG8_SB(0, 0), b2, voffB);
            PG8_BAR; PG8_WAIT_L(0); PG8_MMA(0, 1, At, B1); PG8_BAR;
            PG8_LDA(At, 0, 1); PG8_STAGE(PG8_SA(0, 0), a2, voffA);
            PG8_BAR; PG8_WAIT_L(0); PG8_MMA(1, 0, At, B0); PG8_BAR; PG8_SCHED;
            PG8_STAGE(PG8_SB(0, 1), b2 + hstep, voffB);
            PG8_WAIT_V(6); PG8_BAR; PG8_MMA(1, 1, At, B1); PG8_BAR;
            PG8_LDB(B0, 1, 0); PG8_SCHED; PG8_LDA(At, 1, 0); PG8_STAGE(PG8_SA(0, 1), a2 + hstep, voffA);
            PG8_WAIT_L(8); PG8_BAR; PG8_WAIT_L(0); PG8_MMA(0, 0, At, B0); PG8_BAR; PG8_SCHED;
            PG8_LDB(B1, 1, 1); PG8_STAGE(PG8_SB(1, 0), b3, voffB);
            PG8_BAR; PG8_WAIT_L(0); PG8_MMA(0, 1, At, B1); PG8_BAR;
            PG8_LDA(At, 1, 1); PG8_STAGE(PG8_SA(1, 0), a3, voffA);
            PG8_BAR; PG8_WAIT_L(0); PG8_MMA(1, 0, At, B0); PG8_BAR; PG8_SCHED;
            PG8_STAGE(PG8_SB(1, 1), b3 + hstep, voffB);
            PG8_WAIT_V(6); PG8_BAR; PG8_MMA(1, 1, At, B1); PG8_BAR;
        }
        bool zero_acc = true;
        if constexpr (Epi::CHAIN) zero_acc = E.chain(acc, cur, wr, wc, fr, fq);
        else E(acc, cur, wr, wc, fr, fq);
        if (!has_next) break;
        if (zero_acc)
#pragma unroll
        for (int a = 0; a < 2; ++a)
#pragma unroll
            for (int b = 0; b < 2; ++b)
#pragma unroll
                for (int m = 0; m < 4; ++m)
#pragma unroll
                    for (int n = 0; n < 2; ++n) acc[a][b][m][n] = (f32x4){0.f, 0.f, 0.f, 0.f};
        cur = nxt; cA = nA; cB = nB; ++ui;
    }
    PG8_WAIT_V(0);
    if (wr == 0) PG8_BAR;
    PG8_BAR;
#undef PG8_SA
#undef PG8_SB
#undef PG8_STAGE
#undef PG8_LDA
#undef PG8_LDB
#undef PG8_MMA
#undef PG8_WAIT_V
#undef PG8_WAIT_L
#undef PG8_BAR
#undef PG8_SCHED
}

typedef f32x4 Acc[2][2][4][2];
template <int ACT, int LDC> __device__ __forceinline__ void glu_store(const Acc& acc, char* ub, unsigned lane_off) {
#pragma unroll
    for (int ai = 0; ai < 2; ++ai)
#pragma unroll
        for (int m = 0; m < 4; ++m) {
            char* rp = ub + (size_t)(ai * HALF + m * 16) * LDC * 2;
            f32x4 v[2];
#pragma unroll
            for (int n = 0; n < 2; ++n) { const f32x4 a = acc[ai][0][m][n], b = acc[ai][1][m][n];
                if (ACT == 0) v[n] = a * sigmoid4(a) * b; else v[n] = a * sigmoid4(b); }
            *(u32x4*)(rp + lane_off) = pack8(v[0], v[1]);
        }
}
template <int LDC> __device__ __forceinline__ unsigned lane_off_of(int wr, int wc, int fr, int fq) { return (unsigned)((wr * 64 + fr) * LDC + wc * 32 + 8 * fq) * 2u; }
struct EpiGLU {
    static constexpr bool CHAIN = false;
    bf16_t* O;
    __device__ __forceinline__ void operator()(const Acc& acc, const Unit& u, int wr, int wc, int fr, int fq) const {
        glu_store<0, DFF>(acc, (char*)O + ((size_t)u.pm * BM * DFF + (size_t)u.pn * 128) * 2, lane_off_of<DFF>(wr, wc, fr, fq));
    }
};
template <int ACT, int LDC> __device__ __forceinline__ void plain_store(const Acc& acc, char* ub, unsigned lane_off) {
#pragma unroll
    for (int ai = 0; ai < 2; ++ai)
#pragma unroll
        for (int m = 0; m < 4; ++m) {
            char* rp = ub + (size_t)(ai * HALF + m * 16) * LDC * 2;
#pragma unroll
            for (int bj = 0; bj < 2; ++bj) { f32x4 v0 = acc[ai][bj][m][0], v1 = acc[ai][bj][m][1];
                if (ACT == 1) { v0 = gelu4(v0); v1 = gelu4(v1); }
                if (ACT == 2) { v0 = sigmoid4(v0); v1 = sigmoid4(v1); }
                *(u32x4*)(rp + bj * HALF * 2 + lane_off) = pack8(v0, v1); }
        }
}
struct EpiStore {
    static constexpr bool CHAIN = false;
    bf16_t* O;
    __device__ __forceinline__ void operator()(const Acc& acc, const Unit& u, int wr, int wc, int fr, int fq) const {
        plain_store<0, DM>(acc, (char*)O + ((size_t)u.pm * BM * DM + (size_t)u.pn * BM) * 2, lane_off_of<DM>(wr, wc, fr, fq));
    }
};
struct EpiIn {
    static constexpr bool CHAIN = false;
    bf16_t *ZP, *U, *V, *XG, *GATES;
    __device__ __forceinline__ void operator()(const Acc& acc, const Unit& u, int wr, int wc, int fr, int fq) const {
        const int pn = u.pn; const size_t rb = (size_t)u.pm * BM;
        if (pn >= 10) {
            char* ub = (char*)GATES + rb * 3072 + (size_t)(pn - 10) * 256; const unsigned lo = (unsigned)((wr * 64 + fr) * 3072 + wc * 32 + 8 * fq);
#pragma unroll
            for (int ai = 0; ai < 2; ++ai)
#pragma unroll
                for (int m = 0; m < 4; ++m)
#pragma unroll
                    for (int bj = 0; bj < 2; ++bj) {
                        const f32x4 v0 = sigmoid4(acc[ai][bj][m][0]) * 255.0f, v1 = sigmoid4(acc[ai][bj][m][1]) * 255.0f;
                        u32x2 w; w.x = 0u; w.y = 0u;
                        w.x = __builtin_amdgcn_cvt_pk_u8_f32(v0[0], 0, w.x); w.x = __builtin_amdgcn_cvt_pk_u8_f32(v0[1], 1, w.x); w.x = __builtin_amdgcn_cvt_pk_u8_f32(v0[2], 2, w.x); w.x = __builtin_amdgcn_cvt_pk_u8_f32(v0[3], 3, w.x);
                        w.y = __builtin_amdgcn_cvt_pk_u8_f32(v1[0], 0, w.y); w.y = __builtin_amdgcn_cvt_pk_u8_f32(v1[1], 1, w.y); w.y = __builtin_amdgcn_cvt_pk_u8_f32(v1[2], 2, w.y); w.y = __builtin_amdgcn_cvt_pk_u8_f32(v1[3], 3, w.y);
                        *(u32x2*)(ub + (size_t)(ai * HALF + m * 16) * 3072 + bj * HALF + lo) = w;
                    }
        }
        else {
            const unsigned lo = lane_off_of<512>(wr, wc, fr, fq);
            if (pn >= 6) glu_store<1, 512>(acc, (char*)XG + (rb * 512 + (size_t)(pn - 6) * 128) * 2, lo);
            else if (pn < 2) plain_store<0, 512>(acc, (char*)ZP + (rb * 512 + (size_t)pn * 256) * 2, lo);
            else { char* ub = (char*)(pn < 4 ? U : V) + (rb * 512 + (size_t)(pn & 1) * 256) * 2; plain_store<1, 512>(acc, ub, lo); }
        }
    }
};
struct EpiBranch {
    static constexpr bool CHAIN = true;
    const unsigned char* GATES; bf16_t* MG;
    static __device__ __forceinline__ f32x4 code4(unsigned w) { return (f32x4){__builtin_fmaxf((float)(w & 255u), 0.25f), __builtin_fmaxf((float)((w >> 8) & 255u), 0.25f), __builtin_fmaxf((float)((w >> 16) & 255u), 0.25f), __builtin_fmaxf((float)(w >> 24), 0.25f)}; }
    static __device__ __forceinline__ f32x4 rcp4(f32x4 v) { return (f32x4){__builtin_amdgcn_rcpf(v[0]), __builtin_amdgcn_rcpf(v[1]), __builtin_amdgcn_rcpf(v[2]), __builtin_amdgcn_rcpf(v[3])}; }
    __device__ __forceinline__ bool chain(Acc& acc, const Unit& u, int wr, int wc, int fr, int fq) const {
        const int z = u.pn >> 2, pn = u.pn & 3, pm = u.pm - z * 128;
        const bool fin = (z == 2);
        const char* gb = (const char*)GATES + (size_t)pm * BM * 3072 + (size_t)z * 1024 + (size_t)pn * BM;
        const char* gn = fin ? gb : gb + 1024;
        const unsigned glo = (unsigned)((wr * 64 + fr) * 3072 + wc * 32 + 8 * fq);
        char* mb = (char*)MG + ((size_t)pm * BM * DM + (size_t)pn * BM) * 2;
        const unsigned mlo = lane_off_of<DM>(wr, wc, fr, fq);
        constexpr float q = 1.0f / 255.0f;
        u32x2 g0[2][4][2], g1[2][4][2];
#pragma unroll
        for (int ai = 0; ai < 2; ++ai)
#pragma unroll
            for (int m = 0; m < 4; ++m)
#pragma unroll
                for (int bj = 0; bj < 2; ++bj) {
                    g0[ai][m][bj] = *(const u32x2*)(gb + (size_t)(ai * HALF + m * 16) * 3072 + bj * HALF + glo);
                    g1[ai][m][bj] = *(const u32x2*)(gn + (size_t)(ai * HALF + m * 16) * 3072 + bj * HALF + glo);
                }
#pragma unroll
        for (int ai = 0; ai < 2; ++ai)
#pragma unroll
            for (int m = 0; m < 4; ++m)
#pragma unroll
                for (int bj = 0; bj < 2; ++bj) {
                    const f32x4 d0 = rcp4(code4(g1[ai][m][bj].x)), d1 = rcp4(code4(g1[ai][m][bj].y));
                    acc[ai][bj][m][0] *= code4(g0[ai][m][bj].x) * (fin ? (f32x4){q, q, q, q} : d0);
                    acc[ai][bj][m][1] *= code4(g0[ai][m][bj].y) * (fin ? (f32x4){q, q, q, q} : d1);
                    if (fin) *(u32x4*)(mb + (size_t)(ai * HALF + m * 16) * DM * 2 + bj * HALF * 2 + mlo) = pack8(acc[ai][bj][m][0], acc[ai][bj][m][1]);
                }
        return fin;
    }
};
struct EpiPle {
    static constexpr bool CHAIN = false;
    const bf16_t* E; bf16_t* O;
    __device__ __forceinline__ void operator()(const Acc& acc, const Unit& u, int wr, int wc, int fr, int fq) const {
        const size_t uo = ((size_t)u.pm * BM * DM + (size_t)u.pn * BM) * 2;
        const char* eb = (const char*)E + uo; char* ob = (char*)O + uo;
        const unsigned lo = lane_off_of<DM>(wr, wc, fr, fq);
        u32x4 ew[2][4][2];
#pragma unroll
        for (int ai = 0; ai < 2; ++ai)
#pragma unroll
            for (int m = 0; m < 4; ++m)
#pragma unroll
                for (int bj = 0; bj < 2; ++bj) ew[ai][m][bj] = *(const u32x4*)(eb + (size_t)(ai * HALF + m * 16) * DM * 2 + bj * HALF * 2 + lo);
#pragma unroll
        for (int ai = 0; ai < 2; ++ai)
#pragma unroll
            for (int m = 0; m < 4; ++m)
#pragma unroll
                for (int bj = 0; bj < 2; ++bj) {
                    const f32x4 v0 = sigmoid4(acc[ai][bj][m][0]) * unpack_lo4(ew[ai][m][bj]), v1 = sigmoid4(acc[ai][bj][m][1]) * unpack_hi4(ew[ai][m][bj]);
                    *(u32x4*)(ob + (size_t)(ai * HALF + m * 16) * DM * 2 + bj * HALF * 2 + lo) = pack8(v0, v1);
                }
    }
};
}

template <bool INIT>
__device__ __forceinline__ void row_phase(const float* hin, float* h, const bf16_t* F, float cscale, const float* ga, const float* gb, bf16_t* HN, bool write_hn, const int tid, const int bid) {
    const int wid = tid >> 6, lane = tid & 63;
    constexpr int R = 4;
    f32x4 gav[4], gbv[4];
#pragma unroll
    for (int k = 0; k < 4; ++k) {
        gav[k] = INIT ? (f32x4){0.f, 0.f, 0.f, 0.f} : *(const f32x4*)(ga + 256 * k + 4 * lane);
        gbv[k] = write_hn ? *(const f32x4*)(gb + 256 * k + 4 * lane) : (f32x4){0.f, 0.f, 0.f, 0.f};
    }
    for (int row0 = (bid * 8 + wid) * R; row0 < MTOK; row0 += gridDim.x * 8 * R) {
        f32x4 hv[R][4]; u32x2 fw[R][4];
#pragma unroll
        for (int r = 0; r < R; ++r) { const size_t ro = (size_t)(row0 + r) * DM + 4 * lane;
#pragma unroll
            for (int k = 0; k < 4; ++k) {
                hv[r][k] = *(const f32x4*)(hin + ro + 256 * k);
                if (!INIT) fw[r][k] = *(const u32x2*)(F + ro + 256 * k);
            } }
#pragma unroll
        for (int r = 0; r < R; ++r) { const size_t ro = (size_t)(row0 + r) * DM + 4 * lane;
            if (!INIT) {
                f32x4 fv[4];
#pragma unroll
                for (int k = 0; k < 4; ++k) fv[k] = (f32x4){bf_lo(fw[r][k].x), bf_hi(fw[r][k].x), bf_lo(fw[r][k].y), bf_hi(fw[r][k].y)};
                float ss = 0.f;
#pragma unroll
                for (int i = 0; i < 4; ++i) ss += fv[i][0] * fv[i][0] + fv[i][1] * fv[i][1] + fv[i][2] * fv[i][2] + fv[i][3] * fv[i][3];
                ss = wave_sum(ss);
                const float rs = cscale * __builtin_amdgcn_rsqf(ss * (1.0f / DM) + EPS);
#pragma unroll
                for (int i = 0; i < 4; ++i) hv[r][i] += fv[i] * gav[i] * rs;
            }
            float s2 = 0.f;
#pragma unroll
            for (int i = 0; i < 4; ++i) s2 += hv[r][i][0] * hv[r][i][0] + hv[r][i][1] * hv[r][i][1] + hv[r][i][2] * hv[r][i][2] + hv[r][i][3] * hv[r][i][3];
            s2 = wave_sum(s2);
            const float rs2 = __builtin_amdgcn_rsqf(s2 * (1.0f / DM) + EPS);
            if (!INIT) { _Pragma("unroll") for (int k = 0; k < 4; ++k) *(f32x4*)(h + ro + 256 * k) = hv[r][k]; }
            if (write_hn) {
#pragma unroll
                for (int k = 0; k < 4; ++k) { const f32x4 o = hv[r][k] * gbv[k] * rs2; u32x2 w; w.x = cvt_pk_bf16(o[0], o[1]); w.y = cvt_pk_bf16(o[2], o[3]); *(u32x2*)(HN + ro + 256 * k) = w; }
            }
        }
    }
}

__device__ __forceinline__ f32x4 bf4(u32x2 w) { return (f32x4){bf_lo(w.x), bf_hi(w.x), bf_lo(w.y), bf_hi(w.y)}; }
__device__ __forceinline__ float sumsq16(const f32x4 (&v)[4]) { float s = 0.f;
#pragma unroll
    for (int i = 0; i < 4; ++i) s += v[i][0] * v[i][0] + v[i][1] * v[i][1] + v[i][2] * v[i][2] + v[i][3] * v[i][3];
    return s; }
template <bool FULL>
__device__ __forceinline__ void row_phase2(const float* hin, float* h, const bf16_t* F1, float c1, const float* ga1, const bf16_t* F2, float c2, const float* ga2, const float* gb, bf16_t* HN, bool write_hn, const int tid, const int bid) {
    const int wid = tid >> 6, lane = tid & 63;
    constexpr int R = FULL ? 2 : 4;
    f32x4 g1v[4], g2v[4], gbv[4];
#pragma unroll
    for (int k = 0; k < 4; ++k) {
        g1v[k] = *(const f32x4*)(ga1 + 256 * k + 4 * lane);
        g2v[k] = FULL ? *(const f32x4*)(ga2 + 256 * k + 4 * lane) : (f32x4){0.f, 0.f, 0.f, 0.f};
        gbv[k] = write_hn ? *(const f32x4*)(gb + 256 * k + 4 * lane) : (f32x4){0.f, 0.f, 0.f, 0.f};
    }
    for (int row0 = (bid * 8 + wid) * R; row0 < MTOK; row0 += gridDim.x * 8 * R) {
        f32x4 hv[R][4]; u32x2 fa[R][4], fb[R][4];
#pragma unroll
        for (int r = 0; r < R; ++r) { const size_t ro = (size_t)(row0 + r) * DM + 4 * lane;
#pragma unroll
            for (int k = 0; k < 4; ++k) {
                hv[r][k] = *(const f32x4*)(hin + ro + 256 * k);
                fa[r][k] = *(const u32x2*)(F1 + ro + 256 * k);
                if (FULL) fb[r][k] = *(const u32x2*)(F2 + ro + 256 * k);
            } }
#pragma unroll
        for (int r = 0; r < R; ++r) { const size_t ro = (size_t)(row0 + r) * DM + 4 * lane;
            {
                f32x4 fv[4];
#pragma unroll
                for (int k = 0; k < 4; ++k) fv[k] = bf4(fa[r][k]);
                const float rs = c1 * __builtin_amdgcn_rsqf(wave_sum(sumsq16(fv)) * (1.0f / DM) + EPS);
#pragma unroll
                for (int i = 0; i < 4; ++i) hv[r][i] += fv[i] * g1v[i] * rs;
            }
            if (FULL) {
                f32x4 fv[4];
#pragma unroll
                for (int k = 0; k < 4; ++k) fv[k] = bf4(fb[r][k]);
                const float rs = c2 * __builtin_amdgcn_rsqf(wave_sum(sumsq16(fv)) * (1.0f / DM) + EPS);
#pragma unroll
                for (int i = 0; i < 4; ++i) hv[r][i] += fv[i] * g2v[i] * rs;
#pragma unroll
                for (int k = 0; k < 4; ++k) *(f32x4*)(h + ro + 256 * k) = hv[r][k];
            }
            if (write_hn) {
                const float rs2 = __builtin_amdgcn_rsqf(wave_sum(sumsq16(hv[r])) * (1.0f / DM) + EPS);
#pragma unroll
                for (int k = 0; k < 4; ++k) { const f32x4 o = hv[r][k] * gbv[k] * rs2; u32x2 w; w.x = cvt_pk_bf16(o[0], o[1]); w.y = cvt_pk_bf16(o[2], o[3]); *(u32x2*)(HN + ro + 256 * k) = w; }
            }
        }
    }
}

struct PrepJob { const float* src; bf16_t* dst; int ld, col0, k0, K, n0; };
__device__ __forceinline__ PrepJob prep_job(const Params& P, unsigned char* ws, int l, int tix) {
    constexpr int T_GU = (NGU / 64) * (DM / 64), T_D = (DM / 64) * (DFF / 64), T_IN = (NIN / 64) * (DM / 64), T_BR = (DM / 64) * (512 / 64), T_SQ = (DM / 64) * (DM / 64);
    int t = tix; const float* srcA; const float* srcB; int ld, mode, K; bf16_t* dst;
    if (t < T_GU) { srcA = PIN(3) + (size_t)l * DM * DFF; srcB = PIN(4) + (size_t)l * DM * DFF; ld = DFF; mode = 1; K = DM; dst = (bf16_t*)(ws + WS_WGU1); }
    else if ((t -= T_GU) < T_GU) { srcA = PIN(25) + (size_t)l * DM * DFF; srcB = PIN(26) + (size_t)l * DM * DFF; ld = DFF; mode = 1; K = DM; dst = (bf16_t*)(ws + WS_WGU2); }
    else if ((t -= T_GU) < T_D) { srcA = PIN(5) + (size_t)l * DFF * DM; srcB = srcA; ld = DM; mode = 0; K = DFF; dst = (bf16_t*)(ws + WS_WD1); }
    else if ((t -= T_D) < T_D) { srcA = PIN(27) + (size_t)l * DFF * DM; srcB = srcA; ld = DM; mode = 0; K = DFF; dst = (bf16_t*)(ws + WS_WD2); }
    else if ((t -= T_D) < T_IN) { srcA = PIN(8) + (size_t)l * DM * NIN; srcB = srcA; ld = NIN; mode = 2; K = DM; dst = (bf16_t*)(ws + WS_WIN); }
    else if ((t -= T_IN) < T_BR) { srcA = PIN(16) + (size_t)l * 512 * DM; srcB = srcA; ld = DM; mode = 0; K = 512; dst = (bf16_t*)(ws + WS_WBR) + (size_t)1 * DM * 512; }
    else if ((t -= T_BR) < T_BR) { srcA = PIN(21) + (size_t)l * 512 * DM; srcB = srcA; ld = DM; mode = 0; K = 512; dst = (bf16_t*)(ws + WS_WBR) + (size_t)2 * DM * 512; }
    else if ((t -= T_BR) < T_SQ) { srcA = PIN(22) + (size_t)l * DM * DM; srcB = srcA; ld = DM; mode = 0; K = DM; dst = (bf16_t*)(ws + WS_WOUT); }
    else if ((t -= T_SQ) < T_SQ) { srcA = PIN(31) + (size_t)l * DM * DM; srcB = srcA; ld = DM; mode = 0; K = DM; dst = (bf16_t*)(ws + WS_WPG); }
    else { t -= T_SQ; srcA = PIN(29) + (size_t)l * PLE * DM; srcB = srcA; ld = DM; mode = 0; K = PLE; dst = (bf16_t*)(ws + WS_WPP); }
    const int tk = K / 64, tn = t / tk, tkk = t - tn * tk, n0 = tn * 64, k0 = tkk * 64;
    const float* src = srcA; int col0 = n0;
    if (mode == 1) { const int tt = n0 >> 8, j = n0 & 255; if (j < 128) { col0 = 128 * tt + j; } else { src = srcB; col0 = 128 * tt + j - 128; } }
    else if (mode == 2) { if (n0 >= 1536 && n0 < 2560) { const int tt = (n0 - 1536) >> 8, j = (n0 - 1536) & 255; col0 = (j < 128) ? (1536 + 128 * tt + j) : (2048 + 128 * tt + j - 128); } }
    PrepJob J; J.src = src; J.dst = dst; J.ld = ld; J.col0 = col0; J.k0 = k0; J.K = K; J.n0 = n0; return J;
}

__device__ __forceinline__ void prep_weights(const Params& P, unsigned char* ws, int l, LAS unsigned char* lds, const int tid, const int bid) {
    LAS float* tile = (LAS float*)lds;
    constexpr int T_GU = (NGU / 64) * (DM / 64), T_D = (DM / 64) * (DFF / 64), T_IN = (NIN / 64) * (DM / 64), T_BR = (DM / 64) * (512 / 64), T_SQ = (DM / 64) * (DM / 64), T_PP = (DM / 64) * (PLE / 64);
    constexpr int TOTAL = 2 * T_GU + 2 * T_D + T_IN + 2 * T_BR + 2 * T_SQ + T_PP;
    {
        const int kk = tid >> 4, c4 = tid & 15, n = tid >> 3, k8 = tid & 7;
        f32x4 v0, v1; int tix = bid;
        if (tix < TOTAL) { const PrepJob J = prep_job(P, ws, l, tix); const float* sp = J.src + (size_t)(J.k0 + kk) * J.ld + J.col0 + 4 * c4; v0 = *(const f32x4*)sp; v1 = *(const f32x4*)(sp + (size_t)32 * J.ld); }
        for (; tix < TOTAL; tix += gridDim.x) {
            const PrepJob J = prep_job(P, ws, l, tix);
#pragma unroll
            for (int e = 0; e < 4; ++e) { tile[kk * 65 + 4 * c4 + e] = v0[e]; tile[(kk + 32) * 65 + 4 * c4 + e] = v1[e]; }
            __syncthreads();
            const int nx = tix + gridDim.x;
            if (nx < TOTAL) { const PrepJob Jn = prep_job(P, ws, l, nx); const float* sp = Jn.src + (size_t)(Jn.k0 + kk) * Jn.ld + Jn.col0 + 4 * c4; v0 = *(const f32x4*)sp; v1 = *(const f32x4*)(sp + (size_t)32 * Jn.ld); }
            float v[8];
#pragma unroll
            for (int i = 0; i < 8; ++i) v[i] = tile[(8 * k8 + i) * 65 + n];
            u32x4 w; w.x = cvt_pk_bf16(v[0], v[1]); w.y = cvt_pk_bf16(v[2], v[3]); w.z = cvt_pk_bf16(v[4], v[5]); w.w = cvt_pk_bf16(v[6], v[7]);
            *(u32x4*)(J.dst + (size_t)(J.n0 + n) * J.K + J.k0 + 8 * k8) = w;
            __syncthreads();
        }
    }
    {
        const float* pw = PIN(9) + (size_t)l * 4 * 128 * 128; const float* sc = PIN(10) + (size_t)l * 512; const float* wpo = PIN(11) + (size_t)l * 512 * DM;
        bf16_t* dst = (bf16_t*)(ws + WS_WBR);
        const int ol = tid & 63, i4 = __builtin_amdgcn_readfirstlane(tid >> 6);
        for (int tix = bid; tix < 16 * 16; tix += gridDim.x) {
            const int o = (tix >> 4) * 64 + ol, g = (tix >> 2) & 3, i0 = (tix & 3) * 32 + i4 * 4;
            float a[4] = {0.f, 0.f, 0.f, 0.f};
#pragma unroll 4
            for (int j = 0; j < 128; j += 4) {
                const f32x4 s4 = *(const f32x4*)(sc + g * 128 + j);
                float w[4];
#pragma unroll
                for (int jj = 0; jj < 4; ++jj) w[jj] = wpo[(size_t)(g * 128 + j + jj) * DM + o] * s4[jj];
#pragma unroll
                for (int ii = 0; ii < 4; ++ii) { const f32x4 p4 = *(const f32x4*)(pw + (size_t)(g * 128 + i0 + ii) * 128 + j);
                    a[ii] += p4[0] * w[0] + p4[1] * w[1] + p4[2] * w[2] + p4[3] * w[3]; }
            }
            u32x2 w2; w2.x = cvt_pk_bf16(a[0], a[1]); w2.y = cvt_pk_bf16(a[2], a[3]);
            *(u32x2*)(dst + (size_t)o * 512 + g * 128 + i0) = w2;
        }
    }
    {
        const float* wsrc = PIN(14) + (size_t)l * 4 * 128 * 128; bf16_t* dst = (bf16_t*)(ws + WS_WSPK);
        for (int idx = bid * 512 + tid; idx < 4 * 128 * 128 / 8; idx += gridDim.x * 512) {
            const int fq = idx & 3, kk = (idx >> 2) & 3, t = (idx >> 4) & 127, h = idx >> 11;
            float v[8];
#pragma unroll
            for (int i = 0; i < 8; ++i) { const int sp = 32 * kk + 4 * i + fq; v[i] = (sp <= t) ? wsrc[(size_t)(h * 128 + t) * 128 + sp] : 0.f; }
            u32x4 w4; w4.x = cvt_pk_bf16(v[0], v[1]); w4.y = cvt_pk_bf16(v[2], v[3]); w4.z = cvt_pk_bf16(v[4], v[5]); w4.w = cvt_pk_bf16(v[6], v[7]);
            *(u32x4*)(dst + (size_t)idx * 8) = w4;
        }
    }
}

__device__ __forceinline__ void convert_p(const float* p, bf16_t* PB, const int tid, const int bid) {
    for (size_t idx = (size_t)bid * 512 + tid; idx < (size_t)MTOK * PLE / 8; idx += (size_t)gridDim.x * 512) {
        const f32x4 a = *(const f32x4*)(p + idx * 8), b = *(const f32x4*)(p + idx * 8 + 4);
        *(u32x4*)(PB + idx * 8) = pack8(a, b);
    }
}

template <int W>
__device__ __forceinline__ void pool_run(const bf16_t* ZP, bf16_t* XP, const int oct, const int sub, const int bid) {
    for (int it = bid; it < MTOK / 32; it += gridDim.x) {
        const int tok0 = it * 32 + 4 * sub, t0 = tok0 & (SEQ - 1);
        const bf16_t* zp = ZP + (size_t)tok0 * 512 + 8 * oct;
        u32x4 row[W + 3];
#pragma unroll
        for (int j = 0; j < W + 3; ++j) { row[j] = (u32x4){0u, 0u, 0u, 0u}; if (t0 + 3 - j >= 0) row[j] = *(const u32x4*)(zp + (ptrdiff_t)(3 - j) * 512); }
        f32x4 s0 = (f32x4){0.f, 0.f, 0.f, 0.f}, s1 = s0;
#pragma unroll
        for (int j = 0; j < W; ++j) { s0 += unpack_lo4(row[j]); s1 += unpack_hi4(row[j]); }
        f32x4 o0[4], o1[4]; o0[3] = s0; o1[3] = s1;
#pragma unroll
        for (int d = 0; d < 3; ++d) { s0 += unpack_lo4(row[W + d]) - unpack_lo4(row[d]); s1 += unpack_hi4(row[W + d]) - unpack_hi4(row[d]); o0[2 - d] = s0; o1[2 - d] = s1; }
#pragma unroll
        for (int u = 0; u < 4; ++u) { const int t = t0 + u; const float inv = 1.0f / (float)((t + 1) < W ? (t + 1) : W);
            *(u32x4*)(XP + (size_t)(tok0 + u) * 512 + 8 * oct) = pack8(o0[u] * inv - unpack_lo4(row[3 - u]), o1[u] * inv - unpack_hi4(row[3 - u])); }
    }
}

__device__ __forceinline__ void mixer_phase(const Params& P, unsigned char* ws, int l, LAS unsigned char* lds, const int tid, const int bid) {
    unsigned char* big = ws + WS_BIG;
    const bf16_t* ZP = (const bf16_t*)(big + BIG_ZP); const bf16_t* U = (const bf16_t*)(big + BIG_U); const bf16_t* V = (const bf16_t*)(big + BIG_V); const bf16_t* XG = (const bf16_t*)(big + BIG_XG);
    bf16_t* X3 = (bf16_t*)(big + BIG_X3);
    const int wid = __builtin_amdgcn_readfirstlane(tid >> 6), lane = tid & 63;

    {
        const float* lng = PIN(12) + (size_t)l * 512; const float* lnb = PIN(13) + (size_t)l * 512; const float* bsp = PIN(15) + (size_t)l * 4 * 128;
        const bf16_t* WSPK = (const bf16_t*)(ws + WS_WSPK);
        bf16_t* XS = X3 + (size_t)1 * MTOK * 512;
        const int fr = lane & 15, fq = lane >> 4, h = wid >> 1, th = wid & 1;
        constexpr int VP = 528;
        for (int ch = bid; ch < MTOK / 128; ch += gridDim.x) {
            const size_t tok0 = (size_t)ch * 128;
            {
                const f32x4 g0 = *(const f32x4*)(lng + 8 * lane), g1 = *(const f32x4*)(lng + 8 * lane + 4), b0 = *(const f32x4*)(lnb + 8 * lane), b1 = *(const f32x4*)(lnb + 8 * lane + 4);
#pragma unroll
                for (int i0 = 0; i0 < 16; i0 += 8) {
                    u32x4 wv[8];
#pragma unroll
                    for (int i = 0; i < 8; ++i) wv[i] = *(const u32x4*)(V + (tok0 + wid * 16 + i0 + i) * 512 + 8 * lane);
#pragma unroll
                    for (int i = 0; i < 8; ++i) {
                        const int sp = wid * 16 + i0 + i;
                        f32x4 x0 = unpack_lo4(wv[i]), x1 = unpack_hi4(wv[i]);
                        float s = (x0[0] + x0[1]) + (x0[2] + x0[3]) + (x1[0] + x1[1]) + (x1[2] + x1[3]);
                        s = wave_sum(s); const float mu = s * (1.0f / 512.0f);
                        x0 -= mu; x1 -= mu;
                        float q = x0[0] * x0[0] + x0[1] * x0[1] + x0[2] * x0[2] + x0[3] * x0[3] + x1[0] * x1[0] + x1[1] * x1[1] + x1[2] * x1[2] + x1[3] * x1[3];
                        q = wave_sum(q); const float rs = __builtin_amdgcn_rsqf(q * (1.0f / 512.0f) + EPS);
                        x0 = x0 * rs * g0 + b0; x1 = x1 * rs * g1 + b1;
                        *(LAS u32x4*)(lds + (size_t)sp * (VP * 2) + 16 * lane) = pack8(x0, x1);
                    }
                }
            }
            __syncthreads();
            {
                bf16x8 Wf[4][4]; float bs[4];
#pragma unroll
                for (int m = 0; m < 4; ++m) { const int t = 64 * th + 16 * m + fr; bs[m] = bsp[h * 128 + t];
#pragma unroll
                    for (int kk = 0; kk < 4; ++kk) Wf[m][kk] = *(const bf16x8*)(WSPK + ((size_t)((h * 128 + t) * 4 + kk) * 4 + fq) * 8); }
                const size_t ubase = (tok0 + 64 * th + fr) * 512 + 128 * h + 4 * fq;
                u32x2 uw[2][4];
#pragma unroll
                for (int m = 0; m < 4; ++m) uw[0][m] = *(const u32x2*)(U + ubase + (size_t)(16 * m) * 512);
#pragma unroll
                for (int n = 0; n < 8; ++n) {
                    if (n + 1 < 8) {
#pragma unroll
                        for (int m = 0; m < 4; ++m) uw[(n + 1) & 1][m] = *(const u32x2*)(U + ubase + (size_t)(16 * m) * 512 + 16 * (n + 1));
                    }
                    f32x4 acc[4];
#pragma unroll
                    for (int m = 0; m < 4; ++m) acc[m] = (f32x4){0.f, 0.f, 0.f, 0.f};
#pragma unroll
                    for (int kk = 0; kk < 4; ++kk) {
                        bf16x8 X;
#pragma unroll
                        for (int i = 0; i < 8; ++i) X[i] = *(const LAS short*)(lds + (size_t)(32 * kk + 4 * i + fq) * (VP * 2) + 2 * (128 * h + 16 * n + fr));
#pragma unroll
                        for (int m = 0; m < 4; ++m) acc[m] = __builtin_amdgcn_mfma_f32_16x16x32_bf16(X, Wf[m][kk], acc[m], 0, 0, 0);
                    }
#pragma unroll
                    for (int m = 0; m < 4; ++m) {
                        const u32x2 u2 = uw[n & 1][m];
                        const f32x4 sv = acc[m] + bs[m];
                        u32x2 o; o.x = cvt_pk_bf16(bf_lo(u2.x) * sv[0], bf_hi(u2.x) * sv[1]); o.y = cvt_pk_bf16(bf_lo(u2.y) * sv[2], bf_hi(u2.y) * sv[3]);
                        *(u32x2*)(XS + ubase + (size_t)(16 * m) * 512 + 16 * n) = o;
                    }
                }
            }
            __syncthreads();
        }
    }

    {
        const float* dwk = PIN(17) + (size_t)l * 31 * 512; const float* dwb = PIN(18) + (size_t)l * 512; const float* lng = PIN(19) + (size_t)l * 512; const float* lnb = PIN(20) + (size_t)l * 512;
        bf16_t* XC = X3 + (size_t)2 * MTOK * 512;
        LAS unsigned char* xs = lds;
        LAS float* ys = (LAS float*)(lds + 65536);
        const int c = tid; float wk[31];
#pragma unroll
        for (int k = 0; k < 31; ++k) wk[k] = dwk[k * 512 + c];
        const float bias = dwb[c];
        const f32x4 g0 = *(const f32x4*)(lng + 8 * lane), g1 = *(const f32x4*)(lng + 8 * lane + 4), b0 = *(const f32x4*)(lnb + 8 * lane), b1 = *(const f32x4*)(lnb + 8 * lane + 4);
        u32x4 pre[8];
#define CONV_LOAD(ct_) do { const int tok0_ = (ct_) * 32, t0_ = tok0_ & (SEQ - 1); _Pragma("unroll") for (int i = 0; i < 8; ++i) { const int idx = tid + 512 * i; const int r = idx >> 6, c8 = idx & 63; \
            pre[i] = (u32x4){0u, 0u, 0u, 0u}; if (idx < 62 * 64 && t0_ - 30 + r >= 0) pre[i] = *(const u32x4*)(XG + (size_t)(tok0_ - 30 + r) * 512 + 8 * c8); } } while (0)
        int ct = bid;
        if (ct < MTOK / 32) CONV_LOAD(ct);
        for (; ct < MTOK / 32; ct += gridDim.x) {
            const int tok0 = ct * 32;
#pragma unroll
            for (int i = 0; i < 8; ++i) { const int idx = tid + 512 * i; if (idx < 62 * 64) *(LAS u32x4*)(xs + (idx >> 6) * 1024 + 16 * (idx & 63)) = pre[i]; }
            __syncthreads();
            if (ct + (int)gridDim.x < MTOK / 32) CONV_LOAD(ct + gridDim.x);
#pragma unroll
            for (int hb = 0; hb < 2; ++hb) {
                float x[46];
#pragma unroll
                for (int r = 0; r < 46; ++r) x[r] = __uint_as_float(((unsigned)*(const LAS unsigned short*)(xs + (16 * hb + r) * 1024 + 2 * c)) << 16);
#pragma unroll
                for (int t = 0; t < 16; ++t) { float y = bias;
#pragma unroll
                    for (int k = 0; k < 31; ++k) y += wk[k] * x[t + k];
                    ys[(16 * hb + t) * 512 + c] = y; }
            }
            __syncthreads();
#pragma unroll
            for (int i = 0; i < 4; ++i) { const int t = wid * 4 + i;
                f32x4 x0 = *(const LAS f32x4*)(ys + t * 512 + 8 * lane), x1 = *(const LAS f32x4*)(ys + t * 512 + 8 * lane + 4);
                float s = (x0[0] + x0[1]) + (x0[2] + x0[3]) + (x1[0] + x1[1]) + (x1[2] + x1[3]);
                s = wave_sum(s); const float mu = s * (1.0f / 512.0f);
                x0 -= mu; x1 -= mu;
                float q = x0[0] * x0[0] + x0[1] * x0[1] + x0[2] * x0[2] + x0[3] * x0[3] + x1[0] * x1[0] + x1[1] * x1[1] + x1[2] * x1[2] + x1[3] * x1[3];
                q = wave_sum(q); const float rs = __builtin_amdgcn_rsqf(q * (1.0f / 512.0f) + EPS);
                x0 = x0 * rs * g0 + b0; x1 = x1 * rs * g1 + b1;
                x0 = x0 * sigmoid4(x0); x1 = x1 * sigmoid4(x1);
                *(u32x4*)(XC + (size_t)(tok0 + t) * 512 + 8 * lane) = pack8(x0, x1); }
            __syncthreads();
        }
#undef CONV_LOAD
    }

    {
        const int g = wid & 3, oct = g * 16 + (lane & 15), sub = (wid >> 2) * 4 + (lane >> 4);
        switch (g) {
        case 0: pool_run<2>(ZP, X3, oct, sub, bid); break;
        case 1: pool_run<4>(ZP, X3, oct, sub, bid); break;
        case 2: pool_run<8>(ZP, X3, oct, sub, bid); break;
        default: pool_run<16>(ZP, X3, oct, sub, bid); break;
        }
    }
}

#define XB_TMO      128
#define XB_XCNT(j)  (256  + 64 * (j))
#define XB_XSUB(j)  (1280 + 64 * (j))
#define XB_XGEN(j)  (2304 + 64 * (j))
#define XB_TOP      3328
#define XB_TOPGEN   3392
#define XCD_BAR_WORDS 3456
#define XB_SPIN_CAP (1u << 18)
__device__ __forceinline__ unsigned xb_ld(unsigned* p)              { return __hip_atomic_load(p, __ATOMIC_RELAXED, __HIP_MEMORY_SCOPE_AGENT); }
__device__ __forceinline__ unsigned xb_add(unsigned* p, unsigned v) { return __hip_atomic_fetch_add(p, v, __ATOMIC_RELAXED, __HIP_MEMORY_SCOPE_AGENT); }
__device__ __forceinline__ unsigned xb_xcc_id() { return (unsigned)__builtin_amdgcn_s_getreg((3 << 11) | 20) & 0xFu; }
#define XB_SPIN(cond, bar) do { unsigned _sp = 0; while (cond) { __builtin_amdgcn_s_sleep(1); \
    if ((++_sp & 255u) == 0u) { if (xb_ld(&(bar)[XB_TMO])) break; if (_sp > XB_SPIN_CAP) { atomicAdd(&(bar)[XB_TMO], 1u); break; } } } } while (0)
struct XcdBarrier { unsigned* bar; unsigned x; volatile LAS unsigned* st; };
__device__ __forceinline__ XcdBarrier xcd_barrier_post(unsigned* bar, volatile LAS unsigned* st) {
    XcdBarrier b; b.bar = bar; b.x = xb_xcc_id(); b.st = st;
    if (threadIdx.x == 0) (void)xb_add(&bar[XB_XCNT(b.x)], 1u);
    return b;
}
__device__ __forceinline__ void xcd_barrier_complete(unsigned* bar, unsigned x, unsigned& nloc, unsigned& nx) {
    const unsigned G = gridDim.x * gridDim.y * gridDim.z;
    unsigned sum, cnt, mine, sp = 0u;
    for (;;) {
        sum = 0u; cnt = 0u; mine = 0u;
#pragma unroll
        for (unsigned j = 0; j < 16; ++j) { const unsigned c = xb_ld(&bar[XB_XCNT(j)]); sum += c; cnt += (c > 0u) ? 1u : 0u; mine = (j == x) ? c : mine; }
        if (sum == G) break;
        __builtin_amdgcn_s_sleep(1);
        if ((++sp & 255u) == 0u) { if (xb_ld(&bar[XB_TMO])) break; if (sp > XB_SPIN_CAP) { atomicAdd(&bar[XB_TMO], 1u); break; } }
    }
    nloc = mine > 0u ? mine : 1u; nx = cnt > 0u ? cnt : 1u;
}
__device__ __forceinline__ void xcd_barrier(const XcdBarrier& b) {
    asm volatile("s_waitcnt vmcnt(0)" ::: "memory");
    __syncthreads();
    if (threadIdx.x == 0) {
        unsigned* bar = b.bar;
        __builtin_amdgcn_s_waitcnt(0);
        unsigned nloc = b.st[0], nx = b.st[1];
        if (nloc == 0u) { xcd_barrier_complete(bar, b.x, nloc, nx); b.st[0] = nloc; b.st[1] = nx; }
        const unsigned old = xb_add(&bar[XB_XSUB(b.x)], 1u);
        const unsigned gen = old / nloc;
        if (old + 1u == (gen + 1u) * nloc) {
            __builtin_amdgcn_fence(__ATOMIC_RELEASE, "agent");
            asm volatile("s_waitcnt vmcnt(0)" ::: "memory");
            const unsigned og = xb_add(&bar[XB_TOP], 1u);
            const unsigned tg = og / nx;
            if (og + 1u == (tg + 1u) * nx) xb_add(&bar[XB_TOPGEN], 1u);
            else XB_SPIN(xb_ld(&bar[XB_TOPGEN]) == tg, bar);
            __builtin_amdgcn_fence(__ATOMIC_ACQUIRE, "agent");
            xb_add(&bar[XB_XGEN(b.x)], 1u);
            asm volatile("s_waitcnt vmcnt(0)" ::: "memory");
        } else {
            XB_SPIN(xb_ld(&bar[XB_XGEN(b.x)]) == gen, bar);
            __builtin_amdgcn_fence(__ATOMIC_ACQUIRE, "agent");
            asm volatile("s_waitcnt vmcnt(0)" ::: "memory");
        }
    }
    __syncthreads();
}

__device__ __forceinline__ void run_phase(const Params& P, int ph, LAS unsigned char* lds, const float rmul = 1.0f, const bool row_only = false) {
    GAS unsigned char* wsg = P.ws; GAS float* outg = P.out; int tid = threadIdx.x, bid = blockIdx.x;
    asm volatile("" : "+s"(wsg), "+s"(outg), "+v"(tid), "+s"(bid));
    unsigned char* ws = (unsigned char*)wsg; float* out = (float*)outg;
    unsigned char* big = ws + WS_BIG;
    bf16_t* HN = (bf16_t*)(ws + WS_HN); bf16_t* F = (bf16_t*)(ws + WS_F); bf16_t* F2 = (bf16_t*)(ws + WS_F2);
    const int G = gridDim.x, c = bid;
    constexpr unsigned PM = PHASE_MASK;
    if (ph == 0) {
        if (!(PM & (1u << 13))) return;
        prep_weights(P, ws, 0, lds, tid, bid);
        row_phase<true>(PIN(0), out, nullptr, 0.f, nullptr, PIN(2), HN, true, tid, bid);
        return;
    }
    const int l = (ph - 1) / 13, sub = (ph - 1) % 13;
    pg8::Order S;
    switch (sub) {
    case 0: case 8: if (PM & 1u) {
        pg8::Gemm g{HN, (const bf16_t*)(ws + (sub == 0 ? WS_WGU1 : WS_WGU2)), MTOK, NGU, DM}; S.init(MTOK, NGU, G, c, 1);
        pg8::EpiGLU E{(bf16_t*)(big + BIG_ACT)};
        pg8::gemm_phase(lds, g, S, E, tid);
        if (sub == 8) {
            pg8::Gemm g2{(const bf16_t*)(big + BIG_PB), (const bf16_t*)(ws + WS_WPP), MTOK, DM, PLE}; S.init(MTOK, DM, G, c, 1);
            pg8::EpiStore E2{(bf16_t*)(big + BIG_E)};
            pg8::gemm_phase(lds, g2, S, E2, tid);
        }
    } break;
    case 1: case 9: if (PM & 2u) {
        pg8::Gemm g{(const bf16_t*)(big + BIG_ACT), (const bf16_t*)(ws + (sub == 1 ? WS_WD1 : WS_WD2)), MTOK, DM, DFF}; S.init(MTOK, DM, G, c, 1);
        pg8::EpiStore E{F};
        pg8::gemm_phase(lds, g, S, E, tid);
    } break;
    case 2: if (PM & 4u) row_phase2<false>(l == 0 ? PIN(0) : (const float*)out, out, F, 0.5f, PIN(6) + l * DM, nullptr, 0.f, nullptr, PIN(7) + l * DM, HN, true, tid, bid); break;
    case 3: if (PM & 8u) {
        pg8::Gemm g{HN, (const bf16_t*)(ws + WS_WIN), MTOK, NIN, DM}; S.init(MTOK, NIN, G, c, 1);
        pg8::EpiIn E{(bf16_t*)(big + BIG_ZP), (bf16_t*)(big + BIG_U), (bf16_t*)(big + BIG_V), (bf16_t*)(big + BIG_XG), (bf16_t*)(big + BIG_GATES)};
        pg8::gemm_phase(lds, g, S, E, tid);
    } break;
    case 4: if (PM & 16u) mixer_phase(P, ws, l, lds, tid, bid); break;
    case 5: if (PM & 32u) {
        pg8::Gemm g{(const bf16_t*)(big + BIG_X3), (const bf16_t*)(ws + WS_WBR), MTOK, DM, 512}; S.init(MTOK, DM, G, c, 3);
        pg8::EpiBranch E{(const unsigned char*)(big + BIG_GATES), (bf16_t*)(big + BIG_MERGED)};
        pg8::gemm_phase(lds, g, S, E, tid);
    } break;
    case 6: if (PM & 64u) {
        pg8::Gemm g{(const bf16_t*)(big + BIG_MERGED), (const bf16_t*)(ws + WS_WOUT), MTOK, DM, DM}; S.init(MTOK, DM, G, c, 1);
        pg8::EpiStore E{F2};
        pg8::gemm_phase(lds, g, S, E, tid);
    } break;
    case 7: if (PM & 128u) {
        row_phase2<true>(l == 0 ? PIN(0) : (const float*)out, out, F, 0.5f, PIN(6) + l * DM, F2, 1.0f, PIN(23) + l * DM, PIN(24) + l * DM, HN, true, tid, bid);
        if (!row_only) convert_p(PIN(1) + (size_t)l * MTOK * PLE, (bf16_t*)(big + BIG_PB), tid, bid);
        } break;
    case 10: if (PM & 1024u) row_phase2<false>(out, out, F, 0.5f, PIN(28) + l * DM, nullptr, 0.f, nullptr, PIN(30) + l * DM, HN, true, tid, bid); break;
    case 11: if (PM & 2048u) {
        pg8::Gemm g{HN, (const bf16_t*)(ws + WS_WPG), MTOK, DM, DM}; S.init(MTOK, DM, G, c, 1);
        pg8::EpiPle E{(const bf16_t*)(big + BIG_E), F2};
        pg8::gemm_phase(lds, g, S, E, tid);
    } break;
    case 12: if (PM & 4096u) {
        row_phase2<true>(out, out, F, 0.5f, PIN(28) + l * DM, F2, 1.0f, PIN(32) + l * DM, PIN(2) + (l + 1 < NLAYER ? l + 1 : l) * DM, HN, l + 1 < NLAYER, tid, bid);
        if (l + 1 < NLAYER && !row_only) prep_weights(P, ws, l + 1, lds, tid, bid);
        } break;
    default: break;
    }
}

__global__ void __launch_bounds__(512, 2) mega(Params P) {
    extern __shared__ __attribute__((aligned(16))) unsigned char lds_raw[];
    LAS unsigned char* lds = (LAS unsigned char*)lds_raw;
    cg::grid_group grid = cg::this_grid();
#if !MULTI_LAUNCH
    volatile LAS unsigned* st = (volatile LAS unsigned*)(lds + LDS_BYTES - 16);
    if (threadIdx.x < 2) st[threadIdx.x] = 0u;
    __syncthreads();
    const XcdBarrier bar = xcd_barrier_post((unsigned*)((unsigned char*)P.ws + WS_BAR), st);
#endif
    for (int ph = P.ph_lo; ph < P.ph_hi; ++ph) {
        run_phase(P, ph, lds);
#if PROBE_DUP
        {
            const int sub = ph == 0 ? -1 : (ph - 1) % 13;
            const bool is_gemm = (sub == 0 || sub == 1 || sub == 3 || sub == 5 || sub == 6 || sub == 8 || sub == 9 || sub == 11);
            if (((PROBE_DUP & 1) && is_gemm) || ((PROBE_DUP & 2) && sub == 4)) { __syncthreads(); run_phase(P, ph, lds); }
#if !MULTI_LAUNCH
            if ((PROBE_DUP & 4) && ph > 0) xcd_barrier(bar);
#endif
        }
#endif
#if !MULTI_LAUNCH
        if (ph + 1 < P.ph_hi) { if (ph == 0) grid.sync(); else xcd_barrier(bar); }
#endif
    }
}

extern "C" void kernel_launch(void* const* d_in, const int* in_sizes, int n_in, void* d_out, int out_size, void* d_ws, size_t ws_size, hipStream_t stream) {
    static int grid = 0;
    if (grid == 0) {
        if (n_in != 33 || ws_size < WS_END) { fprintf(stderr, "kernel_launch: unexpected n_in %d or ws_size %zu (< %zu)\n", n_in, ws_size, (size_t)WS_END); grid = -1; return; }
        int dev = 0, cus = 0, per_cu = 0;
        hipGetDevice(&dev);
        hipDeviceGetAttribute(&cus, hipDeviceAttributeMultiprocessorCount, dev);
        if (hipFuncSetAttribute((const void*)mega, hipFuncAttributeMaxDynamicSharedMemorySize, LDS_BYTES) != hipSuccess) { fprintf(stderr, "kernel_launch: hipFuncSetAttribute failed\n"); grid = -1; return; }
        hipOccupancyMaxActiveBlocksPerMultiprocessor(&per_cu, (const void*)mega, 512, LDS_BYTES);
        if (per_cu < 1) per_cu = 1;
        (void)hipGetLastError();
        grid = cus * per_cu;
    }
    if (grid < 0) return;
    Params p{};
    for (int i = 0; i < 33; ++i) p.in[i] = (const GAS float*)d_in[i];
    p.out = (GAS float*)d_out; p.ws = (GAS unsigned char*)d_ws;
#if MULTI_LAUNCH
    for (int ph = 0; ph < NPHASE; ++ph) {
        p.ph_lo = ph; p.ph_hi = ph + 1;
        hipLaunchKernelGGL(mega, dim3(grid), dim3(512), LDS_BYTES, stream, p);
    }
#else
    p.ph_lo = 0; p.ph_hi = NPHASE;
    if (hipMemsetAsync((char*)d_ws + WS_BAR, 0, 16384, stream) != hipSuccess) { fprintf(stderr, "kernel_launch: memset of the barrier words failed\n"); return; }
    void* args[] = {&p};
    hipError_t e = hipLaunchCooperativeKernel((const void*)mega, dim3(grid), dim3(512), args, LDS_BYTES, stream);
    if (e != hipSuccess) fprintf(stderr, "cooperative launch failed: %s (grid %d)\n", hipGetErrorString(e), grid);
#endif
}
```

```cpp
#include <hip/hip_runtime.h>
#include <hip/hip_cooperative_groups.h>
#include <cstdio>
namespace cg = cooperative_groups;

#ifndef PHASE_MASK
#define PHASE_MASK 0xffffu
#endif
#ifndef PROBE_DUP
#define PROBE_DUP 0
#endif
#ifndef MULTI_LAUNCH
#define MULTI_LAUNCH 0
#endif

#define LAS __attribute__((address_space(3)))
typedef unsigned short bf16_t;
typedef short bf16x8 __attribute__((ext_vector_type(8)));
typedef float f32x4 __attribute__((ext_vector_type(4)));
typedef float f32x2 __attribute__((ext_vector_type(2)));
typedef unsigned u32x4 __attribute__((ext_vector_type(4)));
typedef unsigned u32x2 __attribute__((ext_vector_type(2)));

constexpr int MTOK = 32768, DM = 1024, DFF = 2816, SEQ = 4096, NLAYER = 4, PLE = 256;
constexpr int NGU = 2 * DFF;
constexpr int NIN = 5632;
constexpr float EPS = 1e-6f;
constexpr int LDS_BYTES = 147456;
constexpr int NPHASE = 1 + 13 * NLAYER;

constexpr size_t WS_WGU1 = 0;
constexpr size_t WS_WD1 = WS_WGU1 + (size_t)NGU * DM * 2;
constexpr size_t WS_WGU2 = WS_WD1 + (size_t)DM * DFF * 2;
constexpr size_t WS_WD2 = WS_WGU2 + (size_t)NGU * DM * 2;
constexpr size_t WS_WIN = WS_WD2 + (size_t)DM * DFF * 2;
constexpr size_t WS_WBR = WS_WIN + (size_t)NIN * DM * 2;
constexpr size_t WS_WOUT = WS_WBR + (size_t)3 * DM * 512 * 2;
constexpr size_t WS_WPG = WS_WOUT + (size_t)DM * DM * 2;
constexpr size_t WS_WPP = WS_WPG + (size_t)DM * DM * 2;
constexpr size_t WS_WSPK = WS_WPP + (size_t)DM * PLE * 2;
constexpr size_t WS_HN = WS_WSPK + (size_t)4 * 128 * 128 * 2;
constexpr size_t WS_F = WS_HN + (size_t)MTOK * DM * 2;
constexpr size_t WS_BIG = WS_F + (size_t)MTOK * DM * 2;
constexpr size_t BIG_ACT = 0;
constexpr size_t BIG_ZP = 0, BIG_U = (size_t)MTOK * 512 * 2, BIG_V = 2 * BIG_U, BIG_XG = 3 * BIG_U;
constexpr size_t BIG_GATES = 4 * BIG_U;
constexpr size_t BIG_X3 = BIG_GATES + (size_t)MTOK * 3072 * 2;
constexpr size_t BIG_MERGED = 0;
constexpr size_t BIG_E = (size_t)192 * 1024 * 1024;
constexpr size_t BIG_PB = BIG_X3;
constexpr size_t WS_BAR = WS_BIG + BIG_X3 + (size_t)3 * MTOK * 512 * 2;
constexpr size_t WS_F2 = WS_BAR + 16384;
constexpr size_t WS_END = WS_F2 + (size_t)MTOK * DM * 2;

#define GAS __attribute__((address_space(1)))
struct Params { const GAS float* in[33]; GAS float* out; GAS unsigned char* ws; int ph_lo, ph_hi; };
#define PIN(i) ((const float*)P.in[i])

typedef __bf16 bf16x2_t __attribute__((ext_vector_type(2)));
__device__ __forceinline__ unsigned cvt_pk_bf16(float lo, float hi) { const f32x2 v = {lo, hi}; return __builtin_bit_cast(unsigned, __builtin_convertvector(v, bf16x2_t)); }
__device__ __forceinline__ float bf_lo(unsigned w) { return __uint_as_float(w << 16); }
__device__ __forceinline__ float bf_hi(unsigned w) { return __uint_as_float(w & 0xffff0000u); }
__device__ __forceinline__ float sigmoid_f(float x) { return __builtin_amdgcn_rcpf(1.0f + __builtin_amdgcn_exp2f(-1.44269504f * x)); }
__device__ __forceinline__ float wave_sum(float v) {
#pragma unroll
    for (int o = 32; o >= 1; o >>= 1) v += __shfl_xor(v, o);
    return v;
}
__device__ __forceinline__ f32x2 gelu_pk(f32x2 v) {
    const f32x2 av = __builtin_elementwise_abs(v), d = av * 0.2316418882f + 1.0f;
    f32x2 t; t.x = __builtin_amdgcn_rcpf(d.x); t.y = __builtin_amdgcn_rcpf(d.y);
    f32x2 q = t * 0.5307027145f + (-0.7265760135f); q = q * t + 0.7107068705f; q = q * t + (-0.142248368f); q = q * t + 0.127414796f; q = q * t;
    const f32x2 s = (v * v) * (-0.72134752044f);
    f32x2 e; e.x = __builtin_amdgcn_exp2f(s.x); e.y = __builtin_amdgcn_exp2f(s.y);
    const f32x2 m = v * (q * e), r = v - m;
    f32x2 o; o.x = v.x < 0.f ? m.x : r.x; o.y = v.y < 0.f ? m.y : r.y; return o;
}
__device__ __forceinline__ f32x4 gelu4(f32x4 v) { f32x2 a = gelu_pk((f32x2){v[0], v[1]}), b = gelu_pk((f32x2){v[2], v[3]}); return (f32x4){a.x, a.y, b.x, b.y}; }
__device__ __forceinline__ f32x4 sigmoid4(f32x4 v) { return (f32x4){sigmoid_f(v[0]), sigmoid_f(v[1]), sigmoid_f(v[2]), sigmoid_f(v[3])}; }
__device__ __forceinline__ u32x4 pack8(f32x4 a, f32x4 b) { u32x4 w; w.x = cvt_pk_bf16(a[0], a[1]); w.y = cvt_pk_bf16(a[2], a[3]); w.z = cvt_pk_bf16(b[0], b[1]); w.w = cvt_pk_bf16(b[2], b[3]); return w; }
__device__ __forceinline__ f32x4 unpack_lo4(u32x4 w) { return (f32x4){bf_lo(w.x), bf_hi(w.x), bf_lo(w.y), bf_hi(w.y)}; }
__device__ __forceinline__ f32x4 unpack_hi4(u32x4 w) { return (f32x4){bf_lo(w.z), bf_hi(w.z), bf_lo(w.w), bf_hi(w.w)}; }

namespace pg8 {
constexpr int BM = 256, BK = 64, HALF = 128, HTB = HALF * BK * 2, STAGE_BYTES = 8 * HTB, NXCD = 8, WGM = 8;
__device__ __forceinline__ int lds_byte(int r, int c) { const int st = (r >> 4) * 2 + (c >> 5), rr = r & 15, cc = c & 31, ob = rr * 64 + cc * 2; return st * 1024 + (ob ^ (((ob >> 9) & 1) << 5)); }
__device__ __forceinline__ void stage_rc(int b, int& R, int& C) { const int st = b / 1024, sb = b % 1024, swz = sb ^ (((sb >> 9) & 1) << 5); R = (st >> 1) * 16 + swz / 64; C = (st & 1) * 32 + (swz % 64) / 2; }
__device__ __forceinline__ int perm32(int rho) { const int n = rho >> 4, i = rho & 15; return 8 * (i >> 2) + 4 * n + (i & 3); }

struct Unit { int pm, pn; };
struct Gemm { const bf16_t* A; const bf16_t* Bt; int M, N, K; };

struct Order {
    int nM, nN, nwg, G, c, zn;
    __device__ void init(int M, int N, int G_, int c_, int zn_) { nM = M / BM; nN = N / BM; nwg = nM * nN; G = G_; c = c_; zn = zn_; }
    __device__ bool next(int i, Unit& u) const {
        const int ti = i / zn, z = i - ti * zn;
        const long L = (long)ti * G + c; if (L >= nwg) return false;
        int wgid = (int)L; { const int q = nwg / NXCD, r = nwg % NXCD, xcd = wgid % NXCD, off = wgid / NXCD; wgid = (xcd < r ? xcd * (q + 1) : r * (q + 1) + (xcd - r) * q) + off; }
        const int nig = WGM * nN, gid = wgid / nig, fm = gid * WGM, gsz = (nM - fm) < WGM ? (nM - fm) : WGM;
        u.pm = z * nM + fm + ((wgid % nig) % gsz); u.pn = z * nN + (wgid % nig) / gsz; return true;
    }
};

template <class Epi>
__device__ __forceinline__ void gemm_phase(LAS unsigned char* lds, const Gemm g, const Order& S, const Epi& E, const int tid) {
    const int wid = __builtin_amdgcn_readfirstlane(tid >> 6), lane = tid & 63, wr = wid >> 2, wc = wid & 3, fr = lane & 15, fq = lane >> 4;
    const int K = g.K, nt = K / BK;
    unsigned voffA[2], voffB[2];
#pragma unroll
    for (int i = 0; i < 2; ++i) { int R, C; stage_rc(tid * 16 + i * 8192, R, C); const int Rb = (R & ~31) + perm32(R & 31);
        voffA[i] = (unsigned)(R * K + C) * 2u; voffB[i] = (unsigned)(Rb * K + C) * 2u; }
    const size_t kstep = (size_t)(BK * 2);
    const size_t hstep = (size_t)HALF * K * 2;
    const size_t tstep = 2 * hstep;
    const unsigned ldsw = (unsigned)wid * 1024u;
    const int aoff = lds_byte(wr * 64 + fr, fq * 8), boff = lds_byte(wc * 32 + fr, fq * 8);
#define PG8_SA(b, h) (((b) * 2 + (h)) * HTB)
#define PG8_SB(b, h) ((4 + (b) * 2 + (h)) * HTB)
#define PG8_STAGE(bufoff, gbase, voff) do { _Pragma("unroll") for (int _i = 0; _i < 2; ++_i) \
        __builtin_amdgcn_global_load_lds((const unsigned*)((const char*)(gbase) + (voff)[_i]), (LAS unsigned*)(lds + (bufoff) + ldsw + _i * 8192), 16, 0, 0); } while (0)
#define PG8_LDA(dst, b, h) do { _Pragma("unroll") for (int m = 0; m < 4; ++m) _Pragma("unroll") for (int k = 0; k < 2; ++k) dst[m][k] = *(const LAS bf16x8*)(lds + PG8_SA(b, h) + aoff + m * 2048 + k * 1024); } while (0)
#define PG8_LDB(dst, b, h) do { _Pragma("unroll") for (int n = 0; n < 2; ++n) _Pragma("unroll") for (int k = 0; k < 2; ++k) dst[n][k] = *(const LAS bf16x8*)(lds + PG8_SB(b, h) + boff + n * 2048 + k * 1024); } while (0)
#define PG8_MMA(ai, bj, At, Bt) do { __builtin_amdgcn_s_setprio(1); _Pragma("unroll") for (int m = 0; m < 4; ++m) _Pragma("unroll") for (int n = 0; n < 2; ++n) _Pragma("unroll") for (int k = 0; k < 2; ++k) \
        acc[ai][bj][m][n] = __builtin_amdgcn_mfma_f32_16x16x32_bf16(Bt[n][k], At[m][k], acc[ai][bj][m][n], 0, 0, 0); __builtin_amdgcn_s_setprio(0); } while (0)
#define PG8_WAIT_V(n) asm volatile("s_waitcnt vmcnt(" #n ")" ::: "memory")
#define PG8_WAIT_L(n) asm volatile("s_waitcnt lgkmcnt(" #n ")" ::: "memory")
#define PG8_BAR __builtin_amdgcn_s_barrier()
#define PG8_SCHED __builtin_amdgcn_sched_barrier(0)
    Unit cur, nxt; int ui = 0;
    if (!S.next(0, cur)) return;
    f32x4 acc[2][2][4][2];
#pragma unroll
    for (int a = 0; a < 2; ++a)
#pragma unroll
        for (int b = 0; b < 2; ++b)
#pragma unroll
            for (int m = 0; m < 4; ++m)
#pragma unroll
                for (int n = 0; n < 2; ++n) acc[a][b][m][n] = (f32x4){0.f, 0.f, 0.f, 0.f};
    bf16x8 At[4][2], B0[2][2], B1[2][2];
    const char* cA = (const char*)g.A + (size_t)cur.pm * tstep; const char* cB = (const char*)g.Bt + (size_t)cur.pn * tstep;
    PG8_STAGE(PG8_SB(0, 0), cB, voffB); PG8_STAGE(PG8_SA(0, 0), cA, voffA); PG8_STAGE(PG8_SB(0, 1), cB + hstep, voffB); PG8_STAGE(PG8_SA(0, 1), cA + hstep, voffA);
    if (wr == 1) PG8_BAR;
    PG8_WAIT_V(4); PG8_BAR;
    PG8_STAGE(PG8_SB(1, 0), cB + kstep, voffB); PG8_STAGE(PG8_SA(1, 0), cA + kstep, voffA); PG8_STAGE(PG8_SB(1, 1), cB + hstep + kstep, voffB);
    PG8_WAIT_V(6); PG8_BAR;
    for (;;) {
        const bool has_next = S.next(ui + 1, nxt);
        const char* nA = has_next ? (const char*)g.A + (size_t)nxt.pm * tstep : cA; const char* nB = has_next ? (const char*)g.Bt + (size_t)nxt.pn * tstep : cB;
        for (int t = 0; t < nt; t += 2) {
            const bool last = (t == nt - 2);
            const char* a1 = cA + (size_t)(t + 1) * kstep;
            const char* a2 = last ? nA : cA + (size_t)(t + 2) * kstep; const char* b2 = last ? nB : cB + (size_t)(t + 2) * kstep;
            const char* a3 = a2 + kstep; const char* b3 = b2 + kstep;
            PG8_LDB(B0, 0, 0); PG8_SCHED; PG8_LDA(At, 0, 0); PG8_STAGE(PG8_SA(1, 1), a1 + hstep, voffA);
            PG8_WAIT_L(8); PG8_BAR; PG8_WAIT_L(0); PG8_MMA(0, 0, At, B0); PG8_BAR; PG8_SCHED;
            PG8_LDB(B1, 0, 1); PG8_STAGE(PG8_SB(0, 0), b2, voffB);
            PG8_BAR; PG8_WAIT_L(0); PG8_MMA(0, 1, At, B1); PG8_BAR;
            PG8_LDA(At, 0, 1); PG8_STAGE(PG8_SA(0, 0), a2, voffA);
            PG8_BAR; PG8_WAIT_L(0); PG8_MMA(1, 0, At, B0); PG8_BAR; PG8_SCHED;
            PG8_STAGE(PG8_SB(0, 1), b2 + hstep, voffB);
            PG8_WAIT_V(6); PG8_BAR; PG8_MMA(1, 1, At, B1); PG8_BAR;
            PG8_LDB(B0, 1, 0); PG8_SCHED; PG8_LDA(At, 1, 0); PG8_STAGE(PG8_SA(0, 1), a2 + hstep, voffA);
            PG8_WAIT_L(8); PG8_BAR; PG8_WAIT_L(0); PG8_MMA(0, 0, At, B0); PG8_BAR; PG8_SCHED;
            PG8_LDB(B1, 1, 1); PG8_STAGE(PG8_SB(1, 0), b3, voffB);
            PG8_BAR; PG8_WAIT_L(0); PG8_MMA(0, 1, At, B1); PG8_BAR;
            PG8_LDA(At, 1, 1); PG8_STAGE(PG8_SA(1, 0), a3, voffA);
            PG8_BAR; PG8_WAIT_L(0); PG8_MMA(1, 0, At, B0); PG8_BAR; PG8_SCHED;
            PG8_STAGE(PG8_SB(1, 1), b3 + hstep, voffB);
            PG8_WAIT_V(6); PG8_BAR; PG8_MMA(1, 1, At, B1); PG8_BAR;
        }
        bool zero_acc = true;
        if constexpr (Epi::CHAIN) zero_acc = E.chain(acc, cur, wr, wc, fr, fq);
        else E(acc, cur, wr, wc, fr, fq);
        if (!has_next) break;
        if (zero_acc)
#pragma unroll
        for (int a = 0; a < 2; ++a)
#pragma unroll
            for (int b = 0; b < 2; ++b)
#pragma unroll
                for (int m = 0; m < 4; ++m)
#pragma unroll
                    for (int n = 0; n < 2; ++n) acc[a][b][m][n] = (f32x4){0.f, 0.f, 0.f, 0.f};
        cur = nxt; cA = nA; cB = nB; ++ui;
    }
    PG8_WAIT_V(0);
    if (wr == 0) PG8_BAR;
    PG8_BAR;
#undef PG8_SA
#undef PG8_SB
#undef PG8_STAGE
#undef PG8_LDA
#undef PG8_LDB
#undef PG8_MMA
#undef PG8_WAIT_V
#undef PG8_WAIT_L
#undef PG8_BAR
#undef PG8_SCHED
}

typedef f32x4 Acc[2][2][4][2];
template <int ACT, int LDC> __device__ __forceinline__ void glu_store(const Acc& acc, char* ub, unsigned lane_off) {
#pragma unroll
    for (int ai = 0; ai < 2; ++ai)
#pragma unroll
        for (int m = 0; m < 4; ++m) {
            char* rp = ub + (size_t)(ai * HALF + m * 16) * LDC * 2;
            f32x4 v[2];
#pragma unroll
            for (int n = 0; n < 2; ++n) { const f32x4 a = acc[ai][0][m][n], b = acc[ai][1][m][n];
                if (ACT == 0) v[n] = a * sigmoid4(a) * b; else v[n] = a * sigmoid4(b); }
            *(u32x4*)(rp + lane_off) = pack8(v[0], v[1]);
        }
}
template <int LDC> __device__ __forceinline__ unsigned lane_off_of(int wr, int wc, int fr, int fq) { return (unsigned)((wr * 64 + fr) * LDC + wc * 32 + 8 * fq) * 2u; }
struct EpiGLU {
    static constexpr bool CHAIN = false;
    bf16_t* O;
    __device__ __forceinline__ void operator()(const Acc& acc, const Unit& u, int wr, int wc, int fr, int fq) const {
        glu_store<0, DFF>(acc, (char*)O + ((size_t)u.pm * BM * DFF + (size_t)u.pn * 128) * 2, lane_off_of<DFF>(wr, wc, fr, fq));
    }
};
template <int ACT, int LDC> __device__ __forceinline__ void plain_store(const Acc& acc, char* ub, unsigned lane_off) {
#pragma unroll
    for (int ai = 0; ai < 2; ++ai)
#pragma unroll
        for (int m = 0; m < 4; ++m) {
            char* rp = ub + (size_t)(ai * HALF + m * 16) * LDC * 2;
#pragma unroll
            for (int bj = 0; bj < 2; ++bj) { f32x4 v0 = acc[ai][bj][m][0], v1 = acc[ai][bj][m][1];
                if (ACT == 1) { v0 = gelu4(v0); v1 = gelu4(v1); }
                if (ACT == 2) { v0 = sigmoid4(v0); v1 = sigmoid4(v1); }
                *(u32x4*)(rp + bj * HALF * 2 + lane_off) = pack8(v0, v1); }
        }
}
struct EpiStore {
    static constexpr bool CHAIN = false;
    bf16_t* O;
    __device__ __forceinline__ void operator()(const Acc& acc, const Unit& u, int wr, int wc, int fr, int fq) const {
        plain_store<0, DM>(acc, (char*)O + ((size_t)u.pm * BM * DM + (size_t)u.pn * BM) * 2, lane_off_of<DM>(wr, wc, fr, fq));
    }
};
struct EpiIn {
    static constexpr bool CHAIN = false;
    bf16_t *ZP, *U, *V, *XG, *GATES;
    __device__ __forceinline__ void operator()(const Acc& acc, const Unit& u, int wr, int wc, int fr, int fq) const {
        const int pn = u.pn; const size_t rb = (size_t)u.pm * BM;
        if (pn >= 10) {
            char* ub = (char*)GATES + rb * 3072 + (size_t)(pn - 10) * 256; const unsigned lo = (unsigned)((wr * 64 + fr) * 3072 + wc * 32 + 8 * fq);
#pragma unroll
            for (int ai = 0; ai < 2; ++ai)
#pragma unroll
                for (int m = 0; m < 4; ++m)
#pragma unroll
                    for (int bj = 0; bj < 2; ++bj) {
                        const f32x4 v0 = sigmoid4(acc[ai][bj][m][0]) * 255.0f, v1 = sigmoid4(acc[ai][bj][m][1]) * 255.0f;
                        u32x2 w; w.x = 0u; w.y = 0u;
                        w.x = __builtin_amdgcn_cvt_pk_u8_f32(v0[0], 0, w.x); w.x = __builtin_amdgcn_cvt_pk_u8_f32(v0[1], 1, w.x); w.x = __builtin_amdgcn_cvt_pk_u8_f32(v0[2], 2, w.x); w.x = __builtin_amdgcn_cvt_pk_u8_f32(v0[3], 3, w.x);
                        w.y = __builtin_amdgcn_cvt_pk_u8_f32(v1[0], 0, w.y); w.y = __builtin_amdgcn_cvt_pk_u8_f32(v1[1], 1, w.y); w.y = __builtin_amdgcn_cvt_pk_u8_f32(v1[2], 2, w.y); w.y = __builtin_amdgcn_cvt_pk_u8_f32(v1[3], 3, w.y);
                        *(u32x2*)(ub + (size_t)(ai * HALF + m * 16) * 3072 + bj * HALF + lo) = w;
                    }
        }
        else {
            const unsigned lo = lane_off_of<512>(wr, wc, fr, fq);
            if (pn >= 6) glu_store<1, 512>(acc, (char*)XG + (rb * 512 + (size_t)(pn - 6) * 128) * 2, lo);
            else if (pn < 2) plain_store<0, 512>(acc, (char*)ZP + (rb * 512 + (size_t)pn * 256) * 2, lo);
            else { char* ub = (char*)(pn < 4 ? U : V) + (rb * 512 + (size_t)(pn & 1) * 256) * 2; plain_store<1, 512>(acc, ub, lo); }
        }
    }
};
struct EpiBranch {
    static constexpr bool CHAIN = true;
    const unsigned char* GATES; bf16_t* MG;
    static __device__ __forceinline__ f32x4 code4(unsigned w) { return (f32x4){__builtin_fmaxf((float)(w & 255u), 0.25f), __builtin_fmaxf((float)((w >> 8) & 255u), 0.25f), __builtin_fmaxf((float)((w >> 16) & 255u), 0.25f), __builtin_fmaxf((float)(w >> 24), 0.25f)}; }
    static __device__ __forceinline__ f32x4 rcp4(f32x4 v) { return (f32x4){__builtin_amdgcn_rcpf(v[0]), __builtin_amdgcn_rcpf(v[1]), __builtin_amdgcn_rcpf(v[2]), __builtin_amdgcn_rcpf(v[3])}; }
    __device__ __forceinline__ bool chain(Acc& acc, const Unit& u, int wr, int wc, int fr, int fq) const {
        const int z = u.pn >> 2, pn = u.pn & 3, pm = u.pm - z * 128;
        const bool fin = (z == 2);
        const char* gb = (const char*)GATES + (size_t)pm * BM * 3072 + (size_t)z * 1024 + (size_t)pn * BM;
        const char* gn = fin ? gb : gb + 1024;
        const unsigned glo = (unsigned)((wr * 64 + fr) * 3072 + wc * 32 + 8 * fq);
        char* mb = (char*)MG + ((size_t)pm * BM * DM + (size_t)pn * BM) * 2;
        const unsigned mlo = lane_off_of<DM>(wr, wc, fr, fq);
        constexpr float q = 1.0f / 255.0f;
        u32x2 g0[2][4][2], g1[2][4][2];
#pragma unroll
        for (int ai = 0; ai < 2; ++ai)
#pragma unroll
            for (int m = 0; m < 4; ++m)
#pragma unroll
                for (int bj = 0; bj < 2; ++bj) {
                    g0[ai][m][bj] = *(const u32x2*)(gb + (size_t)(ai * HALF + m * 16) * 3072 + bj * HALF + glo);
                    g1[ai][m][bj] = *(const u32x2*)(gn + (size_t)(ai * HALF + m * 16) * 3072 + bj * HALF + glo);
                }
#pragma unroll
        for (int ai = 0; ai < 2; ++ai)
#pragma unroll
            for (int m = 0; m < 4; ++m)
#pragma unroll
                for (int bj = 0; bj < 2; ++bj) {
                    const f32x4 d0 = rcp4(code4(g1[ai][m][bj].x)), d1 = rcp4(code4(g1[ai][m][bj].y));
                    acc[ai][bj][m][0] *= code4(g0[ai][m][bj].x) * (fin ? (f32x4){q, q, q, q} : d0);
                    acc[ai][bj][m][1] *= code4(g0[ai][m][bj].y) * (fin ? (f32x4){q, q, q, q} : d1);
                    if (fin) *(u32x4*)(mb + (size_t)(ai * HALF + m * 16) * DM * 2 + bj * HALF * 2 + mlo) = pack8(acc[ai][bj][m][0], acc[ai][bj][m][1]);
                }
        return fin;
    }
};
struct EpiPle {
    static constexpr bool CHAIN = false;
    const bf16_t* E; bf16_t* O;
    __device__ __forceinline__ void operator()(const Acc& acc, const Unit& u, int wr, int wc, int fr, int fq) const {
        const size_t uo = ((size_t)u.pm * BM * DM + (size_t)u.pn * BM) * 2;
        const char* eb = (const char*)E + uo; char* ob = (char*)O + uo;
        const unsigned lo = lane_off_of<DM>(wr, wc, fr, fq);
        u32x4 ew[2][4][2];
#pragma unroll
        for (int ai = 0; ai < 2; ++ai)
#pragma unroll
            for (int m = 0; m < 4; ++m)
#pragma unroll
                for (int bj = 0; bj < 2; ++bj) ew[ai][m][bj] = *(const u32x4*)(eb + (size_t)(ai * HALF + m * 16) * DM * 2 + bj * HALF * 2 + lo);
#pragma unroll
        for (int ai = 0; ai < 2; ++ai)
#pragma unroll
            for (int m = 0; m < 4; ++m)
#pragma unroll
                for (int bj = 0; bj < 2; ++bj) {
                    const f32x4 v0 = sigmoid4(acc[ai][bj][m][0]) * unpack_lo4(ew[ai][m][bj]), v1 = sigmoid4(acc[ai][bj][m][1]) * unpack_hi4(ew[ai][m][bj]);
                    *(u32x4*)(ob + (size_t)(ai * HALF + m * 16) * DM * 2 + bj * HALF * 2 + lo) = pack8(v0, v1);
                }
    }
};
}

template <bool INIT>
__device__ __forceinline__ void row_phase(const float* hin, float* h, const bf16_t* F, float cscale, const float* ga, const float* gb, bf16_t* HN, bool write_hn, const int tid, const int bid) {
    const int wid = tid >> 6, lane = tid & 63;
    constexpr int R = 4;
    f32x4 gav[4], gbv[4];
#pragma unroll
    for (int k = 0; k < 4; ++k) {
        gav[k] = INIT ? (f32x4){0.f, 0.f, 0.f, 0.f} : *(const f32x4*)(ga + 256 * k + 4 * lane);
        gbv[k] = write_hn ? *(const f32x4*)(gb + 256 * k + 4 * lane) : (f32x4){0.f, 0.f, 0.f, 0.f};
    }
    for (int row0 = (bid * 8 + wid) * R; row0 < MTOK; row0 += gridDim.x * 8 * R) {
        f32x4 hv[R][4]; u32x2 fw[R][4];
#pragma unroll
        for (int r = 0; r < R; ++r) { const size_t ro = (size_t)(row0 + r) * DM + 4 * lane;
#pragma unroll
            for (int k = 0; k < 4; ++k) {
                hv[r][k] = *(const f32x4*)(hin + ro + 256 * k);
                if (!INIT) fw[r][k] = *(const u32x2*)(F + ro + 256 * k);
            } }
#pragma unroll
        for (int r = 0; r < R; ++r) { const size_t ro = (size_t)(row0 + r) * DM + 4 * lane;
            if (!INIT) {
                f32x4 fv[4];
#pragma unroll
                for (int k = 0; k < 4; ++k) fv[k] = (f32x4){bf_lo(fw[r][k].x), bf_hi(fw[r][k].x), bf_lo(fw[r][k].y), bf_hi(fw[r][k].y)};
                float ss = 0.f;
#pragma unroll
                for (int i = 0; i < 4; ++i) ss += fv[i][0] * fv[i][0] + fv[i][1] * fv[i][1] + fv[i][2] * fv[i][2] + fv[i][3] * fv[i][3];
                ss = wave_sum(ss);
                const float rs = cscale * __builtin_amdgcn_rsqf(ss * (1.0f / DM) + EPS);
#pragma unroll
                for (int i = 0; i < 4; ++i) hv[r][i] += fv[i] * gav[i] * rs;
            }
            float s2 = 0.f;
#pragma unroll
            for (int i = 0; i < 4; ++i) s2 += hv[r][i][0] * hv[r][i][0] + hv[r][i][1] * hv[r][i][1] + hv[r][i][2] * hv[r][i][2] + hv[r][i][3] * hv[r][i][3];
            s2 = wave_sum(s2);
            const float rs2 = __builtin_amdgcn_rsqf(s2 * (1.0f / DM) + EPS);
            if (!INIT) { _Pragma("unroll") for (int k = 0; k < 4; ++k) *(f32x4*)(h + ro + 256 * k) = hv[r][k]; }
            if (write_hn) {
#pragma unroll
                for (int k = 0; k < 4; ++k) { const f32x4 o = hv[r][k] * gbv[k] * rs2; u32x2 w; w.x = cvt_pk_bf16(o[0], o[1]); w.y = cvt_pk_bf16(o[2], o[3]); *(u32x2*)(HN + ro + 256 * k) = w; }
            }
        }
    }
}

__device__ __forceinline__ f32x4 bf4(u32x2 w) { return (f32x4){bf_lo(w.x), bf_hi(w.x), bf_lo(w.y), bf_hi(w.y)}; }
__device__ __forceinline__ float sumsq16(const f32x4 (&v)[4]) { float s = 0.f;
#pragma unroll
    for (int i = 0; i < 4; ++i) s += v[i][0] * v[i][0] + v[i][1] * v[i][1] + v[i][2] * v[i][2] + v[i][3] * v[i][3];
    return s; }
template <bool FULL>
__device__ __forceinline__ void row_phase2(const float* hin, float* h, const bf16_t* F1, float c1, const float* ga1, const bf16_t* F2, float c2, const float* ga2, const float* gb, bf16_t* HN, bool write_hn, const int tid, const int bid) {
    const int wid = tid >> 6, lane = tid & 63;
    constexpr int R = FULL ? 2 : 4;
    f32x4 g1v[4], g2v[4], gbv[4];
#pragma unroll
    for (int k = 0; k < 4; ++k) {
        g1v[k] = *(const f32x4*)(ga1 + 256 * k + 4 * lane);
        g2v[k] = FULL ? *(const f32x4*)(ga2 + 256 * k + 4 * lane) : (f32x4){0.f, 0.f, 0.f, 0.f};
        gbv[k] = write_hn ? *(const f32x4*)(gb + 256 * k + 4 * lane) : (f32x4){0.f, 0.f, 0.f, 0.f};
    }
    for (int row0 = (bid * 8 + wid) * R; row0 < MTOK; row0 += gridDim.x * 8 * R) {
        f32x4 hv[R][4]; u32x2 fa[R][4], fb[R][4];
#pragma unroll
        for (int r = 0; r < R; ++r) { const size_t ro = (size_t)(row0 + r) * DM + 4 * lane;
#pragma unroll
            for (int k = 0; k < 4; ++k) {
                hv[r][k] = *(const f32x4*)(hin + ro + 256 * k);
                fa[r][k] = *(const u32x2*)(F1 + ro + 256 * k);
                if (FULL) fb[r][k] = *(const u32x2*)(F2 + ro + 256 * k);
            } }
#pragma unroll
        for (int r = 0; r < R; ++r) { const size_t ro = (size_t)(row0 + r) * DM + 4 * lane;
            {
                f32x4 fv[4];
#pragma unroll
                for (int k = 0; k < 4; ++k) fv[k] = bf4(fa[r][k]);
                const float rs = c1 * __builtin_amdgcn_rsqf(wave_sum(sumsq16(fv)) * (1.0f / DM) + EPS);
#pragma unroll
                for (int i = 0; i < 4; ++i) hv[r][i] += fv[i] * g1v[i] * rs;
            }
            if (FULL) {
                f32x4 fv[4];
#pragma unroll
                for (int k = 0; k < 4; ++k) fv[k] = bf4(fb[r][k]);
                const float rs = c2 * __builtin_amdgcn_rsqf(wave_sum(sumsq16(fv)) * (1.0f / DM) + EPS);
#pragma unroll
                for (int i = 0; i < 4; ++i) hv[r][i] += fv[i] * g2v[i] * rs;
#pragma unroll
                for (int k = 0; k < 4; ++k) *(f32x4*)(h + ro + 256 * k) = hv[r][k];
            }
            if (write_hn) {
                const float rs2 = __builtin_amdgcn_rsqf(wave_sum(sumsq16(hv[r])) * (1.0f / DM) + EPS);
#pragma unroll
                for (int k = 0; k < 4; ++k) { const f32x4 o = hv[r][k] * gbv[k] * rs2; u32x2 w; w.x = cvt_pk_bf16(o[0], o[1]); w.y = cvt_pk_bf16(o[2], o[3]); *(u32x2*)(HN + ro + 256 * k) = w; }
            }
        }
    }
}

struct PrepJob { const float* src; bf16_t* dst; int ld, col0, k0, K, n0; };
__device__ __forceinline__ PrepJob prep_job(const Params& P, unsigned char* ws, int l, int tix) {
    constexpr int T_GU = (NGU / 64) * (DM / 64), T_D = (DM / 64) * (DFF / 64), T_IN = (NIN / 64) * (DM / 64), T_BR = (DM / 64) * (512 / 64), T_SQ = (DM / 64) * (DM / 64);
    int t = tix; const float* srcA; const float* srcB; int ld, mode, K; bf16_t* dst;
    if (t < T_GU) { srcA = PIN(3) + (size_t)l * DM * DFF; srcB = PIN(4) + (size_t)l * DM * DFF; ld = DFF; mode = 1; K = DM; dst = (bf16_t*)(ws + WS_WGU1); }
    else if ((t -= T_GU) < T_GU) { srcA = PIN(25) + (size_t)l * DM * DFF; srcB = PIN(26) + (size_t)l * DM * DFF; ld = DFF; mode = 1; K = DM; dst = (bf16_t*)(ws + WS_WGU2); }
    else if ((t -= T_GU) < T_D) { srcA = PIN(5) + (size_t)l * DFF * DM; srcB = srcA; ld = DM; mode = 0; K = DFF; dst = (bf16_t*)(ws + WS_WD1); }
    else if ((t -= T_D) < T_D) { srcA = PIN(27) + (size_t)l * DFF * DM; srcB = srcA; ld = DM; mode = 0; K = DFF; dst = (bf16_t*)(ws + WS_WD2); }
    else if ((t -= T_D) < T_IN) { srcA = PIN(8) + (size_t)l * DM * NIN; srcB = srcA; ld = NIN; mode = 2; K = DM; dst = (bf16_t*)(ws + WS_WIN); }
    else if ((t -= T_IN) < T_BR) { srcA = PIN(16) + (size_t)l * 512 * DM; srcB = srcA; ld = DM; mode = 0; K = 512; dst = (bf16_t*)(ws + WS_WBR) + (size_t)1 * DM * 512; }
    else if ((t -= T_BR) < T_BR) { srcA = PIN(21) + (size_t)l * 512 * DM; srcB = srcA; ld = DM; mode = 0; K = 512; dst = (bf16_t*)(ws + WS_WBR) + (size_t)2 * DM * 512; }
    else if ((t -= T_BR) < T_SQ) { srcA = PIN(22) + (size_t)l * DM * DM; srcB = srcA; ld = DM; mode = 0; K = DM; dst = (bf16_t*)(ws + WS_WOUT); }
    else if ((t -= T_SQ) < T_SQ) { srcA = PIN(31) + (size_t)l * DM * DM; srcB = srcA; ld = DM; mode = 0; K = DM; dst = (bf16_t*)(ws + WS_WPG); }
    else { t -= T_SQ; srcA = PIN(29) + (size_t)l * PLE * DM; srcB = srcA; ld = DM; mode = 0; K = PLE; dst = (bf16_t*)(ws + WS_WPP); }
    const int tk = K / 64, tn = t / tk, tkk = t - tn * tk, n0 = tn * 64, k0 = tkk * 64;
    const float* src = srcA; int col0 = n0;
    if (mode == 1) { const int tt = n0 >> 8, j = n0 & 255; if (j < 128) { col0 = 128 * tt + j; } else { src = srcB; col0 = 128 * tt + j - 128; } }
    else if (mode == 2) { if (n0 >= 1536 && n0 < 2560) { const int tt = (n0 - 1536) >> 8, j = (n0 - 1536) & 255; col0 = (j < 128) ? (1536 + 128 * tt + j) : (2048 + 128 * tt + j - 128); } }
    PrepJob J; J.src = src; J.dst = dst; J.ld = ld; J.col0 = col0; J.k0 = k0; J.K = K; J.n0 = n0; return J;
}

__device__ __forceinline__ void prep_weights(const Params& P, unsigned char* ws, int l, LAS unsigned char* lds, const int tid, const int bid) {
    LAS float* tile = (LAS float*)lds;
    constexpr int T_GU = (NGU / 64) * (DM / 64), T_D = (DM / 64) * (DFF / 64), T_IN = (NIN / 64) * (DM / 64), T_BR = (DM / 64) * (512 / 64), T_SQ = (DM / 64) * (DM / 64), T_PP = (DM / 64) * (PLE / 64);
    constexpr int TOTAL = 2 * T_GU + 2 * T_D + T_IN + 2 * T_BR + 2 * T_SQ + T_PP;
    {
        const int kk = tid >> 4, c4 = tid & 15, n = tid >> 3, k8 = tid & 7;
        f32x4 v0, v1; int tix = bid;
        if (tix < TOTAL) { const PrepJob J = prep_job(P, ws, l, tix); const float* sp = J.src + (size_t)(J.k0 + kk) * J.ld + J.col0 + 4 * c4; v0 = *(const f32x4*)sp; v1 = *(const f32x4*)(sp + (size_t)32 * J.ld); }
        for (; tix < TOTAL; tix += gridDim.x) {
            const PrepJob J = prep_job(P, ws, l, tix);
#pragma unroll
            for (int e = 0; e < 4; ++e) { tile[kk * 65 + 4 * c4 + e] = v0[e]; tile[(kk + 32) * 65 + 4 * c4 + e] = v1[e]; }
            __syncthreads();
            const int nx = tix + gridDim.x;
            if (nx < TOTAL) { const PrepJob Jn = prep_job(P, ws, l, nx); const float* sp = Jn.src + (size_t)(Jn.k0 + kk) * Jn.ld + Jn.col0 + 4 * c4; v0 = *(const f32x4*)sp; v1 = *(const f32x4*)(sp + (size_t)32 * Jn.ld); }
            float v[8];
#pragma unroll
            for (int i = 0; i < 8; ++i) v[i] = tile[(8 * k8 + i) * 65 + n];
            u32x4 w; w.x = cvt_pk_bf16(v[0], v[1]); w.y = cvt_pk_bf16(v[2], v[3]); w.z = cvt_pk_bf16(v[4], v[5]); w.w = cvt_pk_bf16(v[6], v[7]);
            *(u32x4*)(J.dst + (size_t)(J.n0 + n) * J.K + J.k0 + 8 * k8) = w;
            __syncthreads();
        }
    }
    {
        const float* pw = PIN(9) + (size_t)l * 4 * 128 * 128; const float* sc = PIN(10) + (size_t)l * 512; const float* wpo = PIN(11) + (size_t)l * 512 * DM;
        bf16_t* dst = (bf16_t*)(ws + WS_WBR);
        const int ol = tid & 63, i4 = __builtin_amdgcn_readfirstlane(tid >> 6);
        for (int tix = bid; tix < 16 * 16; tix += gridDim.x) {
            const int o = (tix >> 4) * 64 + ol, g = (tix >> 2) & 3, i0 = (tix & 3) * 32 + i4 * 4;
            float a[4] = {0.f, 0.f, 0.f, 0.f};
#pragma unroll 4
            for (int j = 0; j < 128; j += 4) {
                const f32x4 s4 = *(const f32x4*)(sc + g * 128 + j);
                float w[4];
#pragma unroll
                for (int jj = 0; jj < 4; ++jj) w[jj] = wpo[(size_t)(g * 128 + j + jj) * DM + o] * s4[jj];
#pragma unroll
                for (int ii = 0; ii < 4; ++ii) { const f32x4 p4 = *(const f32x4*)(pw + (size_t)(g * 128 + i0 + ii) * 128 + j);
                    a[ii] += p4[0] * w[0] + p4[1] * w[1] + p4[2] * w[2] + p4[3] * w[3]; }
            }
            u32x2 w2; w2.x = cvt_pk_bf16(a[0], a[1]); w2.y = cvt_pk_bf16(a[2], a[3]);
            *(u32x2*)(dst + (size_t)o * 512 + g * 128 + i0) = w2;
        }
    }
    {
        const float* wsrc = PIN(14) + (size_t)l * 4 * 128 * 128; bf16_t* dst = (bf16_t*)(ws + WS_WSPK);
        for (int idx = bid * 512 + tid; idx < 4 * 128 * 128 / 8; idx += gridDim.x * 512) {
            const int fq = idx & 3, kk = (idx >> 2) & 3, t = (idx >> 4) & 127, h = idx >> 11;
            float v[8];
#pragma unroll
            for (int i = 0; i < 8; ++i) { const int sp = 32 * kk + 4 * i + fq; v[i] = (sp <= t) ? wsrc[(size_t)(h * 128 + t) * 128 + sp] : 0.f; }
            u32x4 w4; w4.x = cvt_pk_bf16(v[0], v[1]); w4.y = cvt_pk_bf16(v[2], v[3]); w4.z = cvt_pk_bf16(v[4], v[5]); w4.w = cvt_pk_bf16(v[6], v[7]);
            *(u32x4*)(dst + (size_t)idx * 8) = w4;
        }
    }
}

__device__ __forceinline__ void convert_p(const float* p, bf16_t* PB, const int tid, const int bid) {
    for (size_t idx = (size_t)bid * 512 + tid; idx < (size_t)MTOK * PLE / 8; idx += (size_t)gridDim.x * 512) {
        const f32x4 a = *(const f32x4*)(p + idx * 8), b = *(const f32x4*)(p + idx * 8 + 4);
        *(u32x4*)(PB + idx * 8) = pack8(a, b);
    }
}

template <int W>
__device__ __forceinline__ void pool_run(const bf16_t* ZP, bf16_t* XP, const int oct, const int sub, const int bid) {
    for (int it = bid; it < MTOK / 32; it += gridDim.x) {
        const int tok0 = it * 32 + 4 * sub, t0 = tok0 & (SEQ - 1);
        const bf16_t* zp = ZP + (size_t)tok0 * 512 + 8 * oct;
        u32x4 row[W + 3];
#pragma unroll
        for (int j = 0; j < W + 3; ++j) { row[j] = (u32x4){0u, 0u, 0u, 0u}; if (t0 + 3 - j >= 0) row[j] = *(const u32x4*)(zp + (ptrdiff_t)(3 - j) * 512); }
        f32x4 s0 = (f32x4){0.f, 0.f, 0.f, 0.f}, s1 = s0;
#pragma unroll
        for (int j = 0; j < W; ++j) { s0 += unpack_lo4(row[j]); s1 += unpack_hi4(row[j]); }
        f32x4 o0[4], o1[4]; o0[3] = s0; o1[3] = s1;
#pragma unroll
        for (int d = 0; d < 3; ++d) { s0 += unpack_lo4(row[W + d]) - unpack_lo4(row[d]); s1 += unpack_hi4(row[W + d]) - unpack_hi4(row[d]); o0[2 - d] = s0; o1[2 - d] = s1; }
#pragma unroll
        for (int u = 0; u < 4; ++u) { const int t = t0 + u; const float inv = 1.0f / (float)((t + 1) < W ? (t + 1) : W);
            *(u32x4*)(XP + (size_t)(tok0 + u) * 512 + 8 * oct) = pack8(o0[u] * inv - unpack_lo4(row[3 - u]), o1[u] * inv - unpack_hi4(row[3 - u])); }
    }
}

__device__ __forceinline__ void mixer_phase(const Params& P, unsigned char* ws, int l, LAS unsigned char* lds, const int tid, const int bid) {
    unsigned char* big = ws + WS_BIG;
    const bf16_t* ZP = (const bf16_t*)(big + BIG_ZP); const bf16_t* U = (const bf16_t*)(big + BIG_U); const bf16_t* V = (const bf16_t*)(big + BIG_V); const bf16_t* XG = (const bf16_t*)(big + BIG_XG);
    bf16_t* X3 = (bf16_t*)(big + BIG_X3);
    const int wid = __builtin_amdgcn_readfirstlane(tid >> 6), lane = tid & 63;

    {
        const float* lng = PIN(12) + (size_t)l * 512; const float* lnb = PIN(13) + (size_t)l * 512; const float* bsp = PIN(15) + (size_t)l * 4 * 128;
        const bf16_t* WSPK = (const bf16_t*)(ws + WS_WSPK);
        bf16_t* XS = X3 + (size_t)1 * MTOK * 512;
        const int fr = lane & 15, fq = lane >> 4, h = wid >> 1, th = wid & 1;
        constexpr int VP = 528;
        for (int ch = bid; ch < MTOK / 128; ch += gridDim.x) {
            const size_t tok0 = (size_t)ch * 128;
            {
                const f32x4 g0 = *(const f32x4*)(lng + 8 * lane), g1 = *(const f32x4*)(lng + 8 * lane + 4), b0 = *(const f32x4*)(lnb + 8 * lane), b1 = *(const f32x4*)(lnb + 8 * lane + 4);
#pragma unroll
                for (int i0 = 0; i0 < 16; i0 += 8) {
                    u32x4 wv[8];
#pragma unroll
                    for (int i = 0; i < 8; ++i) wv[i] = *(const u32x4*)(V + (tok0 + wid * 16 + i0 + i) * 512 + 8 * lane);
#pragma unroll
                    for (int i = 0; i < 8; ++i) {
                        const int sp = wid * 16 + i0 + i;
                        f32x4 x0 = unpack_lo4(wv[i]), x1 = unpack_hi4(wv[i]);
                        float s = (x0[0] + x0[1]) + (x0[2] + x0[3]) + (x1[0] + x1[1]) + (x1[2] + x1[3]);
                        s = wave_sum(s); const float mu = s * (1.0f / 512.0f);
                        x0 -= mu; x1 -= mu;
                        float q = x0[0] * x0[0] + x0[1] * x0[1] + x0[2] * x0[2] + x0[3] * x0[3] + x1[0] * x1[0] + x1[1] * x1[1] + x1[2] * x1[2] + x1[3] * x1[3];
                        q = wave_sum(q); const float rs = __builtin_amdgcn_rsqf(q * (1.0f / 512.0f) + EPS);
                        x0 = x0 * rs * g0 + b0; x1 = x1 * rs * g1 + b1;
                        *(LAS u32x4*)(lds + (size_t)sp * (VP * 2) + 16 * lane) = pack8(x0, x1);
                    }
                }
            }
            __syncthreads();
            {
                bf16x8 Wf[4][4]; float bs[4];
#pragma unroll
                for (int m = 0; m < 4; ++m) { const int t = 64 * th + 16 * m + fr; bs[m] = bsp[h * 128 + t];
#pragma unroll
                    for (int kk = 0; kk < 4; ++kk) Wf[m][kk] = *(const bf16x8*)(WSPK + ((size_t)((h * 128 + t) * 4 + kk) * 4 + fq) * 8); }
                const size_t ubase = (tok0 + 64 * th + fr) * 512 + 128 * h + 4 * fq;
                u32x2 uw[2][4];
#pragma unroll
                for (int m = 0; m < 4; ++m) uw[0][m] = *(const u32x2*)(U + ubase + (size_t)(16 * m) * 512);
#pragma unroll
                for (int n = 0; n < 8; ++n) {
                    if (n + 1 < 8) {
#pragma unroll
                        for (int m = 0; m < 4; ++m) uw[(n + 1) & 1][m] = *(const u32x2*)(U + ubase + (size_t)(16 * m) * 512 + 16 * (n + 1));
                    }
                    f32x4 acc[4];
#pragma unroll
                    for (int m = 0; m < 4; ++m) acc[m] = (f32x4){0.f, 0.f, 0.f, 0.f};
#pragma unroll
                    for (int kk = 0; kk < 4; ++kk) {
                        bf16x8 X;
#pragma unroll
                        for (int i = 0; i < 8; ++i) X[i] = *(const LAS short*)(lds + (size_t)(32 * kk + 4 * i + fq) * (VP * 2) + 2 * (128 * h + 16 * n + fr));
#pragma unroll
                        for (int m = 0; m < 4; ++m) acc[m] = __builtin_amdgcn_mfma_f32_16x16x32_bf16(X, Wf[m][kk], acc[m], 0, 0, 0);
                    }
#pragma unroll
                    for (int m = 0; m < 4; ++m) {
                        const u32x2 u2 = uw[n & 1][m];
                        const f32x4 sv = acc[m] + bs[m];
                        u32x2 o; o.x = cvt_pk_bf16(bf_lo(u2.x) * sv[0], bf_hi(u2.x) * sv[1]); o.y = cvt_pk_bf16(bf_lo(u2.y) * sv[2], bf_hi(u2.y) * sv[3]);
                        *(u32x2*)(XS + ubase + (size_t)(16 * m) * 512 + 16 * n) = o;
                    }
                }
            }
            __syncthreads();
        }
    }

    {
        const float* dwk = PIN(17) + (size_t)l * 31 * 512; const float* dwb = PIN(18) + (size_t)l * 512; const float* lng = PIN(19) + (size_t)l * 512; const float* lnb = PIN(20) + (size_t)l * 512;
        bf16_t* XC = X3 + (size_t)2 * MTOK * 512;
        LAS unsigned char* xs = lds;
        LAS float* ys = (LAS float*)(lds + 65536);
        const int cp = tid & 255, hbq = __builtin_amdgcn_readfirstlane(tid >> 8);
        f32x2 wk[31];
#pragma unroll
        for (int k = 0; k < 31; ++k) wk[k] = *(const f32x2*)(dwk + k * 512 + 2 * cp);
        const f32x2 bias = *(const f32x2*)(dwb + 2 * cp);
        const f32x4 g0 = *(const f32x4*)(lng + 8 * lane), g1 = *(const f32x4*)(lng + 8 * lane + 4), b0 = *(const f32x4*)(lnb + 8 * lane), b1 = *(const f32x4*)(lnb + 8 * lane + 4);
        u32x4 pre[8];
#define CONV_LOAD(ct_) do { const int tok0_ = (ct_) * 32, t0_ = tok0_ & (SEQ - 1); _Pragma("unroll") for (int i = 0; i < 8; ++i) { const int idx = tid + 512 * i; const int r = idx >> 6, c8 = idx & 63; \
            pre[i] = (u32x4){0u, 0u, 0u, 0u}; if (idx < 62 * 64 && t0_ - 30 + r >= 0) pre[i] = *(const u32x4*)(XG + (size_t)(tok0_ - 30 + r) * 512 + 8 * c8); } } while (0)
        int ct = bid;
        if (ct < MTOK / 32) CONV_LOAD(ct);
        for (; ct < MTOK / 32; ct += gridDim.x) {
            const int tok0 = ct * 32;
#pragma unroll
            for (int i = 0; i < 8; ++i) { const int idx = tid + 512 * i; if (idx < 62 * 64) *(LAS u32x4*)(xs + (idx >> 6) * 1024 + 16 * (idx & 63)) = pre[i]; }
            __syncthreads();
            if (ct + (int)gridDim.x < MTOK / 32) CONV_LOAD(ct + gridDim.x);
            {
                f32x2 x[46];
#pragma unroll
                for (int r = 0; r < 46; ++r) { const unsigned w2 = *(const LAS unsigned*)(xs + (16 * hbq + r) * 1024 + 4 * cp); x[r] = (f32x2){bf_lo(w2), bf_hi(w2)}; }
#pragma unroll
                for (int t = 0; t < 16; ++t) { f32x2 y = bias;
#pragma unroll
                    for (int k = 0; k < 31; ++k) y += wk[k] * x[t + k];
                    *(LAS f32x2*)(ys + (16 * hbq + t) * 512 + 2 * cp) = y; }
            }
            __syncthreads();
#pragma unroll
            for (int i = 0; i < 4; ++i) { const int t = wid * 4 + i;
                f32x4 x0 = *(const LAS f32x4*)(ys + t * 512 + 8 * lane), x1 = *(const LAS f32x4*)(ys + t * 512 + 8 * lane + 4);
                float s = (x0[0] + x0[1]) + (x0[2] + x0[3]) + (x1[0] + x1[1]) + (x1[2] + x1[3]);
                s = wave_sum(s); const float mu = s * (1.0f / 512.0f);
                x0 -= mu; x1 -= mu;
                float q = x0[0] * x0[0] + x0[1] * x0[1] + x0[2] * x0[2] + x0[3] * x0[3] + x1[0] * x1[0] + x1[1] * x1[1] + x1[2] * x1[2] + x1[3] * x1[3];
                q = wave_sum(q); const float rs = __builtin_amdgcn_rsqf(q * (1.0f / 512.0f) + EPS);
                x0 = x0 * rs * g0 + b0; x1 = x1 * rs * g1 + b1;
                x0 = x0 * sigmoid4(x0); x1 = x1 * sigmoid4(x1);
                *(u32x4*)(XC + (size_t)(tok0 + t) * 512 + 8 * lane) = pack8(x0, x1); }
            __syncthreads();
        }
#undef CONV_LOAD
    }

    {
        const int g = wid & 3, oct = g * 16 + (lane & 15), sub = (wid >> 2) * 4 + (lane >> 4);
        switch (g) {
        case 0: pool_run<2>(ZP, X3, oct, sub, bid); break;
        case 1: pool_run<4>(ZP, X3, oct, sub, bid); break;
        case 2: pool_run<8>(ZP, X3, oct, sub, bid); break;
        default: pool_run<16>(ZP, X3, oct, sub, bid); break;
        }
    }
}

#define XB_TMO      128
#define XB_XCNT(j)  (256  + 64 * (j))
#define XB_XSUB(j)  (1280 + 64 * (j))
#define XB_XGEN(j)  (2304 + 64 * (j))
#define XB_TOP      3328
#define XB_TOPGEN   3392
#define XCD_BAR_WORDS 3456
#define XB_SPIN_CAP (1u << 18)
__device__ __forceinline__ unsigned xb_ld(unsigned* p)              { return __hip_atomic_load(p, __ATOMIC_RELAXED, __HIP_MEMORY_SCOPE_AGENT); }
__device__ __forceinline__ unsigned xb_add(unsigned* p, unsigned v) { return __hip_atomic_fetch_add(p, v, __ATOMIC_RELAXED, __HIP_MEMORY_SCOPE_AGENT); }
__device__ __forceinline__ unsigned xb_xcc_id() { return (unsigned)__builtin_amdgcn_s_getreg((3 << 11) | 20) & 0xFu; }
#define XB_SPIN(cond, bar) do { unsigned _sp = 0; while (cond) { __builtin_amdgcn_s_sleep(1); \
    if ((++_sp & 255u) == 0u) { if (xb_ld(&(bar)[XB_TMO])) break; if (_sp > XB_SPIN_CAP) { atomicAdd(&(bar)[XB_TMO], 1u); break; } } } } while (0)
struct XcdBarrier { unsigned* bar; unsigned x; volatile LAS unsigned* st; };
__device__ __forceinline__ XcdBarrier xcd_barrier_post(unsigned* bar, volatile LAS unsigned* st) {
    XcdBarrier b; b.bar = bar; b.x = xb_xcc_id(); b.st = st;
    if (threadIdx.x == 0) (void)xb_add(&bar[XB_XCNT(b.x)], 1u);
    return b;
}
__device__ __forceinline__ void xcd_barrier_complete(unsigned* bar, unsigned x, unsigned& nloc, unsigned& nx) {
    const unsigned G = gridDim.x * gridDim.y * gridDim.z;
    unsigned sum, cnt, mine, sp = 0u;
    for (;;) {
        sum = 0u; cnt = 0u; mine = 0u;
#pragma unroll
        for (unsigned j = 0; j < 16; ++j) { const unsigned c = xb_ld(&bar[XB_XCNT(j)]); sum += c; cnt += (c > 0u) ? 1u : 0u; mine = (j == x) ? c : mine; }
        if (sum == G) break;
        __builtin_amdgcn_s_sleep(1);
        if ((++sp & 255u) == 0u) { if (xb_ld(&bar[XB_TMO])) break; if (sp > XB_SPIN_CAP) { atomicAdd(&bar[XB_TMO], 1u); break; } }
    }
    nloc = mine > 0u ? mine : 1u; nx = cnt > 0u ? cnt : 1u;
}
__device__ __forceinline__ void xcd_barrier(const XcdBarrier& b) {
    asm volatile("s_waitcnt vmcnt(0)" ::: "memory");
    __syncthreads();
    if (threadIdx.x == 0) {
        unsigned* bar = b.bar;
        __builtin_amdgcn_s_waitcnt(0);
        unsigned nloc = b.st[0], nx = b.st[1];
        if (nloc == 0u) { xcd_barrier_complete(bar, b.x, nloc, nx); b.st[0] = nloc; b.st[1] = nx; }
        const unsigned old = xb_add(&bar[XB_XSUB(b.x)], 1u);
        const unsigned gen = old / nloc;
        if (old + 1u == (gen + 1u) * nloc) {
            __builtin_amdgcn_fence(__ATOMIC_RELEASE, "agent");
            asm volatile("s_waitcnt vmcnt(0)" ::: "memory");
            const unsigned og = xb_add(&bar[XB_TOP], 1u);
            const unsigned tg = og / nx;
            if (og + 1u == (tg + 1u) * nx) xb_add(&bar[XB_TOPGEN], 1u);
            else XB_SPIN(xb_ld(&bar[XB_TOPGEN]) == tg, bar);
            __builtin_amdgcn_fence(__ATOMIC_ACQUIRE, "agent");
            xb_add(&bar[XB_XGEN(b.x)], 1u);
            asm volatile("s_waitcnt vmcnt(0)" ::: "memory");
        } else {
            XB_SPIN(xb_ld(&bar[XB_XGEN(b.x)]) == gen, bar);
            __builtin_amdgcn_fence(__ATOMIC_ACQUIRE, "agent");
            asm volatile("s_waitcnt vmcnt(0)" ::: "memory");
        }
    }
    __syncthreads();
}

__device__ __forceinline__ void run_phase(const Params& P, int ph, LAS unsigned char* lds, const float rmul = 1.0f, const bool row_only = false) {
    GAS unsigned char* wsg = P.ws; GAS float* outg = P.out; int tid = threadIdx.x, bid = blockIdx.x;
    asm volatile("" : "+s"(wsg), "+s"(outg), "+v"(tid), "+s"(bid));
    unsigned char* ws = (unsigned char*)wsg; float* out = (float*)outg;
    unsigned char* big = ws + WS_BIG;
    bf16_t* HN = (bf16_t*)(ws + WS_HN); bf16_t* F = (bf16_t*)(ws + WS_F); bf16_t* F2 = (bf16_t*)(ws + WS_F2);
    const int G = gridDim.x, c = bid;
    constexpr unsigned PM = PHASE_MASK;
    if (ph == 0) {
        if (!(PM & (1u << 13))) return;
        prep_weights(P, ws, 0, lds, tid, bid);
        row_phase<true>(PIN(0), out, nullptr, 0.f, nullptr, PIN(2), HN, true, tid, bid);
        return;
    }
    const int l = (ph - 1) / 13, sub = (ph - 1) % 13;
    pg8::Order S;
    switch (sub) {
    case 0: case 8: if (PM & 1u) {
        pg8::Gemm g{HN, (const bf16_t*)(ws + (sub == 0 ? WS_WGU1 : WS_WGU2)), MTOK, NGU, DM}; S.init(MTOK, NGU, G, c, 1);
        pg8::EpiGLU E{(bf16_t*)(big + BIG_ACT)};
        pg8::gemm_phase(lds, g, S, E, tid);
        if (sub == 8) {
            pg8::Gemm g2{(const bf16_t*)(big + BIG_PB), (const bf16_t*)(ws + WS_WPP), MTOK, DM, PLE}; S.init(MTOK, DM, G, c, 1);
            pg8::EpiStore E2{(bf16_t*)(big + BIG_E)};
            pg8::gemm_phase(lds, g2, S, E2, tid);
        }
    } break;
    case 1: case 9: if (PM & 2u) {
        pg8::Gemm g{(const bf16_t*)(big + BIG_ACT), (const bf16_t*)(ws + (sub == 1 ? WS_WD1 : WS_WD2)), MTOK, DM, DFF}; S.init(MTOK, DM, G, c, 1);
        pg8::EpiStore E{F};
        pg8::gemm_phase(lds, g, S, E, tid);
    } break;
    case 2: if (PM & 4u) row_phase2<false>(l == 0 ? PIN(0) : (const float*)out, out, F, 0.5f, PIN(6) + l * DM, nullptr, 0.f, nullptr, PIN(7) + l * DM, HN, true, tid, bid); break;
    case 3: if (PM & 8u) {
        pg8::Gemm g{HN, (const bf16_t*)(ws + WS_WIN), MTOK, NIN, DM}; S.init(MTOK, NIN, G, c, 1);
        pg8::EpiIn E{(bf16_t*)(big + BIG_ZP), (bf16_t*)(big + BIG_U), (bf16_t*)(big + BIG_V), (bf16_t*)(big + BIG_XG), (bf16_t*)(big + BIG_GATES)};
        pg8::gemm_phase(lds, g, S, E, tid);
    } break;
    case 4: if (PM & 16u) mixer_phase(P, ws, l, lds, tid, bid); break;
    case 5: if (PM & 32u) {
        pg8::Gemm g{(const bf16_t*)(big + BIG_X3), (const bf16_t*)(ws + WS_WBR), MTOK, DM, 512}; S.init(MTOK, DM, G, c, 3);
        pg8::EpiBranch E{(const unsigned char*)(big + BIG_GATES), (bf16_t*)(big + BIG_MERGED)};
        pg8::gemm_phase(lds, g, S, E, tid);
    } break;
    case 6: if (PM & 64u) {
        pg8::Gemm g{(const bf16_t*)(big + BIG_MERGED), (const bf16_t*)(ws + WS_WOUT), MTOK, DM, DM}; S.init(MTOK, DM, G, c, 1);
        pg8::EpiStore E{F2};
        pg8::gemm_phase(lds, g, S, E, tid);
    } break;
    case 7: if (PM & 128u) {
        row_phase2<true>(l == 0 ? PIN(0) : (const float*)out, out, F, 0.5f, PIN(6) + l * DM, F2, 1.0f, PIN(23) + l * DM, PIN(24) + l * DM, HN, true, tid, bid);
        if (!row_only) convert_p(PIN(1) + (size_t)l * MTOK * PLE, (bf16_t*)(big + BIG_PB), tid, bid);
        } break;
    case 10: if (PM & 1024u) row_phase2<false>(out, out, F, 0.5f, PIN(28) + l * DM, nullptr, 0.f, nullptr, PIN(30) + l * DM, HN, true, tid, bid); break;
    case 11: if (PM & 2048u) {
        pg8::Gemm g{HN, (const bf16_t*)(ws + WS_WPG), MTOK, DM, DM}; S.init(MTOK, DM, G, c, 1);
        pg8::EpiPle E{(const bf16_t*)(big + BIG_E), F2};
        pg8::gemm_phase(lds, g, S, E, tid);
    } break;
    case 12: if (PM & 4096u) {
        row_phase2<true>(out, out, F, 0.5f, PIN(28) + l * DM, F2, 1.0f, PIN(32) + l * DM, PIN(2) + (l + 1 < NLAYER ? l + 1 : l) * DM, HN, l + 1 < NLAYER, tid, bid);
        if (l + 1 < NLAYER && !row_only) prep_weights(P, ws, l + 1, lds, tid, bid);
        } break;
    default: break;
    }
}

__global__ void __launch_bounds__(512, 2) mega(Params P) {
    extern __shared__ __attribute__((aligned(16))) unsigned char lds_raw[];
    LAS unsigned char* lds = (LAS unsigned char*)lds_raw;
    cg::grid_group grid = cg::this_grid();
#if !MULTI_LAUNCH
    volatile LAS unsigned* st = (volatile LAS unsigned*)(lds + LDS_BYTES - 16);
    if (threadIdx.x < 2) st[threadIdx.x] = 0u;
    __syncthreads();
    const XcdBarrier bar = xcd_barrier_post((unsigned*)((unsigned char*)P.ws + WS_BAR), st);
#endif
    for (int ph = P.ph_lo; ph < P.ph_hi; ++ph) {
        run_phase(P, ph, lds);
#if PROBE_DUP
        {
            const int sub = ph == 0 ? -1 : (ph - 1) % 13;
            const bool is_gemm = (sub == 0 || sub == 1 || sub == 3 || sub == 5 || sub == 6 || sub == 8 || sub == 9 || sub == 11);
            if (((PROBE_DUP & 1) && is_gemm) || ((PROBE_DUP & 2) && sub == 4)) { __syncthreads(); run_phase(P, ph, lds); }
#if !MULTI_LAUNCH
            if ((PROBE_DUP & 4) && ph > 0) xcd_barrier(bar);
#endif
        }
#endif
#if !MULTI_LAUNCH
        if (ph + 1 < P.ph_hi) { if (ph == 0) grid.sync(); else xcd_barrier(bar); }
#endif
    }
}

extern "C" void kernel_launch(void* const* d_in, const int* in_sizes, int n_in, void* d_out, int out_size, void* d_ws, size_t ws_size, hipStream_t stream) {
    static int grid = 0;
    if (grid == 0) {
        if (n_in != 33 || ws_size < WS_END) { fprintf(stderr, "kernel_launch: unexpected n_in %d or ws_size %zu (< %zu)\n", n_in, ws_size, (size_t)WS_END); grid = -1; return; }
        int dev = 0, cus = 0, per_cu = 0;
        hipGetDevice(&dev);
        hipDeviceGetAttribute(&cus, hipDeviceAttributeMultiprocessorCount, dev);
        if (hipFuncSetAttribute((const void*)mega, hipFuncAttributeMaxDynamicSharedMemorySize, LDS_BYTES) != hipSuccess) { fprintf(stderr, "kernel_launch: hipFuncSetAttribute failed\n"); grid = -1; return; }
        hipOccupancyMaxActiveBlocksPerMultiprocessor(&per_cu, (const void*)mega, 512, LDS_BYTES);
        if (per_cu < 1) per_cu = 1;
        (void)hipGetLastError();
        grid = cus * per_cu;
    }
    if (grid < 0) return;
    Params p{};
    for (int i = 0; i < 33; ++i) p.in[i] = (const GAS float*)d_in[i];
    p.out = (GAS float*)d_out; p.ws = (GAS unsigned char*)d_ws;
#if MULTI_LAUNCH
    for (int ph = 0; ph < NPHASE; ++ph) {
        p.ph_lo = ph; p.ph_hi = ph + 1;
        hipLaunchKernelGGL(mega, dim3(grid), dim3(512), LDS_BYTES, stream, p);
    }
#else
    p.ph_lo = 0; p.ph_hi = NPHASE;
    if (hipMemsetAsync((char*)d_ws + WS_BAR, 0, 16384, stream) != hipSuccess) { fprintf(stderr, "kernel_launch: memset of the barrier words failed\n"); return; }
    void* args[] = {&p};
    hipError_t e = hipLaunchCooperativeKernel((const void*)mega, dim3(grid), dim3(512), args, LDS_BYTES, stream);
    if (e != hipSuccess) fprintf(stderr, "cooperative launch failed: %s (grid %d)\n", hipGetErrorString(e), grid);
#endif
}
```

```cpp
#include <hip/hip_runtime.h>
#include <hip/hip_cooperative_groups.h>
#include <cstdio>
namespace cg = cooperative_groups;

#ifndef PHASE_MASK
#define PHASE_MASK 0xffffu
#endif
#ifndef PROBE_DUP
#define PROBE_DUP 0
#endif
#ifndef MULTI_LAUNCH
#define MULTI_LAUNCH 0
#endif

#define LAS __attribute__((address_space(3)))
typedef unsigned short bf16_t;
typedef short bf16x8 __attribute__((ext_vector_type(8)));
typedef float f32x4 __attribute__((ext_vector_type(4)));
typedef float f32x2 __attribute__((ext_vector_type(2)));
typedef unsigned u32x4 __attribute__((ext_vector_type(4)));
typedef unsigned u32x2 __attribute__((ext_vector_type(2)));

constexpr int MTOK = 32768, DM = 1024, DFF = 2816, SEQ = 4096, NLAYER = 4, PLE = 256;
constexpr int NGU = 2 * DFF;
constexpr int NIN = 5632;
constexpr float EPS = 1e-6f;
constexpr int LDS_BYTES = 147456;
constexpr int NPHASE = 1 + 13 * NLAYER;

constexpr size_t WS_WGU1 = 0;
constexpr size_t WS_WD1 = WS_WGU1 + (size_t)NGU * DM * 2;
constexpr size_t WS_WGU2 = WS_WD1 + (size_t)DM * DFF * 2;
constexpr size_t WS_WD2 = WS_WGU2 + (size_t)NGU * DM * 2;
constexpr size_t WS_WIN = WS_WD2 + (size_t)DM * DFF * 2;
constexpr size_t WS_WBR = WS_WIN + (size_t)NIN * DM * 2;
constexpr size_t WS_WOUT = WS_WBR + (size_t)3 * DM * 512 * 2;
constexpr size_t WS_WPG = WS_WOUT + (size_t)DM * DM * 2;
constexpr size_t WS_WPP = WS_WPG + (size_t)DM * DM * 2;
constexpr size_t WS_WSPK = WS_WPP + (size_t)DM * PLE * 2;
constexpr size_t WS_HN = WS_WSPK + (size_t)4 * 128 * 128 * 2;
constexpr size_t WS_F = WS_HN + (size_t)MTOK * DM * 2;
constexpr size_t WS_BIG = WS_F + (size_t)MTOK * DM * 2;
constexpr size_t BIG_ACT = 0;
constexpr size_t BIG_ZP = 0, BIG_U = (size_t)MTOK * 512 * 2, BIG_V = 2 * BIG_U, BIG_XG = 3 * BIG_U;
constexpr size_t BIG_GATES = 4 * BIG_U;
constexpr size_t BIG_X3 = BIG_GATES + (size_t)MTOK * 3072 * 2;
constexpr size_t BIG_MERGED = 0;
constexpr size_t BIG_E = (size_t)192 * 1024 * 1024;
constexpr size_t BIG_PB = BIG_X3;
constexpr size_t WS_BAR = WS_BIG + BIG_X3 + (size_t)3 * MTOK * 512 * 2;
constexpr size_t WS_F2 = WS_BAR + 16384;
constexpr size_t WS_END = WS_F2 + (size_t)MTOK * DM * 2;

#define GAS __attribute__((address_space(1)))
struct Params { const GAS float* in[33]; GAS float* out; GAS unsigned char* ws; int ph_lo, ph_hi; };
#define PIN(i) ((const float*)P.in[i])

typedef __bf16 bf16x2_t __attribute__((ext_vector_type(2)));
__device__ __forceinline__ unsigned cvt_pk_bf16(float lo, float hi) { const f32x2 v = {lo, hi}; return __builtin_bit_cast(unsigned, __builtin_convertvector(v, bf16x2_t)); }
__device__ __forceinline__ float bf_lo(unsigned w) { return __uint_as_float(w << 16); }
__device__ __forceinline__ float bf_hi(unsigned w) { return __uint_as_float(w & 0xffff0000u); }
__device__ __forceinline__ float sigmoid_f(float x) { return __builtin_amdgcn_rcpf(1.0f + __builtin_amdgcn_exp2f(-1.44269504f * x)); }
template <int CTRL> __device__ __forceinline__ float dpp_add(float v) { return v + __builtin_bit_cast(float, __builtin_amdgcn_update_dpp(0, __builtin_bit_cast(int, v), CTRL, 0xf, 0xf, false)); }
__device__ __forceinline__ float wave_sum(float v) {
    v = dpp_add<0xB1>(v);
    v = dpp_add<0x4E>(v);
    v = dpp_add<0x141>(v);
    v = dpp_add<0x140>(v);
    const int iv = __builtin_bit_cast(int, v);
    return (__builtin_bit_cast(float, __builtin_amdgcn_readlane(iv, 0)) + __builtin_bit_cast(float, __builtin_amdgcn_readlane(iv, 16)))
         + (__builtin_bit_cast(float, __builtin_amdgcn_readlane(iv, 32)) + __builtin_bit_cast(float, __builtin_amdgcn_readlane(iv, 48)));
}
__device__ __forceinline__ f32x2 gelu_pk(f32x2 v) {
    const f32x2 av = __builtin_elementwise_abs(v), d = av * 0.2316418882f + 1.0f;
    f32x2 t; t.x = __builtin_amdgcn_rcpf(d.x); t.y = __builtin_amdgcn_rcpf(d.y);
    f32x2 q = t * 0.5307027145f + (-0.7265760135f); q = q * t + 0.7107068705f; q = q * t + (-0.142248368f); q = q * t + 0.127414796f; q = q * t;
    const f32x2 s = (v * v) * (-0.72134752044f);
    f32x2 e; e.x = __builtin_amdgcn_exp2f(s.x); e.y = __builtin_amdgcn_exp2f(s.y);
    const f32x2 m = v * (q * e), r = v - m;
    f32x2 o; o.x = v.x < 0.f ? m.x : r.x; o.y = v.y < 0.f ? m.y : r.y; return o;
}
__device__ __forceinline__ f32x4 gelu4(f32x4 v) { f32x2 a = gelu_pk((f32x2){v[0], v[1]}), b = gelu_pk((f32x2){v[2], v[3]}); return (f32x4){a.x, a.y, b.x, b.y}; }
__device__ __forceinline__ f32x4 sigmoid4(f32x4 v) { return (f32x4){sigmoid_f(v[0]), sigmoid_f(v[1]), sigmoid_f(v[2]), sigmoid_f(v[3])}; }
__device__ __forceinline__ u32x4 pack8(f32x4 a, f32x4 b) { u32x4 w; w.x = cvt_pk_bf16(a[0], a[1]); w.y = cvt_pk_bf16(a[2], a[3]); w.z = cvt_pk_bf16(b[0], b[1]); w.w = cvt_pk_bf16(b[2], b[3]); return w; }
__device__ __forceinline__ f32x4 unpack_lo4(u32x4 w) { return (f32x4){bf_lo(w.x), bf_hi(w.x), bf_lo(w.y), bf_hi(w.y)}; }
__device__ __forceinline__ f32x4 unpack_hi4(u32x4 w) { return (f32x4){bf_lo(w.z), bf_hi(w.z), bf_lo(w.w), bf_hi(w.w)}; }

namespace pg8 {
constexpr int BM = 256, BK = 64, HALF = 128, HTB = HALF * BK * 2, STAGE_BYTES = 8 * HTB, NXCD = 8, WGM = 8;
__device__ __forceinline__ int lds_byte(int r, int c) { const int st = (r >> 4) * 2 + (c >> 5), rr = r & 15, cc = c & 31, ob = rr * 64 + cc * 2; return st * 1024 + (ob ^ (((ob >> 9) & 1) << 5)); }
__device__ __forceinline__ void stage_rc(int b, int& R, int& C) { const int st = b / 1024, sb = b % 1024, swz = sb ^ (((sb >> 9) & 1) << 5); R = (st >> 1) * 16 + swz / 64; C = (st & 1) * 32 + (swz % 64) / 2; }
__device__ __forceinline__ int perm32(int rho) { const int n = rho >> 4, i = rho & 15; return 8 * (i >> 2) + 4 * n + (i & 3); }

struct Unit { int pm, pn; };
struct Gemm { const bf16_t* A; const bf16_t* Bt; int M, N, K; };

struct Order {
    int nM, nN, nwg, G, c, zn;
    __device__ void init(int M, int N, int G_, int c_, int zn_) { nM = M / BM; nN = N / BM; nwg = nM * nN; G = G_; c = c_; zn = zn_; }
    __device__ bool next(int i, Unit& u) const {
        const int ti = i / zn, z = i - ti * zn;
        const long L = (long)ti * G + c; if (L >= nwg) return false;
        int wgid = (int)L; { const int q = nwg / NXCD, r = nwg % NXCD, xcd = wgid % NXCD, off = wgid / NXCD; wgid = (xcd < r ? xcd * (q + 1) : r * (q + 1) + (xcd - r) * q) + off; }
        const int nig = WGM * nN, gid = wgid / nig, fm = gid * WGM, gsz = (nM - fm) < WGM ? (nM - fm) : WGM;
        u.pm = z * nM + fm + ((wgid % nig) % gsz); u.pn = z * nN + (wgid % nig) / gsz; return true;
    }
};

template <class Epi>
__device__ __forceinline__ void gemm_phase(LAS unsigned char* lds, const Gemm g, const Order& S, const Epi& E, const int tid) {
    const int wid = __builtin_amdgcn_readfirstlane(tid >> 6), lane = tid & 63, wr = wid >> 2, wc = wid & 3, fr = lane & 15, fq = lane >> 4;
    const int K = g.K, nt = K / BK;
    unsigned voffA[2], voffB[2];
#pragma unroll
    for (int i = 0; i < 2; ++i) { int R, C; stage_rc(tid * 16 + i * 8192, R, C); const int Rb = (R & ~31) + perm32(R & 31);
        voffA[i] = (unsigned)(R * K + C) * 2u; voffB[i] = (unsigned)(Rb * K + C) * 2u; }
    const size_t kstep = (size_t)(BK * 2);
    const size_t hstep = (size_t)HALF * K * 2;
    const size_t tstep = 2 * hstep;
    const unsigned ldsw = (unsigned)wid * 1024u;
    const int aoff = lds_byte(wr * 64 + fr, fq * 8), boff = lds_byte(wc * 32 + fr, fq * 8);
#define PG8_SA(b, h) (((b) * 2 + (h)) * HTB)
#define PG8_SB(b, h) ((4 + (b) * 2 + (h)) * HTB)
#define PG8_STAGE(bufoff, gbase, voff) do { _Pragma("unroll") for (int _i = 0; _i < 2; ++_i) \
        __builtin_amdgcn_global_load_lds((const unsigned*)((const char*)(gbase) + (voff)[_i]), (LAS unsigned*)(lds + (bufoff) + ldsw + _i * 8192), 16, 0, 0); } while (0)
#define PG8_LDA(dst, b, h) do { _Pragma("unroll") for (int m = 0; m < 4; ++m) _Pragma("unroll") for (int k = 0; k < 2; ++k) dst[m][k] = *(const LAS bf16x8*)(lds + PG8_SA(b, h) + aoff + m * 2048 + k * 1024); } while (0)
#define PG8_LDB(dst, b, h) do { _Pragma("unroll") for (int n = 0; n < 2; ++n) _Pragma("unroll") for (int k = 0; k < 2; ++k) dst[n][k] = *(const LAS bf16x8*)(lds + PG8_SB(b, h) + boff + n * 2048 + k * 1024); } while (0)
#define PG8_MMA(ai, bj, At, Bt) do { __builtin_amdgcn_s_setprio(1); _Pragma("unroll") for (int m = 0; m < 4; ++m) _Pragma("unroll") for (int n = 0; n < 2; ++n) _Pragma("unroll") for (int k = 0; k < 2; ++k) \
        acc[ai][bj][m][n] = __builtin_amdgcn_mfma_f32_16x16x32_bf16(Bt[n][k], At[m][k], acc[ai][bj][m][n], 0, 0, 0); __builtin_amdgcn_s_setprio(0); } while (0)
#define PG8_WAIT_V(n) asm volatile("s_waitcnt vmcnt(" #n ")" ::: "memory")
#define PG8_WAIT_L(n) asm volatile("s_waitcnt lgkmcnt(" #n ")" ::: "memory")
#define PG8_BAR __builtin_amdgcn_s_barrier()
#define PG8_SCHED __builtin_amdgcn_sched_barrier(0)
    Unit cur, nxt; int ui = 0;
    if (!S.next(0, cur)) return;
    f32x4 acc[2][2][4][2];
#pragma unroll
    for (int a = 0; a < 2; ++a)
#pragma unroll
        for (int b = 0; b < 2; ++b)
#pragma unroll
            for (int m = 0; m < 4; ++m)
#pragma unroll
                for (int n = 0; n < 2; ++n) acc[a][b][m][n] = (f32x4){0.f, 0.f, 0.f, 0.f};
    bf16x8 At[4][2], B0[2][2], B1[2][2];
    const char* cA = (const char*)g.A + (size_t)cur.pm * tstep; const char* cB = (const char*)g.Bt + (size_t)cur.pn * tstep;
    PG8_STAGE(PG8_SB(0, 0), cB, voffB); PG8_STAGE(PG8_SA(0, 0), cA, voffA); PG8_STAGE(PG8_SB(0, 1), cB + hstep, voffB); PG8_STAGE(PG8_SA(0, 1), cA + hstep, voffA);
    if (wr == 1) PG8_BAR;
    PG8_WAIT_V(4); PG8_BAR;
    PG8_STAGE(PG8_SB(1, 0), cB + kstep, voffB); PG8_STAGE(PG8_SA(1, 0), cA + kstep, voffA); PG8_STAGE(PG8_SB(1, 1), cB + hstep + kstep, voffB);
    PG8_WAIT_V(6); PG8_BAR;
    for (;;) {
        const bool has_next = S.next(ui + 1, nxt);
        const char* nA = has_next ? (const char*)g.A + (size_t)nxt.pm * tstep : cA; const char* nB = has_next ? (const char*)g.Bt + (size_t)nxt.pn * tstep : cB;
        for (int t = 0; t < nt; t += 2) {
            const bool last = (t == nt - 2);
            const char* a1 = cA + (size_t)(t + 1) * kstep;
            const char* a2 = last ? nA : cA + (size_t)(t + 2) * kstep; const char* b2 = last ? nB : cB + (size_t)(t + 2) * kstep;
            const char* a3 = a2 + kstep; const char* b3 = b2 + kstep;
            PG8_LDB(B0, 0, 0); PG8_SCHED; PG8_LDA(At, 0, 0); PG8_STAGE(PG8_SA(1, 1), a1 + hstep, voffA);
            PG8_WAIT_L(8); PG8_BAR; PG8_WAIT_L(0); PG8_MMA(0, 0, At, B0); PG8_BAR; PG8_SCHED;
            PG8_LDB(B1, 0, 1); PG8_STAGE(PG8_SB(0, 0), b2, voffB);
            PG8_BAR; PG8_WAIT_L(0); PG8_MMA(0, 1, At, B1); PG8_BAR;
            PG8_LDA(At, 0, 1); PG8_STAGE(PG8_SA(0, 0), a2, voffA);
            PG8_BAR; PG8_WAIT_L(0); PG8_MMA(1, 0, At, B0); PG8_BAR; PG8_SCHED;
            PG8_STAGE(PG8_SB(0, 1), b2 + hstep, voffB);
            PG8_WAIT_V(6); PG8_BAR; PG8_MMA(1, 1, At, B1); PG8_BAR;
            PG8_LDB(B0, 1, 0); PG8_SCHED; PG8_LDA(At, 1, 0); PG8_STAGE(PG8_SA(0, 1), a2 + hstep, voffA);
            PG8_WAIT_L(8); PG8_BAR; PG8_WAIT_L(0); PG8_MMA(0, 0, At, B0); PG8_BAR; PG8_SCHED;
            PG8_LDB(B1, 1, 1); PG8_STAGE(PG8_SB(1, 0), b3, voffB);
            PG8_BAR; PG8_WAIT_L(0); PG8_MMA(0, 1, At, B1); PG8_BAR;
            PG8_LDA(At, 1, 1); PG8_STAGE(PG8_SA(1, 0), a3, voffA);
            PG8_BAR; PG8_WAIT_L(0); PG8_MMA(1, 0, At, B0); PG8_BAR; PG8_SCHED;
            PG8_STAGE(PG8_SB(1, 1), b3 + hstep, voffB);
            PG8_WAIT_V(6); PG8_BAR; PG8_MMA(1, 1, At, B1); PG8_BAR;
        }
        bool zero_acc = true;
        if constexpr (Epi::CHAIN) zero_acc = E.chain(acc, cur, wr, wc, fr, fq);
        else E(acc, cur, wr, wc, fr, fq);
        if (!has_next) break;
        if (zero_acc)
#pragma unroll
        for (int a = 0; a < 2; ++a)
#pragma unroll
            for (int b = 0; b < 2; ++b)
#pragma unroll
                for (int m = 0; m < 4; ++m)
#pragma unroll
                    for (int n = 0; n < 2; ++n) acc[a][b][m][n] = (f32x4){0.f, 0.f, 0.f, 0.f};
        cur = nxt; cA = nA; cB = nB; ++ui;
    }
    PG8_WAIT_V(0);
    if (wr == 0) PG8_BAR;
    PG8_BAR;
#undef PG8_SA
#undef PG8_SB
#undef PG8_STAGE
#undef PG8_LDA
#undef PG8_LDB
#undef PG8_MMA
#undef PG8_WAIT_V
#undef PG8_WAIT_L
#undef PG8_BAR
#undef PG8_SCHED
}

typedef f32x4 Acc[2][2][4][2];
template <int ACT, int LDC> __device__ __forceinline__ void glu_store(const Acc& acc, char* ub, unsigned lane_off) {
#pragma unroll
    for (int ai = 0; ai < 2; ++ai)
#pragma unroll
        for (int m = 0; m < 4; ++m) {
            char* rp = ub + (size_t)(ai * HALF + m * 16) * LDC * 2;
            f32x4 v[2];
#pragma unroll
            for (int n = 0; n < 2; ++n) { const f32x4 a = acc[ai][0][m][n], b = acc[ai][1][m][n];
                if (ACT == 0) v[n] = a * sigmoid4(a) * b; else v[n] = a * sigmoid4(b); }
            *(u32x4*)(rp + lane_off) = pack8(v[0], v[1]);
        }
}
template <int LDC> __device__ __forceinline__ unsigned lane_off_of(int wr, int wc, int fr, int fq) { return (unsigned)((wr * 64 + fr) * LDC + wc * 32 + 8 * fq) * 2u; }
struct EpiGLU {
    static constexpr bool CHAIN = false;
    bf16_t* O;
    __device__ __forceinline__ void operator()(const Acc& acc, const Unit& u, int wr, int wc, int fr, int fq) const {
        glu_store<0, DFF>(acc, (char*)O + ((size_t)u.pm * BM * DFF + (size_t)u.pn * 128) * 2, lane_off_of<DFF>(wr, wc, fr, fq));
    }
};
template <int ACT, int LDC> __device__ __forceinline__ void plain_store(const Acc& acc, char* ub, unsigned lane_off) {
#pragma unroll
    for (int ai = 0; ai < 2; ++ai)
#pragma unroll
        for (int m = 0; m < 4; ++m) {
            char* rp = ub + (size_t)(ai * HALF + m * 16) * LDC * 2;
#pragma unroll
            for (int bj = 0; bj < 2; ++bj) { f32x4 v0 = acc[ai][bj][m][0], v1 = acc[ai][bj][m][1];
                if (ACT == 1) { v0 = gelu4(v0); v1 = gelu4(v1); }
                if (ACT == 2) { v0 = sigmoid4(v0); v1 = sigmoid4(v1); }
                *(u32x4*)(rp + bj * HALF * 2 + lane_off) = pack8(v0, v1); }
        }
}
struct EpiStore {
    static constexpr bool CHAIN = false;
    bf16_t* O;
    __device__ __forceinline__ void operator()(const Acc& acc, const Unit& u, int wr, int wc, int fr, int fq) const {
        plain_store<0, DM>(acc, (char*)O + ((size_t)u.pm * BM * DM + (size_t)u.pn * BM) * 2, lane_off_of<DM>(wr, wc, fr, fq));
    }
};
struct EpiIn {
    static constexpr bool CHAIN = false;
    bf16_t *ZP, *U, *V, *XG, *GATES;
    __device__ __forceinline__ void operator()(const Acc& acc, const Unit& u, int wr, int wc, int fr, int fq) const {
        const int pn = u.pn; const size_t rb = (size_t)u.pm * BM;
        if (pn >= 10) {
            char* ub = (char*)GATES + rb * 3072 + (size_t)(pn - 10) * 256; const unsigned lo = (unsigned)((wr * 64 + fr) * 3072 + wc * 32 + 8 * fq);
#pragma unroll
            for (int ai = 0; ai < 2; ++ai)
#pragma unroll
                for (int m = 0; m < 4; ++m)
#pragma unroll
                    for (int bj = 0; bj < 2; ++bj) {
                        const f32x4 v0 = sigmoid4(acc[ai][bj][m][0]) * 255.0f, v1 = sigmoid4(acc[ai][bj][m][1]) * 255.0f;
                        u32x2 w; w.x = 0u; w.y = 0u;
                        w.x = __builtin_amdgcn_cvt_pk_u8_f32(v0[0], 0, w.x); w.x = __builtin_amdgcn_cvt_pk_u8_f32(v0[1], 1, w.x); w.x = __builtin_amdgcn_cvt_pk_u8_f32(v0[2], 2, w.x); w.x = __builtin_amdgcn_cvt_pk_u8_f32(v0[3], 3, w.x);
                        w.y = __builtin_amdgcn_cvt_pk_u8_f32(v1[0], 0, w.y); w.y = __builtin_amdgcn_cvt_pk_u8_f32(v1[1], 1, w.y); w.y = __builtin_amdgcn_cvt_pk_u8_f32(v1[2], 2, w.y); w.y = __builtin_amdgcn_cvt_pk_u8_f32(v1[3], 3, w.y);
                        *(u32x2*)(ub + (size_t)(ai * HALF + m * 16) * 3072 + bj * HALF + lo) = w;
                    }
        }
        else {
            const unsigned lo = lane_off_of<512>(wr, wc, fr, fq);
            if (pn >= 6) glu_store<1, 512>(acc, (char*)XG + (rb * 512 + (size_t)(pn - 6) * 128) * 2, lo);
            else if (pn < 2) plain_store<0, 512>(acc, (char*)ZP + (rb * 512 + (size_t)pn * 256) * 2, lo);
            else { char* ub = (char*)(pn < 4 ? U : V) + (rb * 512 + (size_t)(pn & 1) * 256) * 2; plain_store<1, 512>(acc, ub, lo); }
        }
    }
};
struct EpiBranch {
    static constexpr bool CHAIN = true;
    const unsigned char* GATES; bf16_t* MG;
    static __device__ __forceinline__ f32x4 code4(unsigned w) { return (f32x4){__builtin_fmaxf((float)(w & 255u), 0.25f), __builtin_fmaxf((float)((w >> 8) & 255u), 0.25f), __builtin_fmaxf((float)((w >> 16) & 255u), 0.25f), __builtin_fmaxf((float)(w >> 24), 0.25f)}; }
    static __device__ __forceinline__ f32x4 rcp4(f32x4 v) { return (f32x4){__builtin_amdgcn_rcpf(v[0]), __builtin_amdgcn_rcpf(v[1]), __builtin_amdgcn_rcpf(v[2]), __builtin_amdgcn_rcpf(v[3])}; }
    __device__ __forceinline__ bool chain(Acc& acc, const Unit& u, int wr, int wc, int fr, int fq) const {
        const int z = u.pn >> 2, pn = u.pn & 3, pm = u.pm - z * 128;
        const bool fin = (z == 2);
        const char* gb = (const char*)GATES + (size_t)pm * BM * 3072 + (size_t)z * 1024 + (size_t)pn * BM;
        const char* gn = fin ? gb : gb + 1024;
        const unsigned glo = (unsigned)((wr * 64 + fr) * 3072 + wc * 32 + 8 * fq);
        char* mb = (char*)MG + ((size_t)pm * BM * DM + (size_t)pn * BM) * 2;
        const unsigned mlo = lane_off_of<DM>(wr, wc, fr, fq);
        constexpr float q = 1.0f / 255.0f;
        u32x2 g0[2][4][2], g1[2][4][2];
#pragma unroll
        for (int ai = 0; ai < 2; ++ai)
#pragma unroll
            for (int m = 0; m < 4; ++m)
#pragma unroll
                for (int bj = 0; bj < 2; ++bj) {
                    g0[ai][m][bj] = *(const u32x2*)(gb + (size_t)(ai * HALF + m * 16) * 3072 + bj * HALF + glo);
                    g1[ai][m][bj] = *(const u32x2*)(gn + (size_t)(ai * HALF + m * 16) * 3072 + bj * HALF + glo);
                }
#pragma unroll
        for (int ai = 0; ai < 2; ++ai)
#pragma unroll
            for (int m = 0; m < 4; ++m)
#pragma unroll
                for (int bj = 0; bj < 2; ++bj) {
                    const f32x4 d0 = rcp4(code4(g1[ai][m][bj].x)), d1 = rcp4(code4(g1[ai][m][bj].y));
                    acc[ai][bj][m][0] *= code4(g0[ai][m][bj].x) * (fin ? (f32x4){q, q, q, q} : d0);
                    acc[ai][bj][m][1] *= code4(g0[ai][m][bj].y) * (fin ? (f32x4){q, q, q, q} : d1);
                    if (fin) *(u32x4*)(mb + (size_t)(ai * HALF + m * 16) * DM * 2 + bj * HALF * 2 + mlo) = pack8(acc[ai][bj][m][0], acc[ai][bj][m][1]);
                }
        return fin;
    }
};
struct EpiPle {
    static constexpr bool CHAIN = false;
    const bf16_t* E; bf16_t* O;
    __device__ __forceinline__ void operator()(const Acc& acc, const Unit& u, int wr, int wc, int fr, int fq) const {
        const size_t uo = ((size_t)u.pm * BM * DM + (size_t)u.pn * BM) * 2;
        const char* eb = (const char*)E + uo; char* ob = (char*)O + uo;
        const unsigned lo = lane_off_of<DM>(wr, wc, fr, fq);
        u32x4 ew[2][4][2];
#pragma unroll
        for (int ai = 0; ai < 2; ++ai)
#pragma unroll
            for (int m = 0; m < 4; ++m)
#pragma unroll
                for (int bj = 0; bj < 2; ++bj) ew[ai][m][bj] = *(const u32x4*)(eb + (size_t)(ai * HALF + m * 16) * DM * 2 + bj * HALF * 2 + lo);
#pragma unroll
        for (int ai = 0; ai < 2; ++ai)
#pragma unroll
            for (int m = 0; m < 4; ++m)
#pragma unroll
                for (int bj = 0; bj < 2; ++bj) {
                    const f32x4 v0 = sigmoid4(acc[ai][bj][m][0]) * unpack_lo4(ew[ai][m][bj]), v1 = sigmoid4(acc[ai][bj][m][1]) * unpack_hi4(ew[ai][m][bj]);
                    *(u32x4*)(ob + (size_t)(ai * HALF + m * 16) * DM * 2 + bj * HALF * 2 + lo) = pack8(v0, v1);
                }
    }
};
}

template <bool INIT>
__device__ __forceinline__ void row_phase(const float* hin, float* h, const bf16_t* F, float cscale, const float* ga, const float* gb, bf16_t* HN, bool write_hn, const int tid, const int bid) {
    const int wid = tid >> 6, lane = tid & 63;
    constexpr int R = 4;
    f32x4 gav[4], gbv[4];
#pragma unroll
    for (int k = 0; k < 4; ++k) {
        gav[k] = INIT ? (f32x4){0.f, 0.f, 0.f, 0.f} : *(const f32x4*)(ga + 256 * k + 4 * lane);
        gbv[k] = write_hn ? *(const f32x4*)(gb + 256 * k + 4 * lane) : (f32x4){0.f, 0.f, 0.f, 0.f};
    }
    for (int row0 = (bid * 8 + wid) * R; row0 < MTOK; row0 += gridDim.x * 8 * R) {
        f32x4 hv[R][4]; u32x2 fw[R][4];
#pragma unroll
        for (int r = 0; r < R; ++r) { const size_t ro = (size_t)(row0 + r) * DM + 4 * lane;
#pragma unroll
            for (int k = 0; k < 4; ++k) {
                hv[r][k] = *(const f32x4*)(hin + ro + 256 * k);
                if (!INIT) fw[r][k] = *(const u32x2*)(F + ro + 256 * k);
            } }
#pragma unroll
        for (int r = 0; r < R; ++r) { const size_t ro = (size_t)(row0 + r) * DM + 4 * lane;
            if (!INIT) {
                f32x4 fv[4];
#pragma unroll
                for (int k = 0; k < 4; ++k) fv[k] = (f32x4){bf_lo(fw[r][k].x), bf_hi(fw[r][k].x), bf_lo(fw[r][k].y), bf_hi(fw[r][k].y)};
                float ss = 0.f;
#pragma unroll
                for (int i = 0; i < 4; ++i) ss += fv[i][0] * fv[i][0] + fv[i][1] * fv[i][1] + fv[i][2] * fv[i][2] + fv[i][3] * fv[i][3];
                ss = wave_sum(ss);
                const float rs = cscale * __builtin_amdgcn_rsqf(ss * (1.0f / DM) + EPS);
#pragma unroll
                for (int i = 0; i < 4; ++i) hv[r][i] += fv[i] * gav[i] * rs;
            }
            float s2 = 0.f;
#pragma unroll
            for (int i = 0; i < 4; ++i) s2 += hv[r][i][0] * hv[r][i][0] + hv[r][i][1] * hv[r][i][1] + hv[r][i][2] * hv[r][i][2] + hv[r][i][3] * hv[r][i][3];
            s2 = wave_sum(s2);
            const float rs2 = __builtin_amdgcn_rsqf(s2 * (1.0f / DM) + EPS);
            if (!INIT) { _Pragma("unroll") for (int k = 0; k < 4; ++k) *(f32x4*)(h + ro + 256 * k) = hv[r][k]; }
            if (write_hn) {
#pragma unroll
                for (int k = 0; k < 4; ++k) { const f32x4 o = hv[r][k] * gbv[k] * rs2; u32x2 w; w.x = cvt_pk_bf16(o[0], o[1]); w.y = cvt_pk_bf16(o[2], o[3]); *(u32x2*)(HN + ro + 256 * k) = w; }
            }
        }
    }
}

__device__ __forceinline__ f32x4 bf4(u32x2 w) { return (f32x4){bf_lo(w.x), bf_hi(w.x), bf_lo(w.y), bf_hi(w.y)}; }
__device__ __forceinline__ float sumsq16(const f32x4 (&v)[4]) { float s = 0.f;
#pragma unroll
    for (int i = 0; i < 4; ++i) s += v[i][0] * v[i][0] + v[i][1] * v[i][1] + v[i][2] * v[i][2] + v[i][3] * v[i][3];
    return s; }
template <bool FULL>
__device__ __forceinline__ void row_phase2(const float* hin, float* h, const bf16_t* F1, float c1, const float* ga1, const bf16_t* F2, float c2, const float* ga2, const float* gb, bf16_t* HN, bool write_hn, const int tid, const int bid) {
    const int wid = tid >> 6, lane = tid & 63;
    constexpr int R = FULL ? 2 : 4;
    f32x4 g1v[4], g2v[4], gbv[4];
#pragma unroll
    for (int k = 0; k < 4; ++k) {
        g1v[k] = *(const f32x4*)(ga1 + 256 * k + 4 * lane);
        g2v[k] = FULL ? *(const f32x4*)(ga2 + 256 * k + 4 * lane) : (f32x4){0.f, 0.f, 0.f, 0.f};
        gbv[k] = write_hn ? *(const f32x4*)(gb + 256 * k + 4 * lane) : (f32x4){0.f, 0.f, 0.f, 0.f};
    }
    for (int row0 = (bid * 8 + wid) * R; row0 < MTOK; row0 += gridDim.x * 8 * R) {
        f32x4 hv[R][4]; u32x2 fa[R][4], fb[R][4];
#pragma unroll
        for (int r = 0; r < R; ++r) { const size_t ro = (size_t)(row0 + r) * DM + 4 * lane;
#pragma unroll
            for (int k = 0; k < 4; ++k) {
                hv[r][k] = *(const f32x4*)(hin + ro + 256 * k);
                fa[r][k] = *(const u32x2*)(F1 + ro + 256 * k);
                if (FULL) fb[r][k] = *(const u32x2*)(F2 + ro + 256 * k);
            } }
#pragma unroll
        for (int r = 0; r < R; ++r) { const size_t ro = (size_t)(row0 + r) * DM + 4 * lane;
            {
                f32x4 fv[4];
#pragma unroll
                for (int k = 0; k < 4; ++k) fv[k] = bf4(fa[r][k]);
                const float rs = c1 * __builtin_amdgcn_rsqf(wave_sum(sumsq16(fv)) * (1.0f / DM) + EPS);
#pragma unroll
                for (int i = 0; i < 4; ++i) hv[r][i] += fv[i] * g1v[i] * rs;
            }
            if (FULL) {
                f32x4 fv[4];
#pragma unroll
                for (int k = 0; k < 4; ++k) fv[k] = bf4(fb[r][k]);
                const float rs = c2 * __builtin_amdgcn_rsqf(wave_sum(sumsq16(fv)) * (1.0f / DM) + EPS);
#pragma unroll
                for (int i = 0; i < 4; ++i) hv[r][i] += fv[i] * g2v[i] * rs;
#pragma unroll
                for (int k = 0; k < 4; ++k) *(f32x4*)(h + ro + 256 * k) = hv[r][k];
            }
            if (write_hn) {
                const float rs2 = __builtin_amdgcn_rsqf(wave_sum(sumsq16(hv[r])) * (1.0f / DM) + EPS);
#pragma unroll
                for (int k = 0; k < 4; ++k) { const f32x4 o = hv[r][k] * gbv[k] * rs2; u32x2 w; w.x = cvt_pk_bf16(o[0], o[1]); w.y = cvt_pk_bf16(o[2], o[3]); *(u32x2*)(HN + ro + 256 * k) = w; }
            }
        }
    }
}

struct PrepJob { const float* src; bf16_t* dst; int ld, col0, k0, K, n0; };
__device__ __forceinline__ PrepJob prep_job(const Params& P, unsigned char* ws, int l, int tix) {
    constexpr int T_GU = (NGU / 64) * (DM / 64), T_D = (DM / 64) * (DFF / 64), T_IN = (NIN / 64) * (DM / 64), T_BR = (DM / 64) * (512 / 64), T_SQ = (DM / 64) * (DM / 64);
    int t = tix; const float* srcA; const float* srcB; int ld, mode, K; bf16_t* dst;
    if (t < T_GU) { srcA = PIN(3) + (size_t)l * DM * DFF; srcB = PIN(4) + (size_t)l * DM * DFF; ld = DFF; mode = 1; K = DM; dst = (bf16_t*)(ws + WS_WGU1); }
    else if ((t -= T_GU) < T_GU) { srcA = PIN(25) + (size_t)l * DM * DFF; srcB = PIN(26) + (size_t)l * DM * DFF; ld = DFF; mode = 1; K = DM; dst = (bf16_t*)(ws + WS_WGU2); }
    else if ((t -= T_GU) < T_D) { srcA = PIN(5) + (size_t)l * DFF * DM; srcB = srcA; ld = DM; mode = 0; K = DFF; dst = (bf16_t*)(ws + WS_WD1); }
    else if ((t -= T_D) < T_D) { srcA = PIN(27) + (size_t)l * DFF * DM; srcB = srcA; ld = DM; mode = 0; K = DFF; dst = (bf16_t*)(ws + WS_WD2); }
    else if ((t -= T_D) < T_IN) { srcA = PIN(8) + (size_t)l * DM * NIN; srcB = srcA; ld = NIN; mode = 2; K = DM; dst = (bf16_t*)(ws + WS_WIN); }
    else if ((t -= T_IN) < T_BR) { srcA = PIN(16) + (size_t)l * 512 * DM; srcB = srcA; ld = DM; mode = 0; K = 512; dst = (bf16_t*)(ws + WS_WBR) + (size_t)1 * DM * 512; }
    else if ((t -= T_BR) < T_BR) { srcA = PIN(21) + (size_t)l * 512 * DM; srcB = srcA; ld = DM; mode = 0; K = 512; dst = (bf16_t*)(ws + WS_WBR) + (size_t)2 * DM * 512; }
    else if ((t -= T_BR) < T_SQ) { srcA = PIN(22) + (size_t)l * DM * DM; srcB = srcA; ld = DM; mode = 0; K = DM; dst = (bf16_t*)(ws + WS_WOUT); }
    else if ((t -= T_SQ) < T_SQ) { srcA = PIN(31) + (size_t)l * DM * DM; srcB = srcA; ld = DM; mode = 0; K = DM; dst = (bf16_t*)(ws + WS_WPG); }
    else { t -= T_SQ; srcA = PIN(29) + (size_t)l * PLE * DM; srcB = srcA; ld = DM; mode = 0; K = PLE; dst = (bf16_t*)(ws + WS_WPP); }
    const int tk = K / 64, tn = t / tk, tkk = t - tn * tk, n0 = tn * 64, k0 = tkk * 64;
    const float* src = srcA; int col0 = n0;
    if (mode == 1) { const int tt = n0 >> 8, j = n0 & 255; if (j < 128) { col0 = 128 * tt + j; } else { src = srcB; col0 = 128 * tt + j - 128; } }
    else if (mode == 2) { if (n0 >= 1536 && n0 < 2560) { const int tt = (n0 - 1536) >> 8, j = (n0 - 1536) & 255; col0 = (j < 128) ? (1536 + 128 * tt + j) : (2048 + 128 * tt + j - 128); } }
    PrepJob J; J.src = src; J.dst = dst; J.ld = ld; J.col0 = col0; J.k0 = k0; J.K = K; J.n0 = n0; return J;
}

__device__ __forceinline__ void prep_weights(const Params& P, unsigned char* ws, int l, LAS unsigned char* lds, const int tid, const int bid) {
    LAS float* tile = (LAS float*)lds;
    constexpr int T_GU = (NGU / 64) * (DM / 64), T_D = (DM / 64) * (DFF / 64), T_IN = (NIN / 64) * (DM / 64), T_BR = (DM / 64) * (512 / 64), T_SQ = (DM / 64) * (DM / 64), T_PP = (DM / 64) * (PLE / 64);
    constexpr int TOTAL = 2 * T_GU + 2 * T_D + T_IN + 2 * T_BR + 2 * T_SQ + T_PP;
    {
        const int kk = tid >> 4, c4 = tid & 15, n = tid >> 3, k8 = tid & 7;
        f32x4 v0, v1; int tix = bid;
        if (tix < TOTAL) { const PrepJob J = prep_job(P, ws, l, tix); const float* sp = J.src + (size_t)(J.k0 + kk) * J.ld + J.col0 + 4 * c4; v0 = *(const f32x4*)sp; v1 = *(const f32x4*)(sp + (size_t)32 * J.ld); }
        for (; tix < TOTAL; tix += gridDim.x) {
            const PrepJob J = prep_job(P, ws, l, tix);
#pragma unroll
            for (int e = 0; e < 4; ++e) { tile[kk * 65 + 4 * c4 + e] = v0[e]; tile[(kk + 32) * 65 + 4 * c4 + e] = v1[e]; }
            __syncthreads();
            const int nx = tix + gridDim.x;
            if (nx < TOTAL) { const PrepJob Jn = prep_job(P, ws, l, nx); const float* sp = Jn.src + (size_t)(Jn.k0 + kk) * Jn.ld + Jn.col0 + 4 * c4; v0 = *(const f32x4*)sp; v1 = *(const f32x4*)(sp + (size_t)32 * Jn.ld); }
            float v[8];
#pragma unroll
            for (int i = 0; i < 8; ++i) v[i] = tile[(8 * k8 + i) * 65 + n];
            u32x4 w; w.x = cvt_pk_bf16(v[0], v[1]); w.y = cvt_pk_bf16(v[2], v[3]); w.z = cvt_pk_bf16(v[4], v[5]); w.w = cvt_pk_bf16(v[6], v[7]);
            *(u32x4*)(J.dst + (size_t)(J.n0 + n) * J.K + J.k0 + 8 * k8) = w;
            __syncthreads();
        }
    }
    {
        const float* pw = PIN(9) + (size_t)l * 4 * 128 * 128; const float* sc = PIN(10) + (size_t)l * 512; const float* wpo = PIN(11) + (size_t)l * 512 * DM;
        bf16_t* dst = (bf16_t*)(ws + WS_WBR);
        const int ol = tid & 63, i4 = __builtin_amdgcn_readfirstlane(tid >> 6);
        for (int tix = bid; tix < 16 * 16; tix += gridDim.x) {
            const int o = (tix >> 4) * 64 + ol, g = (tix >> 2) & 3, i0 = (tix & 3) * 32 + i4 * 4;
            float a[4] = {0.f, 0.f, 0.f, 0.f};
#pragma unroll 4
            for (int j = 0; j < 128; j += 4) {
                const f32x4 s4 = *(const f32x4*)(sc + g * 128 + j);
                float w[4];
#pragma unroll
                for (int jj = 0; jj < 4; ++jj) w[jj] = wpo[(size_t)(g * 128 + j + jj) * DM + o] * s4[jj];
#pragma unroll
                for (int ii = 0; ii < 4; ++ii) { const f32x4 p4 = *(const f32x4*)(pw + (size_t)(g * 128 + i0 + ii) * 128 + j);
                    a[ii] += p4[0] * w[0] + p4[1] * w[1] + p4[2] * w[2] + p4[3] * w[3]; }
            }
            u32x2 w2; w2.x = cvt_pk_bf16(a[0], a[1]); w2.y = cvt_pk_bf16(a[2], a[3]);
            *(u32x2*)(dst + (size_t)o * 512 + g * 128 + i0) = w2;
        }
    }
    {
        const float* wsrc = PIN(14) + (size_t)l * 4 * 128 * 128; bf16_t* dst = (bf16_t*)(ws + WS_WSPK);
        for (int idx = bid * 512 + tid; idx < 4 * 128 * 128 / 8; idx += gridDim.x * 512) {
            const int fq = idx & 3, kk = (idx >> 2) & 3, t = (idx >> 4) & 127, h = idx >> 11;
            float v[8];
#pragma unroll
            for (int i = 0; i < 8; ++i) { const int sp = 32 * kk + 4 * i + fq; v[i] = (sp <= t) ? wsrc[(size_t)(h * 128 + t) * 128 + sp] : 0.f; }
            u32x4 w4; w4.x = cvt_pk_bf16(v[0], v[1]); w4.y = cvt_pk_bf16(v[2], v[3]); w4.z = cvt_pk_bf16(v[4], v[5]); w4.w = cvt_pk_bf16(v[6], v[7]);
            *(u32x4*)(dst + (size_t)idx * 8) = w4;
        }
    }
}

__device__ __forceinline__ void convert_p(const float* p, bf16_t* PB, const int tid, const int bid) {
    for (size_t idx = (size_t)bid * 512 + tid; idx < (size_t)MTOK * PLE / 8; idx += (size_t)gridDim.x * 512) {
        const f32x4 a = *(const f32x4*)(p + idx * 8), b = *(const f32x4*)(p + idx * 8 + 4);
        *(u32x4*)(PB + idx * 8) = pack8(a, b);
    }
}

template <int W>
__device__ __forceinline__ void pool_run(const bf16_t* ZP, bf16_t* XP, const int oct, const int sub, const int bid) {
    for (int it = bid; it < MTOK / 32; it += gridDim.x) {
        const int tok0 = it * 32 + 4 * sub, t0 = tok0 & (SEQ - 1);
        const bf16_t* zp = ZP + (size_t)tok0 * 512 + 8 * oct;
        u32x4 row[W + 3];
#pragma unroll
        for (int j = 0; j < W + 3; ++j) { row[j] = (u32x4){0u, 0u, 0u, 0u}; if (t0 + 3 - j >= 0) row[j] = *(const u32x4*)(zp + (ptrdiff_t)(3 - j) * 512); }
        f32x4 s0 = (f32x4){0.f, 0.f, 0.f, 0.f}, s1 = s0;
#pragma unroll
        for (int j = 0; j < W; ++j) { s0 += unpack_lo4(row[j]); s1 += unpack_hi4(row[j]); }
        f32x4 o0[4], o1[4]; o0[3] = s0; o1[3] = s1;
#pragma unroll
        for (int d = 0; d < 3; ++d) { s0 += unpack_lo4(row[W + d]) - unpack_lo4(row[d]); s1 += unpack_hi4(row[W + d]) - unpack_hi4(row[d]); o0[2 - d] = s0; o1[2 - d] = s1; }
#pragma unroll
        for (int u = 0; u < 4; ++u) { const int t = t0 + u; const float inv = 1.0f / (float)((t + 1) < W ? (t + 1) : W);
            *(u32x4*)(XP + (size_t)(tok0 + u) * 512 + 8 * oct) = pack8(o0[u] * inv - unpack_lo4(row[3 - u]), o1[u] * inv - unpack_hi4(row[3 - u])); }
    }
}

__device__ __forceinline__ void mixer_phase(const Params& P, unsigned char* ws, int l, LAS unsigned char* lds, const int tid, const int bid) {
    unsigned char* big = ws + WS_BIG;
    const bf16_t* ZP = (const bf16_t*)(big + BIG_ZP); const bf16_t* U = (const bf16_t*)(big + BIG_U); const bf16_t* V = (const bf16_t*)(big + BIG_V); const bf16_t* XG = (const bf16_t*)(big + BIG_XG);
    bf16_t* X3 = (bf16_t*)(big + BIG_X3);
    const int wid = __builtin_amdgcn_readfirstlane(tid >> 6), lane = tid & 63;

    {
        const float* lng = PIN(12) + (size_t)l * 512; const float* lnb = PIN(13) + (size_t)l * 512; const float* bsp = PIN(15) + (size_t)l * 4 * 128;
        const bf16_t* WSPK = (const bf16_t*)(ws + WS_WSPK);
        bf16_t* XS = X3 + (size_t)1 * MTOK * 512;
        const int fr = lane & 15, fq = lane >> 4, h = wid >> 1, th = wid & 1;
        constexpr int VP = 528;
        for (int ch = bid; ch < MTOK / 128; ch += gridDim.x) {
            const size_t tok0 = (size_t)ch * 128;
            {
                const f32x4 g0 = *(const f32x4*)(lng + 8 * lane), g1 = *(const f32x4*)(lng + 8 * lane + 4), b0 = *(const f32x4*)(lnb + 8 * lane), b1 = *(const f32x4*)(lnb + 8 * lane + 4);
#pragma unroll
                for (int i0 = 0; i0 < 16; i0 += 8) {
                    u32x4 wv[8];
#pragma unroll
                    for (int i = 0; i < 8; ++i) wv[i] = *(const u32x4*)(V + (tok0 + wid * 16 + i0 + i) * 512 + 8 * lane);
#pragma unroll
                    for (int i = 0; i < 8; ++i) {
                        const int sp = wid * 16 + i0 + i;
                        f32x4 x0 = unpack_lo4(wv[i]), x1 = unpack_hi4(wv[i]);
                        float s = (x0[0] + x0[1]) + (x0[2] + x0[3]) + (x1[0] + x1[1]) + (x1[2] + x1[3]);
                        s = wave_sum(s); const float mu = s * (1.0f / 512.0f);
                        x0 -= mu; x1 -= mu;
                        float q = x0[0] * x0[0] + x0[1] * x0[1] + x0[2] * x0[2] + x0[3] * x0[3] + x1[0] * x1[0] + x1[1] * x1[1] + x1[2] * x1[2] + x1[3] * x1[3];
                        q = wave_sum(q); const float rs = __builtin_amdgcn_rsqf(q * (1.0f / 512.0f) + EPS);
                        x0 = x0 * rs * g0 + b0; x1 = x1 * rs * g1 + b1;
                        *(LAS u32x4*)(lds + (size_t)sp * (VP * 2) + 16 * lane) = pack8(x0, x1);
                    }
                }
            }
            __syncthreads();
            {
                bf16x8 Wf[4][4]; float bs[4];
#pragma unroll
                for (int m = 0; m < 4; ++m) { const int t = 64 * th + 16 * m + fr; bs[m] = bsp[h * 128 + t];
#pragma unroll
                    for (int kk = 0; kk < 4; ++kk) Wf[m][kk] = *(const bf16x8*)(WSPK + ((size_t)((h * 128 + t) * 4 + kk) * 4 + fq) * 8); }
                const size_t ubase = (tok0 + 64 * th + fr) * 512 + 128 * h + 4 * fq;
                u32x2 uw[2][4];
#pragma unroll
                for (int m = 0; m < 4; ++m) uw[0][m] = *(const u32x2*)(U + ubase + (size_t)(16 * m) * 512);
#pragma unroll
                for (int n = 0; n < 8; ++n) {
                    if (n + 1 < 8) {
#pragma unroll
                        for (int m = 0; m < 4; ++m) uw[(n + 1) & 1][m] = *(const u32x2*)(U + ubase + (size_t)(16 * m) * 512 + 16 * (n + 1));
                    }
                    f32x4 acc[4];
#pragma unroll
                    for (int m = 0; m < 4; ++m) acc[m] = (f32x4){0.f, 0.f, 0.f, 0.f};
#pragma unroll
                    for (int kk = 0; kk < 4; ++kk) {
                        bf16x8 X;
#pragma unroll
                        for (int i = 0; i < 8; ++i) X[i] = *(const LAS short*)(lds + (size_t)(32 * kk + 4 * i + fq) * (VP * 2) + 2 * (128 * h + 16 * n + fr));
#pragma unroll
                        for (int m = 0; m < 4; ++m) acc[m] = __builtin_amdgcn_mfma_f32_16x16x32_bf16(X, Wf[m][kk], acc[m], 0, 0, 0);
                    }
#pragma unroll
                    for (int m = 0; m < 4; ++m) {
                        const u32x2 u2 = uw[n & 1][m];
                        const f32x4 sv = acc[m] + bs[m];
                        u32x2 o; o.x = cvt_pk_bf16(bf_lo(u2.x) * sv[0], bf_hi(u2.x) * sv[1]); o.y = cvt_pk_bf16(bf_lo(u2.y) * sv[2], bf_hi(u2.y) * sv[3]);
                        *(u32x2*)(XS + ubase + (size_t)(16 * m) * 512 + 16 * n) = o;
                    }
                }
            }
            __syncthreads();
        }
    }

    {
        const float* dwk = PIN(17) + (size_t)l * 31 * 512; const float* dwb = PIN(18) + (size_t)l * 512; const float* lng = PIN(19) + (size_t)l * 512; const float* lnb = PIN(20) + (size_t)l * 512;
        bf16_t* XC = X3 + (size_t)2 * MTOK * 512;
        LAS unsigned char* xs = lds;
        LAS float* ys = (LAS float*)(lds + 65536);
        const int cp = tid & 255, hbq = __builtin_amdgcn_readfirstlane(tid >> 8);
        f32x2 wk[31];
#pragma unroll
        for (int k = 0; k < 31; ++k) wk[k] = *(const f32x2*)(dwk + k * 512 + 2 * cp);
        const f32x2 bias = *(const f32x2*)(dwb + 2 * cp);
        const f32x4 g0 = *(const f32x4*)(lng + 8 * lane), g1 = *(const f32x4*)(lng + 8 * lane + 4), b0 = *(const f32x4*)(lnb + 8 * lane), b1 = *(const f32x4*)(lnb + 8 * lane + 4);
        u32x4 pre[8];
#define CONV_LOAD(ct_) do { const int tok0_ = (ct_) * 32, t0_ = tok0_ & (SEQ - 1); _Pragma("unroll") for (int i = 0; i < 8; ++i) { const int idx = tid + 512 * i; const int r = idx >> 6, c8 = idx & 63; \
            pre[i] = (u32x4){0u, 0u, 0u, 0u}; if (idx < 62 * 64 && t0_ - 30 + r >= 0) pre[i] = *(const u32x4*)(XG + (size_t)(tok0_ - 30 + r) * 512 + 8 * c8); } } while (0)
        int ct = bid;
        if (ct < MTOK / 32) CONV_LOAD(ct);
        for (; ct < MTOK / 32; ct += gridDim.x) {
            const int tok0 = ct * 32;
#pragma unroll
            for (int i = 0; i < 8; ++i) { const int idx = tid + 512 * i; if (idx < 62 * 64) *(LAS u32x4*)(xs + (idx >> 6) * 1024 + 16 * (idx & 63)) = pre[i]; }
            __syncthreads();
            if (ct + (int)gridDim.x < MTOK / 32) CONV_LOAD(ct + gridDim.x);
            {
                f32x2 x[46];
#pragma unroll
                for (int r = 0; r < 46; ++r) { const unsigned w2 = *(const LAS unsigned*)(xs + (16 * hbq + r) * 1024 + 4 * cp); x[r] = (f32x2){bf_lo(w2), bf_hi(w2)}; }
#pragma unroll
                for (int t = 0; t < 16; ++t) { f32x2 y = bias;
#pragma unroll
                    for (int k = 0; k < 31; ++k) y += wk[k] * x[t + k];
                    *(LAS f32x2*)(ys + (16 * hbq + t) * 512 + 2 * cp) = y; }
            }
            __syncthreads();
#pragma unroll
            for (int i = 0; i < 4; ++i) { const int t = wid * 4 + i;
                f32x4 x0 = *(const LAS f32x4*)(ys + t * 512 + 8 * lane), x1 = *(const LAS f32x4*)(ys + t * 512 + 8 * lane + 4);
                float s = (x0[0] + x0[1]) + (x0[2] + x0[3]) + (x1[0] + x1[1]) + (x1[2] + x1[3]);
                s = wave_sum(s); const float mu = s * (1.0f / 512.0f);
                x0 -= mu; x1 -= mu;
                float q = x0[0] * x0[0] + x0[1] * x0[1] + x0[2] * x0[2] + x0[3] * x0[3] + x1[0] * x1[0] + x1[1] * x1[1] + x1[2] * x1[2] + x1[3] * x1[3];
                q = wave_sum(q); const float rs = __builtin_amdgcn_rsqf(q * (1.0f / 512.0f) + EPS);
                x0 = x0 * rs * g0 + b0; x1 = x1 * rs * g1 + b1;
                x0 = x0 * sigmoid4(x0); x1 = x1 * sigmoid4(x1);
                *(u32x4*)(XC + (size_t)(tok0 + t) * 512 + 8 * lane) = pack8(x0, x1); }
            __syncthreads();
        }
#undef CONV_LOAD
    }

    {
        const int g = wid & 3, oct = g * 16 + (lane & 15), sub = (wid >> 2) * 4 + (lane >> 4);
        switch (g) {
        case 0: pool_run<2>(ZP, X3, oct, sub, bid); break;
        case 1: pool_run<4>(ZP, X3, oct, sub, bid); break;
        case 2: pool_run<8>(ZP, X3, oct, sub, bid); break;
        default: pool_run<16>(ZP, X3, oct, sub, bid); break;
        }
    }
}

#define XB_TMO      128
#define XB_XCNT(j)  (256  + 64 * (j))
#define XB_XSUB(j)  (1280 + 64 * (j))
#define XB_XGEN(j)  (2304 + 64 * (j))
#define XB_TOP      3328
#define XB_TOPGEN   3392
#define XCD_BAR_WORDS 3456
#define XB_SPIN_CAP (1u << 18)
__device__ __forceinline__ unsigned xb_ld(unsigned* p)              { return __hip_atomic_load(p, __ATOMIC_RELAXED, __HIP_MEMORY_SCOPE_AGENT); }
__device__ __forceinline__ unsigned xb_add(unsigned* p, unsigned v) { return __hip_atomic_fetch_add(p, v, __ATOMIC_RELAXED, __HIP_MEMORY_SCOPE_AGENT); }
__device__ __forceinline__ unsigned xb_xcc_id() { return (unsigned)__builtin_amdgcn_s_getreg((3 << 11) | 20) & 0xFu; }
#define XB_SPIN(cond, bar) do { unsigned _sp = 0; while (cond) { __builtin_amdgcn_s_sleep(1); \
    if ((++_sp & 255u) == 0u) { if (xb_ld(&(bar)[XB_TMO])) break; if (_sp > XB_SPIN_CAP) { atomicAdd(&(bar)[XB_TMO], 1u); break; } } } } while (0)
struct XcdBarrier { unsigned* bar; unsigned x; volatile LAS unsigned* st; };
__device__ __forceinline__ XcdBarrier xcd_barrier_post(unsigned* bar, volatile LAS unsigned* st) {
    XcdBarrier b; b.bar = bar; b.x = xb_xcc_id(); b.st = st;
    if (threadIdx.x == 0) (void)xb_add(&bar[XB_XCNT(b.x)], 1u);
    return b;
}
__device__ __forceinline__ void xcd_barrier_complete(unsigned* bar, unsigned x, unsigned& nloc, unsigned& nx) {
    const unsigned G = gridDim.x * gridDim.y * gridDim.z;
    unsigned sum, cnt, mine, sp = 0u;
    for (;;) {
        sum = 0u; cnt = 0u; mine = 0u;
#pragma unroll
        for (unsigned j = 0; j < 16; ++j) { const unsigned c = xb_ld(&bar[XB_XCNT(j)]); sum += c; cnt += (c > 0u) ? 1u : 0u; mine = (j == x) ? c : mine; }
        if (sum == G) break;
        __builtin_amdgcn_s_sleep(1);
        if ((++sp & 255u) == 0u) { if (xb_ld(&bar[XB_TMO])) break; if (sp > XB_SPIN_CAP) { atomicAdd(&bar[XB_TMO], 1u); break; } }
    }
    nloc = mine > 0u ? mine : 1u; nx = cnt > 0u ? cnt : 1u;
}
__device__ __forceinline__ void xcd_barrier(const XcdBarrier& b) {
    asm volatile("s_waitcnt vmcnt(0)" ::: "memory");
    __syncthreads();
    if (threadIdx.x == 0) {
        unsigned* bar = b.bar;
        __builtin_amdgcn_s_waitcnt(0);
        unsigned nloc = b.st[0], nx = b.st[1];
        if (nloc == 0u) { xcd_barrier_complete(bar, b.x, nloc, nx); b.st[0] = nloc; b.st[1] = nx; }
        const unsigned old = xb_add(&bar[XB_XSUB(b.x)], 1u);
        const unsigned gen = old / nloc;
        if (old + 1u == (gen + 1u) * nloc) {
            __builtin_amdgcn_fence(__ATOMIC_RELEASE, "agent");
            asm volatile("s_waitcnt vmcnt(0)" ::: "memory");
            const unsigned og = xb_add(&bar[XB_TOP], 1u);
            const unsigned tg = og / nx;
            if (og + 1u == (tg + 1u) * nx) xb_add(&bar[XB_TOPGEN], 1u);
            else XB_SPIN(xb_ld(&bar[XB_TOPGEN]) == tg, bar);
            __builtin_amdgcn_fence(__ATOMIC_ACQUIRE, "agent");
            xb_add(&bar[XB_XGEN(b.x)], 1u);
            asm volatile("s_waitcnt vmcnt(0)" ::: "memory");
        } else {
            XB_SPIN(xb_ld(&bar[XB_XGEN(b.x)]) == gen, bar);
            __builtin_amdgcn_fence(__ATOMIC_ACQUIRE, "agent");
            asm volatile("s_waitcnt vmcnt(0)" ::: "memory");
        }
    }
    __syncthreads();
}

__device__ __forceinline__ void run_phase(const Params& P, int ph, LAS unsigned char* lds, const float rmul = 1.0f, const bool row_only = false) {
    GAS unsigned char* wsg = P.ws; GAS float* outg = P.out; int tid = threadIdx.x, bid = blockIdx.x;
    asm volatile("" : "+s"(wsg), "+s"(outg), "+v"(tid), "+s"(bid));
    unsigned char* ws = (unsigned char*)wsg; float* out = (float*)outg;
    unsigned char* big = ws + WS_BIG;
    bf16_t* HN = (bf16_t*)(ws + WS_HN); bf16_t* F = (bf16_t*)(ws + WS_F); bf16_t* F2 = (bf16_t*)(ws + WS_F2);
    const int G = gridDim.x, c = bid;
    constexpr unsigned PM = PHASE_MASK;
    if (ph == 0) {
        if (!(PM & (1u << 13))) return;
        prep_weights(P, ws, 0, lds, tid, bid);
        row_phase<true>(PIN(0), out, nullptr, 0.f, nullptr, PIN(2), HN, true, tid, bid);
        return;
    }
    const int l = (ph - 1) / 13, sub = (ph - 1) % 13;
    pg8::Order S;
    switch (sub) {
    case 0: case 8: if (PM & 1u) {
        pg8::Gemm g{HN, (const bf16_t*)(ws + (sub == 0 ? WS_WGU1 : WS_WGU2)), MTOK, NGU, DM}; S.init(MTOK, NGU, G, c, 1);
        pg8::EpiGLU E{(bf16_t*)(big + BIG_ACT)};
        pg8::gemm_phase(lds, g, S, E, tid);
        if (sub == 8) {
            pg8::Gemm g2{(const bf16_t*)(big + BIG_PB), (const bf16_t*)(ws + WS_WPP), MTOK, DM, PLE}; S.init(MTOK, DM, G, c, 1);
            pg8::EpiStore E2{(bf16_t*)(big + BIG_E)};
            pg8::gemm_phase(lds, g2, S, E2, tid);
        }
    } break;
    case 1: case 9: if (PM & 2u) {
        pg8::Gemm g{(const bf16_t*)(big + BIG_ACT), (const bf16_t*)(ws + (sub == 1 ? WS_WD1 : WS_WD2)), MTOK, DM, DFF}; S.init(MTOK, DM, G, c, 1);
        pg8::EpiStore E{F};
        pg8::gemm_phase(lds, g, S, E, tid);
    } break;
    case 2: if (PM & 4u) row_phase2<false>(l == 0 ? PIN(0) : (const float*)out, out, F, 0.5f, PIN(6) + l * DM, nullptr, 0.f, nullptr, PIN(7) + l * DM, HN, true, tid, bid); break;
    case 3: if (PM & 8u) {
        pg8::Gemm g{HN, (const bf16_t*)(ws + WS_WIN), MTOK, NIN, DM}; S.init(MTOK, NIN, G, c, 1);
        pg8::EpiIn E{(bf16_t*)(big + BIG_ZP), (bf16_t*)(big + BIG_U), (bf16_t*)(big + BIG_V), (bf16_t*)(big + BIG_XG), (bf16_t*)(big + BIG_GATES)};
        pg8::gemm_phase(lds, g, S, E, tid);
    } break;
    case 4: if (PM & 16u) mixer_phase(P, ws, l, lds, tid, bid); break;
    case 5: if (PM & 32u) {
        pg8::Gemm g{(const bf16_t*)(big + BIG_X3), (const bf16_t*)(ws + WS_WBR), MTOK, DM, 512}; S.init(MTOK, DM, G, c, 3);
        pg8::EpiBranch E{(const unsigned char*)(big + BIG_GATES), (bf16_t*)(big + BIG_MERGED)};
        pg8::gemm_phase(lds, g, S, E, tid);
    } break;
    case 6: if (PM & 64u) {
        pg8::Gemm g{(const bf16_t*)(big + BIG_MERGED), (const bf16_t*)(ws + WS_WOUT), MTOK, DM, DM}; S.init(MTOK, DM, G, c, 1);
        pg8::EpiStore E{F2};
        pg8::gemm_phase(lds, g, S, E, tid);
    } break;
    case 7: if (PM & 128u) {
        row_phase2<true>(l == 0 ? PIN(0) : (const float*)out, out, F, 0.5f, PIN(6) + l * DM, F2, 1.0f, PIN(23) + l * DM, PIN(24) + l * DM, HN, true, tid, bid);
        if (!row_only) convert_p(PIN(1) + (size_t)l * MTOK * PLE, (bf16_t*)(big + BIG_PB), tid, bid);
        } break;
    case 10: if (PM & 1024u) row_phase2<false>(out, out, F, 0.5f, PIN(28) + l * DM, nullptr, 0.f, nullptr, PIN(30) + l * DM, HN, true, tid, bid); break;
    case 11: if (PM & 2048u) {
        pg8::Gemm g{HN, (const bf16_t*)(ws + WS_WPG), MTOK, DM, DM}; S.init(MTOK, DM, G, c, 1);
        pg8::EpiPle E{(const bf16_t*)(big + BIG_E), F2};
        pg8::gemm_phase(lds, g, S, E, tid);
    } break;
    case 12: if (PM & 4096u) {
        row_phase2<true>(out, out, F, 0.5f, PIN(28) + l * DM, F2, 1.0f, PIN(32) + l * DM, PIN(2) + (l + 1 < NLAYER ? l + 1 : l) * DM, HN, l + 1 < NLAYER, tid, bid);
        if (l + 1 < NLAYER && !row_only) prep_weights(P, ws, l + 1, lds, tid, bid);
        } break;
    default: break;
    }
}

__global__ void __launch_bounds__(512, 2) mega(Params P) {
    extern __shared__ __attribute__((aligned(16))) unsigned char lds_raw[];
    LAS unsigned char* lds = (LAS unsigned char*)lds_raw;
    cg::grid_group grid = cg::this_grid();
#if !MULTI_LAUNCH
    volatile LAS unsigned* st = (volatile LAS unsigned*)(lds + LDS_BYTES - 16);
    if (threadIdx.x < 2) st[threadIdx.x] = 0u;
    __syncthreads();
    const XcdBarrier bar = xcd_barrier_post((unsigned*)((unsigned char*)P.ws + WS_BAR), st);
#endif
    for (int ph = P.ph_lo; ph < P.ph_hi; ++ph) {
        run_phase(P, ph, lds);
#if PROBE_DUP
        {
            const int sub = ph == 0 ? -1 : (ph - 1) % 13;
            const bool is_gemm = (sub == 0 || sub == 1 || sub == 3 || sub == 5 || sub == 6 || sub == 8 || sub == 9 || sub == 11);
            if (((PROBE_DUP & 1) && is_gemm) || ((PROBE_DUP & 2) && sub == 4)) { __syncthreads(); run_phase(P, ph, lds); }
#if !MULTI_LAUNCH
            if ((PROBE_DUP & 4) && ph > 0) xcd_barrier(bar);
#endif
        }
#endif
#if !MULTI_LAUNCH
        if (ph + 1 < P.ph_hi) { if (ph == 0) grid.sync(); else xcd_barrier(bar); }
#endif
    }
}

extern "C" void kernel_launch(void* const* d_in, const int* in_sizes, int n_in, void* d_out, int out_size, void* d_ws, size_t ws_size, hipStream_t stream) {
    static int grid = 0;
    if (grid == 0) {
        if (n_in != 33 || ws_size < WS_END) { fprintf(stderr, "kernel_launch: unexpected n_in %d or ws_size %zu (< %zu)\n", n_in, ws_size, (size_t)WS_END); grid = -1; return; }
        int dev = 0, cus = 0, per_cu = 0;
        hipGetDevice(&dev);
        hipDeviceGetAttribute(&cus, hipDeviceAttributeMultiprocessorCount, dev);
        if (hipFuncSetAttribute((const void*)mega, hipFuncAttributeMaxDynamicSharedMemorySize, LDS_BYTES) != hipSuccess) { fprintf(stderr, "kernel_launch: hipFuncSetAttribute failed\n"); grid = -1; return; }
        hipOccupancyMaxActiveBlocksPerMultiprocessor(&per_cu, (const void*)mega, 512, LDS_BYTES);
        if (per_cu < 1) per_cu = 1;
        (void)hipGetLastError();
        grid = cus * per_cu;
    }
    if (grid < 0) return;
    Params p{};
    for (int i = 0; i < 33; ++i) p.in[i] = (const GAS float*)d_in[i];
    p.out = (GAS float*)d_out; p.ws = (GAS unsigned char*)d_ws;
#if MULTI_LAUNCH
    for (int ph = 0; ph < NPHASE; ++ph) {
        p.ph_lo = ph; p.ph_hi = ph + 1;
        hipLaunchKernelGGL(mega, dim3(grid), dim3(512), LDS_BYTES, stream, p);
    }
#else
    p.ph_lo = 0; p.ph_hi = NPHASE;
    if (hipMemsetAsync((char*)d_ws + WS_BAR, 0, 16384, stream) != hipSuccess) { fprintf(stderr, "kernel_launch: memset of the barrier words failed\n"); return; }
    void* args[] = {&p};
    hipError_t e = hipLaunchCooperativeKernel((const void*)mega, dim3(grid), dim3(512), args, LDS_BYTES, stream);
    if (e != hipSuccess) fprintf(stderr, "cooperative launch failed: %s (grid %d)\n", hipGetErrorString(e), grid);
#endif
}
```

```cpp
#include <hip/hip_runtime.h>
#include <hip/hip_cooperative_groups.h>
#include <cstdio>
namespace cg = cooperative_groups;

#ifndef PHASE_MASK
#define PHASE_MASK 0xffffu
#endif
#ifndef PROBE_DUP
#define PROBE_DUP 0
#endif
#ifndef MULTI_LAUNCH
#define MULTI_LAUNCH 0
#endif

#define LAS __attribute__((address_space(3)))
typedef unsigned short bf16_t;
typedef short bf16x8 __attribute__((ext_vector_type(8)));
typedef float f32x4 __attribute__((ext_vector_type(4)));
typedef float f32x2 __attribute__((ext_vector_type(2)));
typedef unsigned u32x4 __attribute__((ext_vector_type(4)));
typedef unsigned u32x2 __attribute__((ext_vector_type(2)));

constexpr int MTOK = 32768, DM = 1024, DFF = 2816, SEQ = 4096, NLAYER = 4, PLE = 256;
constexpr int NGU = 2 * DFF;
constexpr int NIN = 5632;
constexpr float EPS = 1e-6f;
constexpr int LDS_BYTES = 147456;
constexpr int NPHASE = 1 + 13 * NLAYER;

constexpr size_t WS_WGU1 = 0;
constexpr size_t WS_WD1 = WS_WGU1 + (size_t)NGU * DM * 2;
constexpr size_t WS_WGU2 = WS_WD1 + (size_t)DM * DFF * 2;
constexpr size_t WS_WD2 = WS_WGU2 + (size_t)NGU * DM * 2;
constexpr size_t WS_WIN = WS_WD2 + (size_t)DM * DFF * 2;
constexpr size_t WS_WBR = WS_WIN + (size_t)NIN * DM * 2;
constexpr size_t WS_WOUT = WS_WBR + (size_t)3 * DM * 512 * 2;
constexpr size_t WS_WPG = WS_WOUT + (size_t)DM * DM * 2;
constexpr size_t WS_WPP = WS_WPG + (size_t)DM * DM * 2;
constexpr size_t WS_WSPK = WS_WPP + (size_t)DM * PLE * 2;
constexpr size_t WS_HN = WS_WSPK + (size_t)4 * 128 * 128 * 2;
constexpr size_t WS_F = WS_HN + (size_t)MTOK * DM * 2;
constexpr size_t WS_BIG = WS_F + (size_t)MTOK * DM * 2;
constexpr size_t BIG_ACT = 0;
constexpr size_t BIG_ZP = 0, BIG_U = (size_t)MTOK * 512 * 2, BIG_V = 2 * BIG_U, BIG_XG = 3 * BIG_U;
constexpr size_t BIG_GATES = 4 * BIG_U;
constexpr size_t BIG_X3 = BIG_GATES + (size_t)MTOK * 3072 * 2;
constexpr size_t BIG_MERGED = 0;
constexpr size_t BIG_E = (size_t)192 * 1024 * 1024;
constexpr size_t BIG_PB = BIG_X3;
constexpr size_t WS_BAR = WS_BIG + BIG_X3 + (size_t)3 * MTOK * 512 * 2;
constexpr size_t WS_F2 = WS_BAR + 16384;
constexpr size_t WS_END = WS_F2 + (size_t)MTOK * DM * 2;

#define GAS __attribute__((address_space(1)))
struct Params { const GAS float* in[33]; GAS float* out; GAS unsigned char* ws; int ph_lo, ph_hi; };
#define PIN(i) ((const float*)P.in[i])

typedef __bf16 bf16x2_t __attribute__((ext_vector_type(2)));
__device__ __forceinline__ unsigned cvt_pk_bf16(float lo, float hi) { const f32x2 v = {lo, hi}; return __builtin_bit_cast(unsigned, __builtin_convertvector(v, bf16x2_t)); }
__device__ __forceinline__ float bf_lo(unsigned w) { return __uint_as_float(w << 16); }
__device__ __forceinline__ float bf_hi(unsigned w) { return __uint_as_float(w & 0xffff0000u); }
__device__ __forceinline__ float sigmoid_f(float x) { return __builtin_amdgcn_rcpf(1.0f + __builtin_amdgcn_exp2f(-1.44269504f * x)); }
template <int CTRL> __device__ __forceinline__ float dpp_add(float v) { return v + __builtin_bit_cast(float, __builtin_amdgcn_update_dpp(0, __builtin_bit_cast(int, v), CTRL, 0xf, 0xf, false)); }
__device__ __forceinline__ float wave_sum(float v) {
    v = dpp_add<0xB1>(v);
    v = dpp_add<0x4E>(v);
    v = dpp_add<0x141>(v);
    v = dpp_add<0x140>(v);
    const int iv = __builtin_bit_cast(int, v);
    return (__builtin_bit_cast(float, __builtin_amdgcn_readlane(iv, 0)) + __builtin_bit_cast(float, __builtin_amdgcn_readlane(iv, 16)))
         + (__builtin_bit_cast(float, __builtin_amdgcn_readlane(iv, 32)) + __builtin_bit_cast(float, __builtin_amdgcn_readlane(iv, 48)));
}
__device__ __forceinline__ f32x2 gelu_pk(f32x2 v) {
    const f32x2 av = __builtin_elementwise_abs(v), d = av * 0.2316418882f + 1.0f;
    f32x2 t; t.x = __builtin_amdgcn_rcpf(d.x); t.y = __builtin_amdgcn_rcpf(d.y);
    f32x2 q = t * 0.5307027145f + (-0.7265760135f); q = q * t + 0.7107068705f; q = q * t + (-0.142248368f); q = q * t + 0.127414796f; q = q * t;
    const f32x2 s = (v * v) * (-0.72134752044f);
    f32x2 e; e.x = __builtin_amdgcn_exp2f(s.x); e.y = __builtin_amdgcn_exp2f(s.y);
    const f32x2 m = v * (q * e), r = v - m;
    f32x2 o; o.x = v.x < 0.f ? m.x : r.x; o.y = v.y < 0.f ? m.y : r.y; return o;
}
__device__ __forceinline__ f32x4 gelu4(f32x4 v) { f32x2 a = gelu_pk((f32x2){v[0], v[1]}), b = gelu_pk((f32x2){v[2], v[3]}); return (f32x4){a.x, a.y, b.x, b.y}; }
__device__ __forceinline__ f32x4 sigmoid4(f32x4 v) { return (f32x4){sigmoid_f(v[0]), sigmoid_f(v[1]), sigmoid_f(v[2]), sigmoid_f(v[3])}; }
__device__ __forceinline__ u32x4 pack8(f32x4 a, f32x4 b) { u32x4 w; w.x = cvt_pk_bf16(a[0], a[1]); w.y = cvt_pk_bf16(a[2], a[3]); w.z = cvt_pk_bf16(b[0], b[1]); w.w = cvt_pk_bf16(b[2], b[3]); return w; }
__device__ __forceinline__ f32x4 unpack_lo4(u32x4 w) { return (f32x4){bf_lo(w.x), bf_hi(w.x), bf_lo(w.y), bf_hi(w.y)}; }
__device__ __forceinline__ f32x4 unpack_hi4(u32x4 w) { return (f32x4){bf_lo(w.z), bf_hi(w.z), bf_lo(w.w), bf_hi(w.w)}; }

namespace pg8 {
constexpr int BM = 256, BK = 64, HALF = 128, HTB = HALF * BK * 2, STAGE_BYTES = 8 * HTB, NXCD = 8, WGM = 8;
__device__ __forceinline__ int lds_byte(int r, int c) { const int st = (r >> 4) * 2 + (c >> 5), rr = r & 15, cc = c & 31, ob = rr * 64 + cc * 2; return st * 1024 + (ob ^ (((ob >> 9) & 1) << 5)); }
__device__ __forceinline__ void stage_rc(int b, int& R, int& C) { const int st = b / 1024, sb = b % 1024, swz = sb ^ (((sb >> 9) & 1) << 5); R = (st >> 1) * 16 + swz / 64; C = (st & 1) * 32 + (swz % 64) / 2; }
__device__ __forceinline__ int perm32(int rho) { const int n = rho >> 4, i = rho & 15; return 8 * (i >> 2) + 4 * n + (i & 3); }

struct Unit { int pm, pn; };
struct Gemm { const bf16_t* A; const bf16_t* Bt; int M, N, K; };

struct Order {
    int nM, nN, nwg, G, c, zn;
    __device__ void init(int M, int N, int G_, int c_, int zn_) { nM = M / BM; nN = N / BM; nwg = nM * nN; G = G_; c = c_; zn = zn_; }
    __device__ bool next(int i, Unit& u) const {
        const int ti = i / zn, z = i - ti * zn;
        const long L = (long)ti * G + c; if (L >= nwg) return false;
        int wgid = (int)L; { const int q = nwg / NXCD, r = nwg % NXCD, xcd = wgid % NXCD, off = wgid / NXCD; wgid = (xcd < r ? xcd * (q + 1) : r * (q + 1) + (xcd - r) * q) + off; }
        const int nig = WGM * nN, gid = wgid / nig, fm = gid * WGM, gsz = (nM - fm) < WGM ? (nM - fm) : WGM;
        u.pm = z * nM + fm + ((wgid % nig) % gsz); u.pn = z * nN + (wgid % nig) / gsz; return true;
    }
};

template <class Epi>
__device__ __forceinline__ void gemm_phase(LAS unsigned char* lds, const Gemm g, const Order& S, const Epi& E, const int tid) {
    const int wid = __builtin_amdgcn_readfirstlane(tid >> 6), lane = tid & 63, wr = wid >> 2, wc = wid & 3, fr = lane & 15, fq = lane >> 4;
    const int K = g.K, nt = K / BK;
    unsigned voffA[2], voffB[2];
#pragma unroll
    for (int i = 0; i < 2; ++i) { int R, C; stage_rc(tid * 16 + i * 8192, R, C); const int Rb = (R & ~31) + perm32(R & 31);
        voffA[i] = (unsigned)(R * K + C) * 2u; voffB[i] = (unsigned)(Rb * K + C) * 2u; }
    const size_t kstep = (size_t)(BK * 2);
    const size_t hstep = (size_t)HALF * K * 2;
    const size_t tstep = 2 * hstep;
    const unsigned ldsw = (unsigned)wid * 1024u;
    const int aoff = lds_byte(wr * 64 + fr, fq * 8), boff = lds_byte(wc * 32 + fr, fq * 8);
#define PG8_SA(b, h) (((b) * 2 + (h)) * HTB)
#define PG8_SB(b, h) ((4 + (b) * 2 + (h)) * HTB)
#define PG8_STAGE(bufoff, gbase, voff) do { _Pragma("unroll") for (int _i = 0; _i < 2; ++_i) \
        __builtin_amdgcn_global_load_lds((const unsigned*)((const char*)(gbase) + (voff)[_i]), (LAS unsigned*)(lds + (bufoff) + ldsw + _i * 8192), 16, 0, 0); } while (0)
#define PG8_LDA(dst, b, h) do { _Pragma("unroll") for (int m = 0; m < 4; ++m) _Pragma("unroll") for (int k = 0; k < 2; ++k) dst[m][k] = *(const LAS bf16x8*)(lds + PG8_SA(b, h) + aoff + m * 2048 + k * 1024); } while (0)
#define PG8_LDB(dst, b, h) do { _Pragma("unroll") for (int n = 0; n < 2; ++n) _Pragma("unroll") for (int k = 0; k < 2; ++k) dst[n][k] = *(const LAS bf16x8*)(lds + PG8_SB(b, h) + boff + n * 2048 + k * 1024); } while (0)
#define PG8_MMA(ai, bj, At, Bt) do { __builtin_amdgcn_s_setprio(1); _Pragma("unroll") for (int m = 0; m < 4; ++m) _Pragma("unroll") for (int n = 0; n < 2; ++n) _Pragma("unroll") for (int k = 0; k < 2; ++k) \
        acc[ai][bj][m][n] = __builtin_amdgcn_mfma_f32_16x16x32_bf16(Bt[n][k], At[m][k], acc[ai][bj][m][n], 0, 0, 0); __builtin_amdgcn_s_setprio(0); } while (0)
#define PG8_WAIT_V(n) asm volatile("s_waitcnt vmcnt(" #n ")" ::: "memory")
#define PG8_WAIT_L(n) asm volatile("s_waitcnt lgkmcnt(" #n ")" ::: "memory")
#define PG8_BAR __builtin_amdgcn_s_barrier()
#define PG8_SCHED __builtin_amdgcn_sched_barrier(0)
    Unit cur, nxt; int ui = 0;
    if (!S.next(0, cur)) return;
    f32x4 acc[2][2][4][2];
#pragma unroll
    for (int a = 0; a < 2; ++a)
#pragma unroll
        for (int b = 0; b < 2; ++b)
#pragma unroll
            for (int m = 0; m < 4; ++m)
#pragma unroll
                for (int n = 0; n < 2; ++n) acc[a][b][m][n] = (f32x4){0.f, 0.f, 0.f, 0.f};
    bf16x8 At[4][2], B0[2][2], B1[2][2];
    const char* cA = (const char*)g.A + (size_t)cur.pm * tstep; const char* cB = (const char*)g.Bt + (size_t)cur.pn * tstep;
    PG8_STAGE(PG8_SB(0, 0), cB, voffB); PG8_STAGE(PG8_SA(0, 0), cA, voffA); PG8_STAGE(PG8_SB(0, 1), cB + hstep, voffB); PG8_STAGE(PG8_SA(0, 1), cA + hstep, voffA);
    if (wr == 1) PG8_BAR;
    PG8_WAIT_V(4); PG8_BAR;
    PG8_STAGE(PG8_SB(1, 0), cB + kstep, voffB); PG8_STAGE(PG8_SA(1, 0), cA + kstep, voffA); PG8_STAGE(PG8_SB(1, 1), cB + hstep + kstep, voffB);
    PG8_WAIT_V(6); PG8_BAR;
    for (;;) {
        const bool has_next = S.next(ui + 1, nxt);
        const char* nA = has_next ? (const char*)g.A + (size_t)nxt.pm * tstep : cA; const char* nB = has_next ? (const char*)g.Bt + (size_t)nxt.pn * tstep : cB;
        for (int t = 0; t < nt; t += 2) {
            const bool last = (t == nt - 2);
            const char* a1 = cA + (size_t)(t + 1) * kstep;
            const char* a2 = last ? nA : cA + (size_t)(t + 2) * kstep; const char* b2 = last ? nB : cB + (size_t)(t + 2) * kstep;
            const char* a3 = a2 + kstep; const char* b3 = b2 + kstep;
            PG8_LDB(B0, 0, 0); PG8_SCHED; PG8_LDA(At, 0, 0); PG8_STAGE(PG8_SA(1, 1), a1 + hstep, voffA);
            PG8_WAIT_L(8); PG8_BAR; PG8_WAIT_L(0); PG8_MMA(0, 0, At, B0); PG8_BAR; PG8_SCHED;
            PG8_LDB(B1, 0, 1); PG8_STAGE(PG8_SB(0, 0), b2, voffB);
            PG8_BAR; PG8_WAIT_L(0); PG8_MMA(0, 1, At, B1); PG8_BAR;
            PG8_LDA(At, 0, 1); PG8_STAGE(PG8_SA(0, 0), a2, voffA);
            PG8_BAR; PG8_WAIT_L(0); PG8_MMA(1, 0, At, B0); PG8_BAR; PG8_SCHED;
            PG8_STAGE(PG8_SB(0, 1), b2 + hstep, voffB);
            PG8_WAIT_V(6); PG8_BAR; PG8_MMA(1, 1, At, B1); PG8_BAR;
            PG8_LDB(B0, 1, 0); PG8_SCHED; PG8_LDA(At, 1, 0); PG8_STAGE(PG8_SA(0, 1), a2 + hstep, voffA);
            PG8_WAIT_L(8); PG8_BAR; PG8_WAIT_L(0); PG8_MMA(0, 0, At, B0); PG8_BAR; PG8_SCHED;
            PG8_LDB(B1, 1, 1); PG8_STAGE(PG8_SB(1, 0), b3, voffB);
            PG8_BAR; PG8_WAIT_L(0); PG8_MMA(0, 1, At, B1); PG8_BAR;
            PG8_LDA(At, 1, 1); PG8_STAGE(PG8_SA(1, 0), a3, voffA);
            PG8_BAR; PG8_WAIT_L(0); PG8_MMA(1, 0, At, B0); PG8_BAR; PG8_SCHED;
            PG8_STAGE(PG8_SB(1, 1), b3 + hstep, voffB);
            PG8_WAIT_V(6); PG8_BAR; PG8_MMA(1, 1, At, B1); PG8_BAR;
        }
        bool zero_acc = true;
        if constexpr (Epi::CHAIN) zero_acc = E.chain(acc, cur, wr, wc, fr, fq);
        else E(acc, cur, wr, wc, fr, fq);
        if (!has_next) break;
        if (zero_acc)
#pragma unroll
        for (int a = 0; a < 2; ++a)
#pragma unroll
            for (int b = 0; b < 2; ++b)
#pragma unroll
                for (int m = 0; m < 4; ++m)
#pragma unroll
                    for (int n = 0; n < 2; ++n) acc[a][b][m][n] = (f32x4){0.f, 0.f, 0.f, 0.f};
        cur = nxt; cA = nA; cB = nB; ++ui;
    }
    PG8_WAIT_V(0);
    if (wr == 0) PG8_BAR;
    PG8_BAR;
#undef PG8_SA
#undef PG8_SB
#undef PG8_STAGE
#undef PG8_LDA
#undef PG8_LDB
#undef PG8_MMA
#undef PG8_WAIT_V
#undef PG8_WAIT_L
#undef PG8_BAR
#undef PG8_SCHED
}

typedef f32x4 Acc[2][2][4][2];
template <int ACT, int LDC> __device__ __forceinline__ void glu_store(const Acc& acc, char* ub, unsigned lane_off) {
#pragma unroll
    for (int ai = 0; ai < 2; ++ai)
#pragma unroll
        for (int m = 0; m < 4; ++m) {
            char* rp = ub + (size_t)(ai * HALF + m * 16) * LDC * 2;
            f32x4 v[2];
#pragma unroll
            for (int n = 0; n < 2; ++n) { const f32x4 a = acc[ai][0][m][n], b = acc[ai][1][m][n];
                if (ACT == 0) v[n] = a * sigmoid4(a) * b; else v[n] = a * sigmoid4(b); }
            *(u32x4*)(rp + lane_off) = pack8(v[0], v[1]);
        }
}
template <int LDC> __device__ __forceinline__ unsigned lane_off_of(int wr, int wc, int fr, int fq) { return (unsigned)((wr * 64 + fr) * LDC + wc * 32 + 8 * fq) * 2u; }
struct EpiGLU {
    static constexpr bool CHAIN = false;
    bf16_t* O;
    __device__ __forceinline__ void operator()(const Acc& acc, const Unit& u, int wr, int wc, int fr, int fq) const {
        glu_store<0, DFF>(acc, (char*)O + ((size_t)u.pm * BM * DFF + (size_t)u.pn * 128) * 2, lane_off_of<DFF>(wr, wc, fr, fq));
    }
};
template <int ACT, int LDC> __device__ __forceinline__ void plain_store(const Acc& acc, char* ub, unsigned lane_off) {
#pragma unroll
    for (int ai = 0; ai < 2; ++ai)
#pragma unroll
        for (int m = 0; m < 4; ++m) {
            char* rp = ub + (size_t)(ai * HALF + m * 16) * LDC * 2;
#pragma unroll
            for (int bj = 0; bj < 2; ++bj) { f32x4 v0 = acc[ai][bj][m][0], v1 = acc[ai][bj][m][1];
                if (ACT == 1) { v0 = gelu4(v0); v1 = gelu4(v1); }
                if (ACT == 2) { v0 = sigmoid4(v0); v1 = sigmoid4(v1); }
                *(u32x4*)(rp + bj * HALF * 2 + lane_off) = pack8(v0, v1); }
        }
}
struct EpiStore {
    static constexpr bool CHAIN = false;
    bf16_t* O;
    __device__ __forceinline__ void operator()(const Acc& acc, const Unit& u, int wr, int wc, int fr, int fq) const {
        plain_store<0, DM>(acc, (char*)O + ((size_t)u.pm * BM * DM + (size_t)u.pn * BM) * 2, lane_off_of<DM>(wr, wc, fr, fq));
    }
};
struct EpiIn {
    static constexpr bool CHAIN = false;
    bf16_t *ZP, *U, *V, *XG, *GATES;
    __device__ __forceinline__ void operator()(const Acc& acc, const Unit& u, int wr, int wc, int fr, int fq) const {
        const int pn = u.pn; const size_t rb = (size_t)u.pm * BM;
        if (pn >= 10) {
            char* ub = (char*)GATES + rb * 3072 + (size_t)(pn - 10) * 256; const unsigned lo = (unsigned)((wr * 64 + fr) * 3072 + wc * 32 + 8 * fq);
#pragma unroll
            for (int ai = 0; ai < 2; ++ai)
#pragma unroll
                for (int m = 0; m < 4; ++m)
#pragma unroll
                    for (int bj = 0; bj < 2; ++bj) {
                        const f32x4 v0 = sigmoid4(acc[ai][bj][m][0]) * 255.0f, v1 = sigmoid4(acc[ai][bj][m][1]) * 255.0f;
                        u32x2 w; w.x = 0u; w.y = 0u;
                        w.x = __builtin_amdgcn_cvt_pk_u8_f32(v0[0], 0, w.x); w.x = __builtin_amdgcn_cvt_pk_u8_f32(v0[1], 1, w.x); w.x = __builtin_amdgcn_cvt_pk_u8_f32(v0[2], 2, w.x); w.x = __builtin_amdgcn_cvt_pk_u8_f32(v0[3], 3, w.x);
                        w.y = __builtin_amdgcn_cvt_pk_u8_f32(v1[0], 0, w.y); w.y = __builtin_amdgcn_cvt_pk_u8_f32(v1[1], 1, w.y); w.y = __builtin_amdgcn_cvt_pk_u8_f32(v1[2], 2, w.y); w.y = __builtin_amdgcn_cvt_pk_u8_f32(v1[3], 3, w.y);
                        *(u32x2*)(ub + (size_t)(ai * HALF + m * 16) * 3072 + bj * HALF + lo) = w;
                    }
        }
        else {
            const unsigned lo = lane_off_of<512>(wr, wc, fr, fq);
            if (pn >= 6) glu_store<1, 512>(acc, (char*)XG + (rb * 512 + (size_t)(pn - 6) * 128) * 2, lo);
            else if (pn < 2) plain_store<0, 512>(acc, (char*)ZP + (rb * 512 + (size_t)pn * 256) * 2, lo);
            else { char* ub = (char*)(pn < 4 ? U : V) + (rb * 512 + (size_t)(pn & 1) * 256) * 2; plain_store<1, 512>(acc, ub, lo); }
        }
    }
};
struct EpiBranch {
    static constexpr bool CHAIN = true;
    const unsigned char* GATES; bf16_t* MG;
    static __device__ __forceinline__ f32x4 code4(unsigned w) { return (f32x4){__builtin_fmaxf((float)(w & 255u), 0.25f), __builtin_fmaxf((float)((w >> 8) & 255u), 0.25f), __builtin_fmaxf((float)((w >> 16) & 255u), 0.25f), __builtin_fmaxf((float)(w >> 24), 0.25f)}; }
    static __device__ __forceinline__ f32x4 rcp4(f32x4 v) { return (f32x4){__builtin_amdgcn_rcpf(v[0]), __builtin_amdgcn_rcpf(v[1]), __builtin_amdgcn_rcpf(v[2]), __builtin_amdgcn_rcpf(v[3])}; }
    __device__ __forceinline__ bool chain(Acc& acc, const Unit& u, int wr, int wc, int fr, int fq) const {
        const int z = u.pn >> 2, pn = u.pn & 3, pm = u.pm - z * 128;
        const bool fin = (z == 2);
        const char* gb = (const char*)GATES + (size_t)pm * BM * 3072 + (size_t)z * 1024 + (size_t)pn * BM;
        const char* gn = fin ? gb : gb + 1024;
        const unsigned glo = (unsigned)((wr * 64 + fr) * 3072 + wc * 32 + 8 * fq);
        char* mb = (char*)MG + ((size_t)pm * BM * DM + (size_t)pn * BM) * 2;
        const unsigned mlo = lane_off_of<DM>(wr, wc, fr, fq);
        constexpr float q = 1.0f / 255.0f;
        u32x2 g0[2][4][2], g1[2][4][2];
#pragma unroll
        for (int ai = 0; ai < 2; ++ai)
#pragma unroll
            for (int m = 0; m < 4; ++m)
#pragma unroll
                for (int bj = 0; bj < 2; ++bj) {
                    g0[ai][m][bj] = *(const u32x2*)(gb + (size_t)(ai * HALF + m * 16) * 3072 + bj * HALF + glo);
                    g1[ai][m][bj] = *(const u32x2*)(gn + (size_t)(ai * HALF + m * 16) * 3072 + bj * HALF + glo);
                }
#pragma unroll
        for (int ai = 0; ai < 2; ++ai)
#pragma unroll
            for (int m = 0; m < 4; ++m)
#pragma unroll
                for (int bj = 0; bj < 2; ++bj) {
                    const f32x4 d0 = rcp4(code4(g1[ai][m][bj].x)), d1 = rcp4(code4(g1[ai][m][bj].y));
                    acc[ai][bj][m][0] *= code4(g0[ai][m][bj].x) * (fin ? (f32x4){q, q, q, q} : d0);
                    acc[ai][bj][m][1] *= code4(g0[ai][m][bj].y) * (fin ? (f32x4){q, q, q, q} : d1);
                    if (fin) *(u32x4*)(mb + (size_t)(ai * HALF + m * 16) * DM * 2 + bj * HALF * 2 + mlo) = pack8(acc[ai][bj][m][0], acc[ai][bj][m][1]);
                }
        return fin;
    }
};
struct EpiPle {
    static constexpr bool CHAIN = false;
    const bf16_t* E; bf16_t* O;
    __device__ __forceinline__ void operator()(const Acc& acc, const Unit& u, int wr, int wc, int fr, int fq) const {
        const size_t uo = ((size_t)u.pm * BM * DM + (size_t)u.pn * BM) * 2;
        const char* eb = (const char*)E + uo; char* ob = (char*)O + uo;
        const unsigned lo = lane_off_of<DM>(wr, wc, fr, fq);
        u32x4 ew[2][4][2];
#pragma unroll
        for (int ai = 0; ai < 2; ++ai)
#pragma unroll
            for (int m = 0; m < 4; ++m)
#pragma unroll
                for (int bj = 0; bj < 2; ++bj) ew[ai][m][bj] = *(const u32x4*)(eb + (size_t)(ai * HALF + m * 16) * DM * 2 + bj * HALF * 2 + lo);
#pragma unroll
        for (int ai = 0; ai < 2; ++ai)
#pragma unroll
            for (int m = 0; m < 4; ++m)
#pragma unroll
                for (int bj = 0; bj < 2; ++bj) {
                    const f32x4 v0 = sigmoid4(acc[ai][bj][m][0]) * unpack_lo4(ew[ai][m][bj]), v1 = sigmoid4(acc[ai][bj][m][1]) * unpack_hi4(ew[ai][m][bj]);
                    *(u32x4*)(ob + (size_t)(ai * HALF + m * 16) * DM * 2 + bj * HALF * 2 + lo) = pack8(v0, v1);
                }
    }
};
}

template <bool INIT>
__device__ __forceinline__ void row_phase(const float* hin, float* h, const bf16_t* F, float cscale, const float* ga, const float* gb, bf16_t* HN, bool write_hn, const int tid, const int bid) {
    const int wid = tid >> 6, lane = tid & 63;
    constexpr int R = 4;
    f32x4 gav[4], gbv[4];
#pragma unroll
    for (int k = 0; k < 4; ++k) {
        gav[k] = INIT ? (f32x4){0.f, 0.f, 0.f, 0.f} : *(const f32x4*)(ga + 256 * k + 4 * lane);
        gbv[k] = write_hn ? *(const f32x4*)(gb + 256 * k + 4 * lane) : (f32x4){0.f, 0.f, 0.f, 0.f};
    }
    for (int row0 = (bid * 8 + wid) * R; row0 < MTOK; row0 += gridDim.x * 8 * R) {
        f32x4 hv[R][4]; u32x2 fw[R][4];
#pragma unroll
        for (int r = 0; r < R; ++r) { const size_t ro = (size_t)(row0 + r) * DM + 4 * lane;
#pragma unroll
            for (int k = 0; k < 4; ++k) {
                hv[r][k] = *(const f32x4*)(hin + ro + 256 * k);
                if (!INIT) fw[r][k] = *(const u32x2*)(F + ro + 256 * k);
            } }
#pragma unroll
        for (int r = 0; r < R; ++r) { const size_t ro = (size_t)(row0 + r) * DM + 4 * lane;
            if (!INIT) {
                f32x4 fv[4];
#pragma unroll
                for (int k = 0; k < 4; ++k) fv[k] = (f32x4){bf_lo(fw[r][k].x), bf_hi(fw[r][k].x), bf_lo(fw[r][k].y), bf_hi(fw[r][k].y)};
                float ss = 0.f;
#pragma unroll
                for (int i = 0; i < 4; ++i) ss += fv[i][0] * fv[i][0] + fv[i][1] * fv[i][1] + fv[i][2] * fv[i][2] + fv[i][3] * fv[i][3];
                ss = wave_sum(ss);
                const float rs = cscale * __builtin_amdgcn_rsqf(ss * (1.0f / DM) + EPS);
#pragma unroll
                for (int i = 0; i < 4; ++i) hv[r][i] += fv[i] * gav[i] * rs;
            }
            float s2 = 0.f;
#pragma unroll
            for (int i = 0; i < 4; ++i) s2 += hv[r][i][0] * hv[r][i][0] + hv[r][i][1] * hv[r][i][1] + hv[r][i][2] * hv[r][i][2] + hv[r][i][3] * hv[r][i][3];
            s2 = wave_sum(s2);
            const float rs2 = __builtin_amdgcn_rsqf(s2 * (1.0f / DM) + EPS);
            if (!INIT) { _Pragma("unroll") for (int k = 0; k < 4; ++k) *(f32x4*)(h + ro + 256 * k) = hv[r][k]; }
            if (write_hn) {
#pragma unroll
                for (int k = 0; k < 4; ++k) { const f32x4 o = hv[r][k] * gbv[k] * rs2; u32x2 w; w.x = cvt_pk_bf16(o[0], o[1]); w.y = cvt_pk_bf16(o[2], o[3]); *(u32x2*)(HN + ro + 256 * k) = w; }
            }
        }
    }
}

__device__ __forceinline__ f32x4 bf4(u32x2 w) { return (f32x4){bf_lo(w.x), bf_hi(w.x), bf_lo(w.y), bf_hi(w.y)}; }
__device__ __forceinline__ float sumsq16(const f32x4 (&v)[4]) { float s = 0.f;
#pragma unroll
    for (int i = 0; i < 4; ++i) s += v[i][0] * v[i][0] + v[i][1] * v[i][1] + v[i][2] * v[i][2] + v[i][3] * v[i][3];
    return s; }
template <bool FULL>
__device__ __forceinline__ void row_phase2(const float* hin, float* h, const bf16_t* F1, float c1, const float* ga1, const bf16_t* F2, float c2, const float* ga2, const float* gb, bf16_t* HN, bool write_hn, const int tid, const int bid) {
    const int wid = tid >> 6, lane = tid & 63;
    constexpr int R = 2;
    f32x4 g1v[4], g2v[4], gbv[4];
#pragma unroll
    for (int k = 0; k < 4; ++k) {
        g1v[k] = *(const f32x4*)(ga1 + 256 * k + 4 * lane);
        g2v[k] = FULL ? *(const f32x4*)(ga2 + 256 * k + 4 * lane) : (f32x4){0.f, 0.f, 0.f, 0.f};
        gbv[k] = write_hn ? *(const f32x4*)(gb + 256 * k + 4 * lane) : (f32x4){0.f, 0.f, 0.f, 0.f};
    }
    f32x4 hv[R][4], hn_[R][4]; u32x2 fa[R][4], fan[R][4], fb[R][4], fbn[R][4];
#define ROW_LOAD(HV, FA, FB, ROW0) do { _Pragma("unroll") for (int r = 0; r < R; ++r) { const size_t ro_ = (size_t)((ROW0) + r) * DM + 4 * lane; \
        _Pragma("unroll") for (int k = 0; k < 4; ++k) { HV[r][k] = *(const f32x4*)(hin + ro_ + 256 * k); FA[r][k] = *(const u32x2*)(F1 + ro_ + 256 * k); if (FULL) FB[r][k] = *(const u32x2*)(F2 + ro_ + 256 * k); } } } while (0)
    const int stride = (int)gridDim.x * 8 * R;
    int row0 = (bid * 8 + wid) * R;
    if (row0 < MTOK) ROW_LOAD(hv, fa, fb, row0);
    for (; row0 < MTOK; row0 += stride) {
        const bool more = row0 + stride < MTOK;
        if (more) ROW_LOAD(hn_, fan, fbn, row0 + stride);
#pragma unroll
        for (int r = 0; r < R; ++r) { const size_t ro = (size_t)(row0 + r) * DM + 4 * lane;
            {
                f32x4 fv[4];
#pragma unroll
                for (int k = 0; k < 4; ++k) fv[k] = bf4(fa[r][k]);
                const float rs = c1 * __builtin_amdgcn_rsqf(wave_sum(sumsq16(fv)) * (1.0f / DM) + EPS);
#pragma unroll
                for (int i = 0; i < 4; ++i) hv[r][i] += fv[i] * g1v[i] * rs;
            }
            if (FULL) {
                f32x4 fv[4];
#pragma unroll
                for (int k = 0; k < 4; ++k) fv[k] = bf4(fb[r][k]);
                const float rs = c2 * __builtin_amdgcn_rsqf(wave_sum(sumsq16(fv)) * (1.0f / DM) + EPS);
#pragma unroll
                for (int i = 0; i < 4; ++i) hv[r][i] += fv[i] * g2v[i] * rs;
#pragma unroll
                for (int k = 0; k < 4; ++k) *(f32x4*)(h + ro + 256 * k) = hv[r][k];
            }
            if (write_hn) {
                const float rs2 = __builtin_amdgcn_rsqf(wave_sum(sumsq16(hv[r])) * (1.0f / DM) + EPS);
#pragma unroll
                for (int k = 0; k < 4; ++k) { const f32x4 o = hv[r][k] * gbv[k] * rs2; u32x2 w; w.x = cvt_pk_bf16(o[0], o[1]); w.y = cvt_pk_bf16(o[2], o[3]); *(u32x2*)(HN + ro + 256 * k) = w; }
            }
        }
        if (more) {
#pragma unroll
            for (int r = 0; r < R; ++r)
#pragma unroll
                for (int k = 0; k < 4; ++k) { hv[r][k] = hn_[r][k]; fa[r][k] = fan[r][k]; if (FULL) fb[r][k] = fbn[r][k]; }
        }
    }
#undef ROW_LOAD
}

struct PrepJob { const float* src; bf16_t* dst; int ld, col0, k0, K, n0; };
__device__ __forceinline__ PrepJob prep_job(const Params& P, unsigned char* ws, int l, int tix) {
    constexpr int T_GU = (NGU / 64) * (DM / 64), T_D = (DM / 64) * (DFF / 64), T_IN = (NIN / 64) * (DM / 64), T_BR = (DM / 64) * (512 / 64), T_SQ = (DM / 64) * (DM / 64);
    int t = tix; const float* srcA; const float* srcB; int ld, mode, K; bf16_t* dst;
    if (t < T_GU) { srcA = PIN(3) + (size_t)l * DM * DFF; srcB = PIN(4) + (size_t)l * DM * DFF; ld = DFF; mode = 1; K = DM; dst = (bf16_t*)(ws + WS_WGU1); }
    else if ((t -= T_GU) < T_GU) { srcA = PIN(25) + (size_t)l * DM * DFF; srcB = PIN(26) + (size_t)l * DM * DFF; ld = DFF; mode = 1; K = DM; dst = (bf16_t*)(ws + WS_WGU2); }
    else if ((t -= T_GU) < T_D) { srcA = PIN(5) + (size_t)l * DFF * DM; srcB = srcA; ld = DM; mode = 0; K = DFF; dst = (bf16_t*)(ws + WS_WD1); }
    else if ((t -= T_D) < T_D) { srcA = PIN(27) + (size_t)l * DFF * DM; srcB = srcA; ld = DM; mode = 0; K = DFF; dst = (bf16_t*)(ws + WS_WD2); }
    else if ((t -= T_D) < T_IN) { srcA = PIN(8) + (size_t)l * DM * NIN; srcB = srcA; ld = NIN; mode = 2; K = DM; dst = (bf16_t*)(ws + WS_WIN); }
    else if ((t -= T_IN) < T_BR) { srcA = PIN(16) + (size_t)l * 512 * DM; srcB = srcA; ld = DM; mode = 0; K = 512; dst = (bf16_t*)(ws + WS_WBR) + (size_t)1 * DM * 512; }
    else if ((t -= T_BR) < T_BR) { srcA = PIN(21) + (size_t)l * 512 * DM; srcB = srcA; ld = DM; mode = 0; K = 512; dst = (bf16_t*)(ws + WS_WBR) + (size_t)2 * DM * 512; }
    else if ((t -= T_BR) < T_SQ) { srcA = PIN(22) + (size_t)l * DM * DM; srcB = srcA; ld = DM; mode = 0; K = DM; dst = (bf16_t*)(ws + WS_WOUT); }
    else if ((t -= T_SQ) < T_SQ) { srcA = PIN(31) + (size_t)l * DM * DM; srcB = srcA; ld = DM; mode = 0; K = DM; dst = (bf16_t*)(ws + WS_WPG); }
    else { t -= T_SQ; srcA = PIN(29) + (size_t)l * PLE * DM; srcB = srcA; ld = DM; mode = 0; K = PLE; dst = (bf16_t*)(ws + WS_WPP); }
    const int tk = K / 64, tn = t / tk, tkk = t - tn * tk, n0 = tn * 64, k0 = tkk * 64;
    const float* src = srcA; int col0 = n0;
    if (mode == 1) { const int tt = n0 >> 8, j = n0 & 255; if (j < 128) { col0 = 128 * tt + j; } else { src = srcB; col0 = 128 * tt + j - 128; } }
    else if (mode == 2) { if (n0 >= 1536 && n0 < 2560) { const int tt = (n0 - 1536) >> 8, j = (n0 - 1536) & 255; col0 = (j < 128) ? (1536 + 128 * tt + j) : (2048 + 128 * tt + j - 128); } }
    PrepJob J; J.src = src; J.dst = dst; J.ld = ld; J.col0 = col0; J.k0 = k0; J.K = K; J.n0 = n0; return J;
}

__device__ __forceinline__ void prep_weights(const Params& P, unsigned char* ws, int l, LAS unsigned char* lds, const int tid, const int bid) {
    LAS float* tile = (LAS float*)lds;
    constexpr int T_GU = (NGU / 64) * (DM / 64), T_D = (DM / 64) * (DFF / 64), T_IN = (NIN / 64) * (DM / 64), T_BR = (DM / 64) * (512 / 64), T_SQ = (DM / 64) * (DM / 64), T_PP = (DM / 64) * (PLE / 64);
    constexpr int TOTAL = 2 * T_GU + 2 * T_D + T_IN + 2 * T_BR + 2 * T_SQ + T_PP;
    {
        const int kk = tid >> 4, c4 = tid & 15, n = tid >> 3, k8 = tid & 7;
        f32x4 v0, v1; int tix = bid;
        if (tix < TOTAL) { const PrepJob J = prep_job(P, ws, l, tix); const float* sp = J.src + (size_t)(J.k0 + kk) * J.ld + J.col0 + 4 * c4; v0 = *(const f32x4*)sp; v1 = *(const f32x4*)(sp + (size_t)32 * J.ld); }
        for (; tix < TOTAL; tix += gridDim.x) {
            const PrepJob J = prep_job(P, ws, l, tix);
#pragma unroll
            for (int e = 0; e < 4; ++e) { tile[kk * 65 + 4 * c4 + e] = v0[e]; tile[(kk + 32) * 65 + 4 * c4 + e] = v1[e]; }
            __syncthreads();
            const int nx = tix + gridDim.x;
            if (nx < TOTAL) { const PrepJob Jn = prep_job(P, ws, l, nx); const float* sp = Jn.src + (size_t)(Jn.k0 + kk) * Jn.ld + Jn.col0 + 4 * c4; v0 = *(const f32x4*)sp; v1 = *(const f32x4*)(sp + (size_t)32 * Jn.ld); }
            float v[8];
#pragma unroll
            for (int i = 0; i < 8; ++i) v[i] = tile[(8 * k8 + i) * 65 + n];
            u32x4 w; w.x = cvt_pk_bf16(v[0], v[1]); w.y = cvt_pk_bf16(v[2], v[3]); w.z = cvt_pk_bf16(v[4], v[5]); w.w = cvt_pk_bf16(v[6], v[7]);
            *(u32x4*)(J.dst + (size_t)(J.n0 + n) * J.K + J.k0 + 8 * k8) = w;
            __syncthreads();
        }
    }
    {
        const float* pw = PIN(9) + (size_t)l * 4 * 128 * 128; const float* sc = PIN(10) + (size_t)l * 512; const float* wpo = PIN(11) + (size_t)l * 512 * DM;
        bf16_t* dst = (bf16_t*)(ws + WS_WBR);
        const int ol = tid & 63, i4 = __builtin_amdgcn_readfirstlane(tid >> 6);
        for (int tix = bid; tix < 16 * 16; tix += gridDim.x) {
            const int o = (tix >> 4) * 64 + ol, g = (tix >> 2) & 3, i0 = (tix & 3) * 32 + i4 * 4;
            float a[4] = {0.f, 0.f, 0.f, 0.f};
#pragma unroll 4
            for (int j = 0; j < 128; j += 4) {
                const f32x4 s4 = *(const f32x4*)(sc + g * 128 + j);
                float w[4];
#pragma unroll
                for (int jj = 0; jj < 4; ++jj) w[jj] = wpo[(size_t)(g * 128 + j + jj) * DM + o] * s4[jj];
#pragma unroll
                for (int ii = 0; ii < 4; ++ii) { const f32x4 p4 = *(const f32x4*)(pw + (size_t)(g * 128 + i0 + ii) * 128 + j);
                    a[ii] += p4[0] * w[0] + p4[1] * w[1] + p4[2] * w[2] + p4[3] * w[3]; }
            }
            u32x2 w2; w2.x = cvt_pk_bf16(a[0], a[1]); w2.y = cvt_pk_bf16(a[2], a[3]);
            *(u32x2*)(dst + (size_t)o * 512 + g * 128 + i0) = w2;
        }
    }
    {
        const float* wsrc = PIN(14) + (size_t)l * 4 * 128 * 128; bf16_t* dst = (bf16_t*)(ws + WS_WSPK);
        for (int idx = bid * 512 + tid; idx < 4 * 128 * 128 / 8; idx += gridDim.x * 512) {
            const int fq = idx & 3, kk = (idx >> 2) & 3, t = (idx >> 4) & 127, h = idx >> 11;
            float v[8];
#pragma unroll
            for (int i = 0; i < 8; ++i) { const int sp = 32 * kk + 4 * i + fq; v[i] = (sp <= t) ? wsrc[(size_t)(h * 128 + t) * 128 + sp] : 0.f; }
            u32x4 w4; w4.x = cvt_pk_bf16(v[0], v[1]); w4.y = cvt_pk_bf16(v[2], v[3]); w4.z = cvt_pk_bf16(v[4], v[5]); w4.w = cvt_pk_bf16(v[6], v[7]);
            *(u32x4*)(dst + (size_t)idx * 8) = w4;
        }
    }
}

__device__ __forceinline__ void convert_p(const float* p, bf16_t* PB, const int tid, const int bid) {
    for (size_t idx = (size_t)bid * 512 + tid; idx < (size_t)MTOK * PLE / 8; idx += (size_t)gridDim.x * 512) {
        const f32x4 a = *(const f32x4*)(p + idx * 8), b = *(const f32x4*)(p + idx * 8 + 4);
        *(u32x4*)(PB + idx * 8) = pack8(a, b);
    }
}

template <int W>
__device__ __forceinline__ void pool_run(const bf16_t* ZP, bf16_t* XP, const int oct, const int sub, const int bid) {
    for (int it = bid; it < MTOK / 32; it += gridDim.x) {
        const int tok0 = it * 32 + 4 * sub, t0 = tok0 & (SEQ - 1);
        const bf16_t* zp = ZP + (size_t)tok0 * 512 + 8 * oct;
        u32x4 row[W + 3];
#pragma unroll
        for (int j = 0; j < W + 3; ++j) { row[j] = (u32x4){0u, 0u, 0u, 0u}; if (t0 + 3 - j >= 0) row[j] = *(const u32x4*)(zp + (ptrdiff_t)(3 - j) * 512); }
        f32x4 s0 = (f32x4){0.f, 0.f, 0.f, 0.f}, s1 = s0;
#pragma unroll
        for (int j = 0; j < W; ++j) { s0 += unpack_lo4(row[j]); s1 += unpack_hi4(row[j]); }
        f32x4 o0[4], o1[4]; o0[3] = s0; o1[3] = s1;
#pragma unroll
        for (int d = 0; d < 3; ++d) { s0 += unpack_lo4(row[W + d]) - unpack_lo4(row[d]); s1 += unpack_hi4(row[W + d]) - unpack_hi4(row[d]); o0[2 - d] = s0; o1[2 - d] = s1; }
#pragma unroll
        for (int u = 0; u < 4; ++u) { const int t = t0 + u; const float inv = 1.0f / (float)((t + 1) < W ? (t + 1) : W);
            *(u32x4*)(XP + (size_t)(tok0 + u) * 512 + 8 * oct) = pack8(o0[u] * inv - unpack_lo4(row[3 - u]), o1[u] * inv - unpack_hi4(row[3 - u])); }
    }
}

__device__ __forceinline__ void mixer_phase(const Params& P, unsigned char* ws, int l, LAS unsigned char* lds, const int tid, const int bid) {
    unsigned char* big = ws + WS_BIG;
    const bf16_t* ZP = (const bf16_t*)(big + BIG_ZP); const bf16_t* U = (const bf16_t*)(big + BIG_U); const bf16_t* V = (const bf16_t*)(big + BIG_V); const bf16_t* XG = (const bf16_t*)(big + BIG_XG);
    bf16_t* X3 = (bf16_t*)(big + BIG_X3);
    const int wid = __builtin_amdgcn_readfirstlane(tid >> 6), lane = tid & 63;

    {
        const float* lng = PIN(12) + (size_t)l * 512; const float* lnb = PIN(13) + (size_t)l * 512; const float* bsp = PIN(15) + (size_t)l * 4 * 128;
        const bf16_t* WSPK = (const bf16_t*)(ws + WS_WSPK);
        bf16_t* XS = X3 + (size_t)1 * MTOK * 512;
        const int fr = lane & 15, fq = lane >> 4, h = wid >> 1, th = wid & 1;
        constexpr int VP = 528;
        for (int ch = bid; ch < MTOK / 128; ch += gridDim.x) {
            const size_t tok0 = (size_t)ch * 128;
            {
                const f32x4 g0 = *(const f32x4*)(lng + 8 * lane), g1 = *(const f32x4*)(lng + 8 * lane + 4), b0 = *(const f32x4*)(lnb + 8 * lane), b1 = *(const f32x4*)(lnb + 8 * lane + 4);
#pragma unroll
                for (int i0 = 0; i0 < 16; i0 += 8) {
                    u32x4 wv[8];
#pragma unroll
                    for (int i = 0; i < 8; ++i) wv[i] = *(const u32x4*)(V + (tok0 + wid * 16 + i0 + i) * 512 + 8 * lane);
#pragma unroll
                    for (int i = 0; i < 8; ++i) {
                        const int sp = wid * 16 + i0 + i;
                        f32x4 x0 = unpack_lo4(wv[i]), x1 = unpack_hi4(wv[i]);
                        float s = (x0[0] + x0[1]) + (x0[2] + x0[3]) + (x1[0] + x1[1]) + (x1[2] + x1[3]);
                        s = wave_sum(s); const float mu = s * (1.0f / 512.0f);
                        x0 -= mu; x1 -= mu;
                        float q = x0[0] * x0[0] + x0[1] * x0[1] + x0[2] * x0[2] + x0[3] * x0[3] + x1[0] * x1[0] + x1[1] * x1[1] + x1[2] * x1[2] + x1[3] * x1[3];
                        q = wave_sum(q); const float rs = __builtin_amdgcn_rsqf(q * (1.0f / 512.0f) + EPS);
                        x0 = x0 * rs * g0 + b0; x1 = x1 * rs * g1 + b1;
                        *(LAS u32x4*)(lds + (size_t)sp * (VP * 2) + 16 * lane) = pack8(x0, x1);
                    }
                }
            }
            __syncthreads();
            {
                bf16x8 Wf[4][4]; float bs[4];
#pragma unroll
                for (int m = 0; m < 4; ++m) { const int t = 64 * th + 16 * m + fr; bs[m] = bsp[h * 128 + t];
#pragma unroll
                    for (int kk = 0; kk < 4; ++kk) Wf[m][kk] = *(const bf16x8*)(WSPK + ((size_t)((h * 128 + t) * 4 + kk) * 4 + fq) * 8); }
                const size_t ubase = (tok0 + 64 * th + fr) * 512 + 128 * h + 4 * fq;
                u32x2 uw[2][4];
#pragma unroll
                for (int m = 0; m < 4; ++m) uw[0][m] = *(const u32x2*)(U + ubase + (size_t)(16 * m) * 512);
#pragma unroll
                for (int n = 0; n < 8; ++n) {
                    if (n + 1 < 8) {
#pragma unroll
                        for (int m = 0; m < 4; ++m) uw[(n + 1) & 1][m] = *(const u32x2*)(U + ubase + (size_t)(16 * m) * 512 + 16 * (n + 1));
                    }
                    f32x4 acc[4];
#pragma unroll
                    for (int m = 0; m < 4; ++m) acc[m] = (f32x4){0.f, 0.f, 0.f, 0.f};
#pragma unroll
                    for (int kk = 0; kk < 4; ++kk) {
                        bf16x8 X;
#pragma unroll
                        for (int i = 0; i < 8; ++i) X[i] = *(const LAS short*)(lds + (size_t)(32 * kk + 4 * i + fq) * (VP * 2) + 2 * (128 * h + 16 * n + fr));
#pragma unroll
                        for (int m = 0; m < 4; ++m) acc[m] = __builtin_amdgcn_mfma_f32_16x16x32_bf16(X, Wf[m][kk], acc[m], 0, 0, 0);
                    }
#pragma unroll
                    for (int m = 0; m < 4; ++m) {
                        const u32x2 u2 = uw[n & 1][m];
                        const f32x4 sv = acc[m] + bs[m];
                        u32x2 o; o.x = cvt_pk_bf16(bf_lo(u2.x) * sv[0], bf_hi(u2.x) * sv[1]); o.y = cvt_pk_bf16(bf_lo(u2.y) * sv[2], bf_hi(u2.y) * sv[3]);
                        *(u32x2*)(XS + ubase + (size_t)(16 * m) * 512 + 16 * n) = o;
                    }
                }
            }
            __syncthreads();
        }
    }

    {
        const float* dwk = PIN(17) + (size_t)l * 31 * 512; const float* dwb = PIN(18) + (size_t)l * 512; const float* lng = PIN(19) + (size_t)l * 512; const float* lnb = PIN(20) + (size_t)l * 512;
        bf16_t* XC = X3 + (size_t)2 * MTOK * 512;
        LAS unsigned char* xs = lds;
        LAS float* ys = (LAS float*)(lds + 65536);
        const int cp = tid & 255, hbq = __builtin_amdgcn_readfirstlane(tid >> 8);
        f32x2 wk[31];
#pragma unroll
        for (int k = 0; k < 31; ++k) wk[k] = *(const f32x2*)(dwk + k * 512 + 2 * cp);
        const f32x2 bias = *(const f32x2*)(dwb + 2 * cp);
        const f32x4 g0 = *(const f32x4*)(lng + 8 * lane), g1 = *(const f32x4*)(lng + 8 * lane + 4), b0 = *(const f32x4*)(lnb + 8 * lane), b1 = *(const f32x4*)(lnb + 8 * lane + 4);
        u32x4 pre[8];
#define CONV_LOAD(ct_) do { const int tok0_ = (ct_) * 32, t0_ = tok0_ & (SEQ - 1); _Pragma("unroll") for (int i = 0; i < 8; ++i) { const int idx = tid + 512 * i; const int r = idx >> 6, c8 = idx & 63; \
            pre[i] = (u32x4){0u, 0u, 0u, 0u}; if (idx < 62 * 64 && t0_ - 30 + r >= 0) pre[i] = *(const u32x4*)(XG + (size_t)(tok0_ - 30 + r) * 512 + 8 * c8); } } while (0)
        int ct = bid;
        if (ct < MTOK / 32) CONV_LOAD(ct);
        for (; ct < MTOK / 32; ct += gridDim.x) {
            const int tok0 = ct * 32;
#pragma unroll
            for (int i = 0; i < 8; ++i) { const int idx = tid + 512 * i; if (idx < 62 * 64) *(LAS u32x4*)(xs + (idx >> 6) * 1024 + 16 * (idx & 63)) = pre[i]; }
            __syncthreads();
            if (ct + (int)gridDim.x < MTOK / 32) CONV_LOAD(ct + gridDim.x);
            {
                f32x2 x[46];
#pragma unroll
                for (int r = 0; r < 46; ++r) { const unsigned w2 = *(const LAS unsigned*)(xs + (16 * hbq + r) * 1024 + 4 * cp); x[r] = (f32x2){bf_lo(w2), bf_hi(w2)}; }
#pragma unroll
                for (int t = 0; t < 16; ++t) { f32x2 y = bias;
#pragma unroll
                    for (int k = 0; k < 31; ++k) y += wk[k] * x[t + k];
                    *(LAS f32x2*)(ys + (16 * hbq + t) * 512 + 2 * cp) = y; }
            }
            __syncthreads();
#pragma unroll
            for (int i = 0; i < 4; ++i) { const int t = wid * 4 + i;
                f32x4 x0 = *(const LAS f32x4*)(ys + t * 512 + 8 * lane), x1 = *(const LAS f32x4*)(ys + t * 512 + 8 * lane + 4);
                float s = (x0[0] + x0[1]) + (x0[2] + x0[3]) + (x1[0] + x1[1]) + (x1[2] + x1[3]);
                s = wave_sum(s); const float mu = s * (1.0f / 512.0f);
                x0 -= mu; x1 -= mu;
                float q = x0[0] * x0[0] + x0[1] * x0[1] + x0[2] * x0[2] + x0[3] * x0[3] + x1[0] * x1[0] + x1[1] * x1[1] + x1[2] * x1[2] + x1[3] * x1[3];
                q = wave_sum(q); const float rs = __builtin_amdgcn_rsqf(q * (1.0f / 512.0f) + EPS);
                x0 = x0 * rs * g0 + b0; x1 = x1 * rs * g1 + b1;
                x0 = x0 * sigmoid4(x0); x1 = x1 * sigmoid4(x1);
                *(u32x4*)(XC + (size_t)(tok0 + t) * 512 + 8 * lane) = pack8(x0, x1); }
            __syncthreads();
        }
#undef CONV_LOAD
    }

    {
        const int g = wid & 3, oct = g * 16 + (lane & 15), sub = (wid >> 2) * 4 + (lane >> 4);
        switch (g) {
        case 0: pool_run<2>(ZP, X3, oct, sub, bid); break;
        case 1: pool_run<4>(ZP, X3, oct, sub, bid); break;
        case 2: pool_run<8>(ZP, X3, oct, sub, bid); break;
        default: pool_run<16>(ZP, X3, oct, sub, bid); break;
        }
    }
}

#define XB_TMO      128
#define XB_XCNT(j)  (256  + 64 * (j))
#define XB_XSUB(j)  (1280 + 64 * (j))
#define XB_XGEN(j)  (2304 + 64 * (j))
#define XB_TOP      3328
#define XB_TOPGEN   3392
#define XCD_BAR_WORDS 3456
#define XB_SPIN_CAP (1u << 18)
__device__ __forceinline__ unsigned xb_ld(unsigned* p)              { return __hip_atomic_load(p, __ATOMIC_RELAXED, __HIP_MEMORY_SCOPE_AGENT); }
__device__ __forceinline__ unsigned xb_add(unsigned* p, unsigned v) { return __hip_atomic_fetch_add(p, v, __ATOMIC_RELAXED, __HIP_MEMORY_SCOPE_AGENT); }
__device__ __forceinline__ unsigned xb_xcc_id() { return (unsigned)__builtin_amdgcn_s_getreg((3 << 11) | 20) & 0xFu; }
#define XB_SPIN(cond, bar) do { unsigned _sp = 0; while (cond) { __builtin_amdgcn_s_sleep(1); \
    if ((++_sp & 255u) == 0u) { if (xb_ld(&(bar)[XB_TMO])) break; if (_sp > XB_SPIN_CAP) { atomicAdd(&(bar)[XB_TMO], 1u); break; } } } } while (0)
struct XcdBarrier { unsigned* bar; unsigned x; volatile LAS unsigned* st; };
__device__ __forceinline__ XcdBarrier xcd_barrier_post(unsigned* bar, volatile LAS unsigned* st) {
    XcdBarrier b; b.bar = bar; b.x = xb_xcc_id(); b.st = st;
    if (threadIdx.x == 0) (void)xb_add(&bar[XB_XCNT(b.x)], 1u);
    return b;
}
__device__ __forceinline__ void xcd_barrier_complete(unsigned* bar, unsigned x, unsigned& nloc, unsigned& nx) {
    const unsigned G = gridDim.x * gridDim.y * gridDim.z;
    unsigned sum, cnt, mine, sp = 0u;
    for (;;) {
        sum = 0u; cnt = 0u; mine = 0u;
#pragma unroll
        for (unsigned j = 0; j < 16; ++j) { const unsigned c = xb_ld(&bar[XB_XCNT(j)]); sum += c; cnt += (c > 0u) ? 1u : 0u; mine = (j == x) ? c : mine; }
        if (sum == G) break;
        __builtin_amdgcn_s_sleep(1);
        if ((++sp & 255u) == 0u) { if (xb_ld(&bar[XB_TMO])) break; if (sp > XB_SPIN_CAP) { atomicAdd(&bar[XB_TMO], 1u); break; } }
    }
    nloc = mine > 0u ? mine : 1u; nx = cnt > 0u ? cnt : 1u;
}
__device__ __forceinline__ void xcd_barrier(const XcdBarrier& b) {
    asm volatile("s_waitcnt vmcnt(0)" ::: "memory");
    __syncthreads();
    if (threadIdx.x == 0) {
        unsigned* bar = b.bar;
        __builtin_amdgcn_s_waitcnt(0);
        unsigned nloc = b.st[0], nx = b.st[1];
        if (nloc == 0u) { xcd_barrier_complete(bar, b.x, nloc, nx); b.st[0] = nloc; b.st[1] = nx; }
        const unsigned old = xb_add(&bar[XB_XSUB(b.x)], 1u);
        const unsigned gen = old / nloc;
        if (old + 1u == (gen + 1u) * nloc) {
            __builtin_amdgcn_fence(__ATOMIC_RELEASE, "agent");
            asm volatile("s_waitcnt vmcnt(0)" ::: "memory");
            const unsigned og = xb_add(&bar[XB_TOP], 1u);
            const unsigned tg = og / nx;
            if (og + 1u == (tg + 1u) * nx) xb_add(&bar[XB_TOPGEN], 1u);
            else XB_SPIN(xb_ld(&bar[XB_TOPGEN]) == tg, bar);
            __builtin_amdgcn_fence(__ATOMIC_ACQUIRE, "agent");
            xb_add(&bar[XB_XGEN(b.x)], 1u);
            asm volatile("s_waitcnt vmcnt(0)" ::: "memory");
        } else {
            XB_SPIN(xb_ld(&bar[XB_XGEN(b.x)]) == gen, bar);
            __builtin_amdgcn_fence(__ATOMIC_ACQUIRE, "agent");
            asm volatile("s_waitcnt vmcnt(0)" ::: "memory");
        }
    }
    __syncthreads();
}

__device__ __forceinline__ void run_phase(const Params& P, int ph, LAS unsigned char* lds, const float rmul = 1.0f, const bool row_only = false) {
    GAS unsigned char* wsg = P.ws; GAS float* outg = P.out; int tid = threadIdx.x, bid = blockIdx.x;
    asm volatile("" : "+s"(wsg), "+s"(outg), "+v"(tid), "+s"(bid));
    unsigned char* ws = (unsigned char*)wsg; float* out = (float*)outg;
    unsigned char* big = ws + WS_BIG;
    bf16_t* HN = (bf16_t*)(ws + WS_HN); bf16_t* F = (bf16_t*)(ws + WS_F); bf16_t* F2 = (bf16_t*)(ws + WS_F2);
    const int G = gridDim.x, c = bid;
    constexpr unsigned PM = PHASE_MASK;
    if (ph == 0) {
        if (!(PM & (1u << 13))) return;
        prep_weights(P, ws, 0, lds, tid, bid);
        row_phase<true>(PIN(0), out, nullptr, 0.f, nullptr, PIN(2), HN, true, tid, bid);
        return;
    }
    const int l = (ph - 1) / 13, sub = (ph - 1) % 13;
    pg8::Order S;
    switch (sub) {
    case 0: case 8: if (PM & 1u) {
        pg8::Gemm g{HN, (const bf16_t*)(ws + (sub == 0 ? WS_WGU1 : WS_WGU2)), MTOK, NGU, DM}; S.init(MTOK, NGU, G, c, 1);
        pg8::EpiGLU E{(bf16_t*)(big + BIG_ACT)};
        pg8::gemm_phase(lds, g, S, E, tid);
        if (sub == 8) {
            pg8::Gemm g2{(const bf16_t*)(big + BIG_PB), (const bf16_t*)(ws + WS_WPP), MTOK, DM, PLE}; S.init(MTOK, DM, G, c, 1);
            pg8::EpiStore E2{(bf16_t*)(big + BIG_E)};
            pg8::gemm_phase(lds, g2, S, E2, tid);
        }
    } break;
    case 1: case 9: if (PM & 2u) {
        pg8::Gemm g{(const bf16_t*)(big + BIG_ACT), (const bf16_t*)(ws + (sub == 1 ? WS_WD1 : WS_WD2)), MTOK, DM, DFF}; S.init(MTOK, DM, G, c, 1);
        pg8::EpiStore E{F};
        pg8::gemm_phase(lds, g, S, E, tid);
    } break;
    case 2: if (PM & 4u) row_phase2<false>(l == 0 ? PIN(0) : (const float*)out, out, F, 0.5f, PIN(6) + l * DM, nullptr, 0.f, nullptr, PIN(7) + l * DM, HN, true, tid, bid); break;
    case 3: if (PM & 8u) {
        pg8::Gemm g{HN, (const bf16_t*)(ws + WS_WIN), MTOK, NIN, DM}; S.init(MTOK, NIN, G, c, 1);
        pg8::EpiIn E{(bf16_t*)(big + BIG_ZP), (bf16_t*)(big + BIG_U), (bf16_t*)(big + BIG_V), (bf16_t*)(big + BIG_XG), (bf16_t*)(big + BIG_GATES)};
        pg8::gemm_phase(lds, g, S, E, tid);
    } break;
    case 4: if (PM & 16u) mixer_phase(P, ws, l, lds, tid, bid); break;
    case 5: if (PM & 32u) {
        pg8::Gemm g{(const bf16_t*)(big + BIG_X3), (const bf16_t*)(ws + WS_WBR), MTOK, DM, 512}; S.init(MTOK, DM, G, c, 3);
        pg8::EpiBranch E{(const unsigned char*)(big + BIG_GATES), (bf16_t*)(big + BIG_MERGED)};
        pg8::gemm_phase(lds, g, S, E, tid);
    } break;
    case 6: if (PM & 64u) {
        pg8::Gemm g{(const bf16_t*)(big + BIG_MERGED), (const bf16_t*)(ws + WS_WOUT), MTOK, DM, DM}; S.init(MTOK, DM, G, c, 1);
        pg8::EpiStore E{F2};
        pg8::gemm_phase(lds, g, S, E, tid);
    } break;
    case 7: if (PM & 128u) {
        row_phase2<true>(l == 0 ? PIN(0) : (const float*)out, out, F, 0.5f, PIN(6) + l * DM, F2, 1.0f, PIN(23) + l * DM, PIN(24) + l * DM, HN, true, tid, bid);
        if (!row_only) convert_p(PIN(1) + (size_t)l * MTOK * PLE, (bf16_t*)(big + BIG_PB), tid, bid);
        } break;
    case 10: if (PM & 1024u) row_phase2<false>(out, out, F, 0.5f, PIN(28) + l * DM, nullptr, 0.f, nullptr, PIN(30) + l * DM, HN, true, tid, bid); break;
    case 11: if (PM & 2048u) {
        pg8::Gemm g{HN, (const bf16_t*)(ws + WS_WPG), MTOK, DM, DM}; S.init(MTOK, DM, G, c, 1);
        pg8::EpiPle E{(const bf16_t*)(big + BIG_E), F2};
        pg8::gemm_phase(lds, g, S, E, tid);
    } break;
    case 12: if (PM & 4096u) {
        row_phase2<true>(out, out, F, 0.5f, PIN(28) + l * DM, F2, 1.0f, PIN(32) + l * DM, PIN(2) + (l + 1 < NLAYER ? l + 1 : l) * DM, HN, l + 1 < NLAYER, tid, bid);
        if (l + 1 < NLAYER && !row_only) prep_weights(P, ws, l + 1, lds, tid, bid);
        } break;
    default: break;
    }
}

__global__ void __launch_bounds__(512, 2) mega(Params P) {
    extern __shared__ __attribute__((aligned(16))) unsigned char lds_raw[];
    LAS unsigned char* lds = (LAS unsigned char*)lds_raw;
    cg::grid_group grid = cg::this_grid();
#if !MULTI_LAUNCH
    volatile LAS unsigned* st = (volatile LAS unsigned*)(lds + LDS_BYTES - 16);
    if (threadIdx.x < 2) st[threadIdx.x] = 0u;
    __syncthreads();
    const XcdBarrier bar = xcd_barrier_post((unsigned*)((unsigned char*)P.ws + WS_BAR), st);
#endif
    for (int ph = P.ph_lo; ph < P.ph_hi; ++ph) {
        run_phase(P, ph, lds);
#if PROBE_DUP
        {
            const int sub = ph == 0 ? -1 : (ph - 1) % 13;
            const bool is_gemm = (sub == 0 || sub == 1 || sub == 3 || sub == 5 || sub == 6 || sub == 8 || sub == 9 || sub == 11);
            if (((PROBE_DUP & 1) && is_gemm) || ((PROBE_DUP & 2) && sub == 4)) { __syncthreads(); run_phase(P, ph, lds); }
#if !MULTI_LAUNCH
            if ((PROBE_DUP & 4) && ph > 0) xcd_barrier(bar);
#endif
        }
#endif
#if !MULTI_LAUNCH
        if (ph + 1 < P.ph_hi) { if (ph == 0) grid.sync(); else xcd_barrier(bar); }
#endif
    }
}

extern "C" void kernel_launch(void* const* d_in, const int* in_sizes, int n_in, void* d_out, int out_size, void* d_ws, size_t ws_size, hipStream_t stream) {
    static int grid = 0;
    if (grid == 0) {
        if (n_in != 33 || ws_size < WS_END) { fprintf(stderr, "kernel_launch: unexpected n_in %d or ws_size %zu (< %zu)\n", n_in, ws_size, (size_t)WS_END); grid = -1; return; }
        int dev = 0, cus = 0, per_cu = 0;
        hipGetDevice(&dev);
        hipDeviceGetAttribute(&cus, hipDeviceAttributeMultiprocessorCount, dev);
        if (hipFuncSetAttribute((const void*)mega, hipFuncAttributeMaxDynamicSharedMemorySize, LDS_BYTES) != hipSuccess) { fprintf(stderr, "kernel_launch: hipFuncSetAttribute failed\n"); grid = -1; return; }
        hipOccupancyMaxActiveBlocksPerMultiprocessor(&per_cu, (const void*)mega, 512, LDS_BYTES);
        if (per_cu < 1) per_cu = 1;
        (void)hipGetLastError();
        grid = cus * per_cu;
    }
    if (grid < 0) return;
    Params p{};
    for (int i = 0; i < 33; ++i) p.in[i] = (const GAS float*)d_in[i];
    p.out = (GAS float*)d_out; p.ws = (GAS unsigned char*)d_ws;
#if MULTI_LAUNCH
    for (int ph = 0; ph < NPHASE; ++ph) {
        p.ph_lo = ph; p.ph_hi = ph + 1;
        hipLaunchKernelGGL(mega, dim3(grid), dim3(512), LDS_BYTES, stream, p);
    }
#else
    p.ph_lo = 0; p.ph_hi = NPHASE;
    if (hipMemsetAsync((char*)d_ws + WS_BAR, 0, 16384, stream) != hipSuccess) { fprintf(stderr, "kernel_launch: memset of the barrier words failed\n"); return; }
    void* args[] = {&p};
    hipError_t e = hipLaunchCooperativeKernel((const void*)mega, dim3(grid), dim3(512), args, LDS_BYTES, stream);
    if (e != hipSuccess) fprintf(stderr, "cooperative launch failed: %s (grid %d)\n", hipGetErrorString(e), grid);
#endif
}
```

```cpp
#include <hip/hip_runtime.h>
#include <hip/hip_cooperative_groups.h>
#include <cstdio>
namespace cg = cooperative_groups;

#ifndef PHASE_MASK
#define PHASE_MASK 0xffffu
#endif
#ifndef PROBE_DUP
#define PROBE_DUP 0
#endif
#ifndef MULTI_LAUNCH
#define MULTI_LAUNCH 0
#endif

#define LAS __attribute__((address_space(3)))
typedef unsigned short bf16_t;
typedef short bf16x8 __attribute__((ext_vector_type(8)));
typedef float f32x4 __attribute__((ext_vector_type(4)));
typedef float f32x2 __attribute__((ext_vector_type(2)));
typedef unsigned u32x4 __attribute__((ext_vector_type(4)));
typedef unsigned u32x2 __attribute__((ext_vector_type(2)));

constexpr int MTOK = 32768, DM = 1024, DFF = 2816, SEQ = 4096, NLAYER = 4, PLE = 256;
constexpr int NGU = 2 * DFF;
constexpr int NIN = 5632;
constexpr float EPS = 1e-6f;
constexpr int LDS_BYTES = 147456;
constexpr int NPHASE = 1 + 13 * NLAYER;

constexpr size_t WS_WGU1 = 0;
constexpr size_t WS_WD1 = WS_WGU1 + (size_t)NGU * DM * 2;
constexpr size_t WS_WGU2 = WS_WD1 + (size_t)DM * DFF * 2;
constexpr size_t WS_WD2 = WS_WGU2 + (size_t)NGU * DM * 2;
constexpr size_t WS_WIN = WS_WD2 + (size_t)DM * DFF * 2;
constexpr size_t WS_WBR = WS_WIN + (size_t)NIN * DM * 2;
constexpr size_t WS_WOUT = WS_WBR + (size_t)3 * DM * 512 * 2;
constexpr size_t WS_WPG = WS_WOUT + (size_t)DM * DM * 2;
constexpr size_t WS_WPP = WS_WPG + (size_t)DM * DM * 2;
constexpr size_t WS_WSPK = WS_WPP + (size_t)DM * PLE * 2;
constexpr size_t WS_HN = WS_WSPK + (size_t)4 * 128 * 128 * 2;
constexpr size_t WS_F = WS_HN + (size_t)MTOK * DM * 2;
constexpr size_t WS_BIG = WS_F + (size_t)MTOK * DM * 2;
constexpr size_t BIG_ACT = 0;
constexpr size_t BIG_ZP = 0, BIG_U = (size_t)MTOK * 512 * 2, BIG_V = 2 * BIG_U, BIG_XG = 3 * BIG_U;
constexpr size_t BIG_GATES = 4 * BIG_U;
constexpr size_t BIG_X3 = BIG_GATES + (size_t)MTOK * 3072 * 2;
constexpr size_t BIG_MERGED = 0;
constexpr size_t BIG_E = (size_t)192 * 1024 * 1024;
constexpr size_t BIG_PB = BIG_X3;
constexpr size_t WS_BAR = WS_BIG + BIG_X3 + (size_t)3 * MTOK * 512 * 2;
constexpr size_t WS_F2 = WS_BAR + 16384;
constexpr size_t WS_END = WS_F2 + (size_t)MTOK * DM * 2;

#define GAS __attribute__((address_space(1)))
struct Params { const GAS float* in[33]; GAS float* out; GAS unsigned char* ws; int ph_lo, ph_hi; };
#define PIN(i) ((const float*)P.in[i])

typedef __bf16 bf16x2_t __attribute__((ext_vector_type(2)));
__device__ __forceinline__ unsigned cvt_pk_bf16(float lo, float hi) { const f32x2 v = {lo, hi}; return __builtin_bit_cast(unsigned, __builtin_convertvector(v, bf16x2_t)); }
__device__ __forceinline__ float bf_lo(unsigned w) { return __uint_as_float(w << 16); }
__device__ __forceinline__ float bf_hi(unsigned w) { return __uint_as_float(w & 0xffff0000u); }
__device__ __forceinline__ float sigmoid_f(float x) { return __builtin_amdgcn_rcpf(1.0f + __builtin_amdgcn_exp2f(-1.44269504f * x)); }
template <int CTRL> __device__ __forceinline__ float dpp_add(float v) { return v + __builtin_bit_cast(float, __builtin_amdgcn_update_dpp(0, __builtin_bit_cast(int, v), CTRL, 0xf, 0xf, false)); }
__device__ __forceinline__ float wave_sum(float v) {
    v = dpp_add<0xB1>(v);
    v = dpp_add<0x4E>(v);
    v = dpp_add<0x141>(v);
    v = dpp_add<0x140>(v);
    const int iv = __builtin_bit_cast(int, v);
    return (__builtin_bit_cast(float, __builtin_amdgcn_readlane(iv, 0)) + __builtin_bit_cast(float, __builtin_amdgcn_readlane(iv, 16)))
         + (__builtin_bit_cast(float, __builtin_amdgcn_readlane(iv, 32)) + __builtin_bit_cast(float, __builtin_amdgcn_readlane(iv, 48)));
}
__device__ __forceinline__ f32x2 gelu_pk(f32x2 v) {
    const f32x2 av = __builtin_elementwise_abs(v), d = av * 0.2316418882f + 1.0f;
    f32x2 t; t.x = __builtin_amdgcn_rcpf(d.x); t.y = __builtin_amdgcn_rcpf(d.y);
    f32x2 q = t * 0.5307027145f + (-0.7265760135f); q = q * t + 0.7107068705f; q = q * t + (-0.142248368f); q = q * t + 0.127414796f; q = q * t;
    const f32x2 s = (v * v) * (-0.72134752044f);
    f32x2 e; e.x = __builtin_amdgcn_exp2f(s.x); e.y = __builtin_amdgcn_exp2f(s.y);
    const f32x2 m = v * (q * e), r = v - m;
    f32x2 o; o.x = v.x < 0.f ? m.x : r.x; o.y = v.y < 0.f ? m.y : r.y; return o;
}
__device__ __forceinline__ f32x4 gelu4(f32x4 v) { f32x2 a = gelu_pk((f32x2){v[0], v[1]}), b = gelu_pk((f32x2){v[2], v[3]}); return (f32x4){a.x, a.y, b.x, b.y}; }
__device__ __forceinline__ f32x4 sigmoid4(f32x4 v) { return (f32x4){sigmoid_f(v[0]), sigmoid_f(v[1]), sigmoid_f(v[2]), sigmoid_f(v[3])}; }
__device__ __forceinline__ u32x4 pack8(f32x4 a, f32x4 b) { u32x4 w; w.x = cvt_pk_bf16(a[0], a[1]); w.y = cvt_pk_bf16(a[2], a[3]); w.z = cvt_pk_bf16(b[0], b[1]); w.w = cvt_pk_bf16(b[2], b[3]); return w; }
__device__ __forceinline__ f32x4 unpack_lo4(u32x4 w) { return (f32x4){bf_lo(w.x), bf_hi(w.x), bf_lo(w.y), bf_hi(w.y)}; }
__device__ __forceinline__ f32x4 unpack_hi4(u32x4 w) { return (f32x4){bf_lo(w.z), bf_hi(w.z), bf_lo(w.w), bf_hi(w.w)}; }

namespace pg8 {
constexpr int BM = 256, BK = 64, HALF = 128, HTB = HALF * BK * 2, STAGE_BYTES = 8 * HTB, NXCD = 8, WGM = 8;
__device__ __forceinline__ int lds_byte(int r, int c) { const int st = (r >> 4) * 2 + (c >> 5), rr = r & 15, cc = c & 31, ob = rr * 64 + cc * 2; return st * 1024 + (ob ^ (((ob >> 9) & 1) << 5)); }
__device__ __forceinline__ void stage_rc(int b, int& R, int& C) { const int st = b / 1024, sb = b % 1024, swz = sb ^ (((sb >> 9) & 1) << 5); R = (st >> 1) * 16 + swz / 64; C = (st & 1) * 32 + (swz % 64) / 2; }
__device__ __forceinline__ int perm32(int rho) { const int n = rho >> 4, i = rho & 15; return 8 * (i >> 2) + 4 * n + (i & 3); }

struct Unit { int pm, pn; };
struct Gemm { const bf16_t* A; const bf16_t* Bt; int M, N, K; };

struct Order {
    int nM, nN, nwg, G, c, zn;
    __device__ void init(int M, int N, int G_, int c_, int zn_) { nM = M / BM; nN = N / BM; nwg = nM * nN; G = G_; c = c_; zn = zn_; }
    __device__ bool next(int i, Unit& u) const {
        const int ti = i / zn, z = i - ti * zn;
        const long L = (long)ti * G + c; if (L >= nwg) return false;
        int wgid = (int)L; { const int q = nwg / NXCD, r = nwg % NXCD, xcd = wgid % NXCD, off = wgid / NXCD; wgid = (xcd < r ? xcd * (q + 1) : r * (q + 1) + (xcd - r) * q) + off; }
        const int nig = WGM * nN, gid = wgid / nig, fm = gid * WGM, gsz = (nM - fm) < WGM ? (nM - fm) : WGM;
        u.pm = z * nM + fm + ((wgid % nig) % gsz); u.pn = z * nN + (wgid % nig) / gsz; return true;
    }
};

template <class Epi>
__device__ __forceinline__ void gemm_phase(LAS unsigned char* lds, const Gemm g, const Order& S, const Epi& E, const int tid) {
    const int wid = __builtin_amdgcn_readfirstlane(tid >> 6), lane = tid & 63, wr = wid >> 2, wc = wid & 3, fr = lane & 15, fq = lane >> 4;
    const int K = g.K, nt = K / BK;
    unsigned voffA[2], voffB[2];
#pragma unroll
    for (int i = 0; i < 2; ++i) { int R, C; stage_rc(tid * 16 + i * 8192, R, C); const int Rb = (R & ~31) + perm32(R & 31);
        voffA[i] = (unsigned)(R * K + C) * 2u; voffB[i] = (unsigned)(Rb * K + C) * 2u; }
    const size_t kstep = (size_t)(BK * 2);
    const size_t hstep = (size_t)HALF * K * 2;
    const size_t tstep = 2 * hstep;
    const unsigned ldsw = (unsigned)wid * 1024u;
    const int aoff = lds_byte(wr * 64 + fr, fq * 8), boff = lds_byte(wc * 32 + fr, fq * 8);
#define PG8_SA(b, h) (((b) * 2 + (h)) * HTB)
#define PG8_SB(b, h) ((4 + (b) * 2 + (h)) * HTB)
#define PG8_STAGE(bufoff, gbase, voff) do { _Pragma("unroll") for (int _i = 0; _i < 2; ++_i) \
        __builtin_amdgcn_global_load_lds((const unsigned*)((const char*)(gbase) + (voff)[_i]), (LAS unsigned*)(lds + (bufoff) + ldsw + _i * 8192), 16, 0, 0); } while (0)
#define PG8_LDA(dst, b, h) do { _Pragma("unroll") for (int m = 0; m < 4; ++m) _Pragma("unroll") for (int k = 0; k < 2; ++k) dst[m][k] = *(const LAS bf16x8*)(lds + PG8_SA(b, h) + aoff + m * 2048 + k * 1024); } while (0)
#define PG8_LDB(dst, b, h) do { _Pragma("unroll") for (int n = 0; n < 2; ++n) _Pragma("unroll") for (int k = 0; k < 2; ++k) dst[n][k] = *(const LAS bf16x8*)(lds + PG8_SB(b, h) + boff + n * 2048 + k * 1024); } while (0)
#define PG8_MMA(ai, bj, At, Bt) do { __builtin_amdgcn_s_setprio(1); _Pragma("unroll") for (int m = 0; m < 4; ++m) _Pragma("unroll") for (int n = 0; n < 2; ++n) _Pragma("unroll") for (int k = 0; k < 2; ++k) \
        acc[ai][bj][m][n] = __builtin_amdgcn_mfma_f32_16x16x32_bf16(Bt[n][k], At[m][k], acc[ai][bj][m][n], 0, 0, 0); __builtin_amdgcn_s_setprio(0); } while (0)
#define PG8_WAIT_V(n) asm volatile("s_waitcnt vmcnt(" #n ")" ::: "memory")
#define PG8_WAIT_L(n) asm volatile("s_waitcnt lgkmcnt(" #n ")" ::: "memory")
#define PG8_BAR __builtin_amdgcn_s_barrier()
#define PG8_SCHED __builtin_amdgcn_sched_barrier(0)
    Unit cur, nxt; int ui = 0;
    if (!S.next(0, cur)) return;
    f32x4 acc[2][2][4][2];
#pragma unroll
    for (int a = 0; a < 2; ++a)
#pragma unroll
        for (int b = 0; b < 2; ++b)
#pragma unroll
            for (int m = 0; m < 4; ++m)
#pragma unroll
                for (int n = 0; n < 2; ++n) acc[a][b][m][n] = (f32x4){0.f, 0.f, 0.f, 0.f};
    bf16x8 At[4][2], B0[2][2], B1[2][2];
    const char* cA = (const char*)g.A + (size_t)cur.pm * tstep; const char* cB = (const char*)g.Bt + (size_t)cur.pn * tstep;
    PG8_STAGE(PG8_SB(0, 0), cB, voffB); PG8_STAGE(PG8_SA(0, 0), cA, voffA); PG8_STAGE(PG8_SB(0, 1), cB + hstep, voffB); PG8_STAGE(PG8_SA(0, 1), cA + hstep, voffA);
    PG8_STAGE(PG8_SB(1, 0), cB + kstep, voffB); PG8_STAGE(PG8_SA(1, 0), cA + kstep, voffA); PG8_STAGE(PG8_SB(1, 1), cB + hstep + kstep, voffB);
    PG8_WAIT_V(6);
    if (wr == 1) PG8_BAR;
    PG8_BAR;
    for (;;) {
        const bool has_next = S.next(ui + 1, nxt);
        const char* nA = has_next ? (const char*)g.A + (size_t)nxt.pm * tstep : cA; const char* nB = has_next ? (const char*)g.Bt + (size_t)nxt.pn * tstep : cB;
        for (int t = 0; t < nt; t += 2) {
            const bool last = (t == nt - 2);
            const char* a1 = cA + (size_t)(t + 1) * kstep;
            const char* a2 = last ? nA : cA + (size_t)(t + 2) * kstep; const char* b2 = last ? nB : cB + (size_t)(t + 2) * kstep;
            const char* a3 = a2 + kstep; const char* b3 = b2 + kstep;
            PG8_LDB(B0, 0, 0); PG8_SCHED; PG8_LDA(At, 0, 0); PG8_STAGE(PG8_SA(1, 1), a1 + hstep, voffA);
            PG8_WAIT_L(8); PG8_BAR; PG8_WAIT_L(0); PG8_MMA(0, 0, At, B0); PG8_BAR; PG8_SCHED;
            PG8_LDB(B1, 0, 1); PG8_STAGE(PG8_SB(0, 0), b2, voffB);
            PG8_BAR; PG8_WAIT_L(0); PG8_MMA(0, 1, At, B1); PG8_BAR;
            PG8_LDA(At, 0, 1); PG8_STAGE(PG8_SA(0, 0), a2, voffA);
            PG8_BAR; PG8_WAIT_L(0); PG8_MMA(1, 0, At, B0); PG8_BAR; PG8_SCHED;
            PG8_STAGE(PG8_SB(0, 1), b2 + hstep, voffB);
            PG8_WAIT_V(6); PG8_BAR; PG8_MMA(1, 1, At, B1); PG8_BAR;
            PG8_LDB(B0, 1, 0); PG8_SCHED; PG8_LDA(At, 1, 0); PG8_STAGE(PG8_SA(0, 1), a2 + hstep, voffA);
            PG8_WAIT_L(8); PG8_BAR; PG8_WAIT_L(0); PG8_MMA(0, 0, At, B0); PG8_BAR; PG8_SCHED;
            PG8_LDB(B1, 1, 1); PG8_STAGE(PG8_SB(1, 0), b3, voffB);
            PG8_BAR; PG8_WAIT_L(0); PG8_MMA(0, 1, At, B1); PG8_BAR;
            PG8_LDA(At, 1, 1); PG8_STAGE(PG8_SA(1, 0), a3, voffA);
            PG8_BAR; PG8_WAIT_L(0); PG8_MMA(1, 0, At, B0); PG8_BAR; PG8_SCHED;
            PG8_STAGE(PG8_SB(1, 1), b3 + hstep, voffB);
            PG8_WAIT_V(6); PG8_BAR; PG8_MMA(1, 1, At, B1); PG8_BAR;
        }
        bool zero_acc = true;
        if constexpr (Epi::CHAIN) zero_acc = E.chain(acc, cur, wr, wc, fr, fq);
        else E(acc, cur, wr, wc, fr, fq);
        if (!has_next) break;
        if (zero_acc)
#pragma unroll
        for (int a = 0; a < 2; ++a)
#pragma unroll
            for (int b = 0; b < 2; ++b)
#pragma unroll
                for (int m = 0; m < 4; ++m)
#pragma unroll
                    for (int n = 0; n < 2; ++n) acc[a][b][m][n] = (f32x4){0.f, 0.f, 0.f, 0.f};
        cur = nxt; cA = nA; cB = nB; ++ui;
    }
    PG8_WAIT_V(0);
    if (wr == 0) PG8_BAR;
    PG8_BAR;
#undef PG8_SA
#undef PG8_SB
#undef PG8_STAGE
#undef PG8_LDA
#undef PG8_LDB
#undef PG8_MMA
#undef PG8_WAIT_V
#undef PG8_WAIT_L
#undef PG8_BAR
#undef PG8_SCHED
}

typedef f32x4 Acc[2][2][4][2];
template <int ACT, int LDC> __device__ __forceinline__ void glu_store(const Acc& acc, char* ub, unsigned lane_off) {
#pragma unroll
    for (int ai = 0; ai < 2; ++ai)
#pragma unroll
        for (int m = 0; m < 4; ++m) {
            char* rp = ub + (size_t)(ai * HALF + m * 16) * LDC * 2;
            f32x4 v[2];
#pragma unroll
            for (int n = 0; n < 2; ++n) { const f32x4 a = acc[ai][0][m][n], b = acc[ai][1][m][n];
                if (ACT == 0) v[n] = a * sigmoid4(a) * b; else v[n] = a * sigmoid4(b); }
            *(u32x4*)(rp + lane_off) = pack8(v[0], v[1]);
        }
}
template <int LDC> __device__ __forceinline__ unsigned lane_off_of(int wr, int wc, int fr, int fq) { return (unsigned)((wr * 64 + fr) * LDC + wc * 32 + 8 * fq) * 2u; }
struct EpiGLU {
    static constexpr bool CHAIN = false;
    bf16_t* O;
    __device__ __forceinline__ void operator()(const Acc& acc, const Unit& u, int wr, int wc, int fr, int fq) const {
        glu_store<0, DFF>(acc, (char*)O + ((size_t)u.pm * BM * DFF + (size_t)u.pn * 128) * 2, lane_off_of<DFF>(wr, wc, fr, fq));
    }
};
template <int ACT, int LDC> __device__ __forceinline__ void plain_store(const Acc& acc, char* ub, unsigned lane_off) {
#pragma unroll
    for (int ai = 0; ai < 2; ++ai)
#pragma unroll
        for (int m = 0; m < 4; ++m) {
            char* rp = ub + (size_t)(ai * HALF + m * 16) * LDC * 2;
#pragma unroll
            for (int bj = 0; bj < 2; ++bj) { f32x4 v0 = acc[ai][bj][m][0], v1 = acc[ai][bj][m][1];
                if (ACT == 1) { v0 = gelu4(v0); v1 = gelu4(v1); }
                if (ACT == 2) { v0 = sigmoid4(v0); v1 = sigmoid4(v1); }
                *(u32x4*)(rp + bj * HALF * 2 + lane_off) = pack8(v0, v1); }
        }
}
struct EpiStore {
    static constexpr bool CHAIN = false;
    bf16_t* O;
    __device__ __forceinline__ void operator()(const Acc& acc, const Unit& u, int wr, int wc, int fr, int fq) const {
        plain_store<0, DM>(acc, (char*)O + ((size_t)u.pm * BM * DM + (size_t)u.pn * BM) * 2, lane_off_of<DM>(wr, wc, fr, fq));
    }
};
struct EpiIn {
    static constexpr bool CHAIN = false;
    bf16_t *ZP, *U, *V, *XG, *GATES;
    __device__ __forceinline__ void operator()(const Acc& acc, const Unit& u, int wr, int wc, int fr, int fq) const {
        const int pn = u.pn; const size_t rb = (size_t)u.pm * BM;
        if (pn >= 10) {
            char* ub = (char*)GATES + rb * 3072 + (size_t)(pn - 10) * 256; const unsigned lo = (unsigned)((wr * 64 + fr) * 3072 + wc * 32 + 8 * fq);
#pragma unroll
            for (int ai = 0; ai < 2; ++ai)
#pragma unroll
                for (int m = 0; m < 4; ++m)
#pragma unroll
                    for (int bj = 0; bj < 2; ++bj) {
                        const f32x4 v0 = sigmoid4(acc[ai][bj][m][0]) * 255.0f, v1 = sigmoid4(acc[ai][bj][m][1]) * 255.0f;
                        u32x2 w; w.x = 0u; w.y = 0u;
                        w.x = __builtin_amdgcn_cvt_pk_u8_f32(v0[0], 0, w.x); w.x = __builtin_amdgcn_cvt_pk_u8_f32(v0[1], 1, w.x); w.x = __builtin_amdgcn_cvt_pk_u8_f32(v0[2], 2, w.x); w.x = __builtin_amdgcn_cvt_pk_u8_f32(v0[3], 3, w.x);
                        w.y = __builtin_amdgcn_cvt_pk_u8_f32(v1[0], 0, w.y); w.y = __builtin_amdgcn_cvt_pk_u8_f32(v1[1], 1, w.y); w.y = __builtin_amdgcn_cvt_pk_u8_f32(v1[2], 2, w.y); w.y = __builtin_amdgcn_cvt_pk_u8_f32(v1[3], 3, w.y);
                        *(u32x2*)(ub + (size_t)(ai * HALF + m * 16) * 3072 + bj * HALF + lo) = w;
                    }
        }
        else {
            const unsigned lo = lane_off_of<512>(wr, wc, fr, fq);
            if (pn >= 6) glu_store<1, 512>(acc, (char*)XG + (rb * 512 + (size_t)(pn - 6) * 128) * 2, lo);
            else if (pn < 2) plain_store<0, 512>(acc, (char*)ZP + (rb * 512 + (size_t)pn * 256) * 2, lo);
            else { char* ub = (char*)(pn < 4 ? U : V) + (rb * 512 + (size_t)(pn & 1) * 256) * 2; plain_store<1, 512>(acc, ub, lo); }
        }
    }
};
struct EpiBranch {
    static constexpr bool CHAIN = true;
    const unsigned char* GATES; bf16_t* MG;
    static __device__ __forceinline__ f32x4 code4(unsigned w) { return (f32x4){__builtin_fmaxf((float)(w & 255u), 0.25f), __builtin_fmaxf((float)((w >> 8) & 255u), 0.25f), __builtin_fmaxf((float)((w >> 16) & 255u), 0.25f), __builtin_fmaxf((float)(w >> 24), 0.25f)}; }
    static __device__ __forceinline__ f32x4 rcp4(f32x4 v) { return (f32x4){__builtin_amdgcn_rcpf(v[0]), __builtin_amdgcn_rcpf(v[1]), __builtin_amdgcn_rcpf(v[2]), __builtin_amdgcn_rcpf(v[3])}; }
    __device__ __forceinline__ bool chain(Acc& acc, const Unit& u, int wr, int wc, int fr, int fq) const {
        const int z = u.pn >> 2, pn = u.pn & 3, pm = u.pm - z * 128;
        const bool fin = (z == 2);
        const char* gb = (const char*)GATES + (size_t)pm * BM * 3072 + (size_t)z * 1024 + (size_t)pn * BM;
        const char* gn = fin ? gb : gb + 1024;
        const unsigned glo = (unsigned)((wr * 64 + fr) * 3072 + wc * 32 + 8 * fq);
        char* mb = (char*)MG + ((size_t)pm * BM * DM + (size_t)pn * BM) * 2;
        const unsigned mlo = lane_off_of<DM>(wr, wc, fr, fq);
        constexpr float q = 1.0f / 255.0f;
        u32x2 g0[2][4][2], g1[2][4][2];
#pragma unroll
        for (int ai = 0; ai < 2; ++ai)
#pragma unroll
            for (int m = 0; m < 4; ++m)
#pragma unroll
                for (int bj = 0; bj < 2; ++bj) {
                    g0[ai][m][bj] = *(const u32x2*)(gb + (size_t)(ai * HALF + m * 16) * 3072 + bj * HALF + glo);
                    g1[ai][m][bj] = *(const u32x2*)(gn + (size_t)(ai * HALF + m * 16) * 3072 + bj * HALF + glo);
                }
#pragma unroll
        for (int ai = 0; ai < 2; ++ai)
#pragma unroll
            for (int m = 0; m < 4; ++m)
#pragma unroll
                for (int bj = 0; bj < 2; ++bj) {
                    const f32x4 d0 = rcp4(code4(g1[ai][m][bj].x)), d1 = rcp4(code4(g1[ai][m][bj].y));
                    acc[ai][bj][m][0] *= code4(g0[ai][m][bj].x) * (fin ? (f32x4){q, q, q, q} : d0);
                    acc[ai][bj][m][1] *= code4(g0[ai][m][bj].y) * (fin ? (f32x4){q, q, q, q} : d1);
                    if (fin) *(u32x4*)(mb + (size_t)(ai * HALF + m * 16) * DM * 2 + bj * HALF * 2 + mlo) = pack8(acc[ai][bj][m][0], acc[ai][bj][m][1]);
                }
        return fin;
    }
};
struct EpiPle {
    static constexpr bool CHAIN = false;
    const bf16_t* E; bf16_t* O;
    __device__ __forceinline__ void operator()(const Acc& acc, const Unit& u, int wr, int wc, int fr, int fq) const {
        const size_t uo = ((size_t)u.pm * BM * DM + (size_t)u.pn * BM) * 2;
        const char* eb = (const char*)E + uo; char* ob = (char*)O + uo;
        const unsigned lo = lane_off_of<DM>(wr, wc, fr, fq);
        u32x4 ew[2][4][2];
#pragma unroll
        for (int ai = 0; ai < 2; ++ai)
#pragma unroll
            for (int m = 0; m < 4; ++m)
#pragma unroll
                for (int bj = 0; bj < 2; ++bj) ew[ai][m][bj] = *(const u32x4*)(eb + (size_t)(ai * HALF + m * 16) * DM * 2 + bj * HALF * 2 + lo);
#pragma unroll
        for (int ai = 0; ai < 2; ++ai)
#pragma unroll
            for (int m = 0; m < 4; ++m)
#pragma unroll
                for (int bj = 0; bj < 2; ++bj) {
                    const f32x4 v0 = sigmoid4(acc[ai][bj][m][0]) * unpack_lo4(ew[ai][m][bj]), v1 = sigmoid4(acc[ai][bj][m][1]) * unpack_hi4(ew[ai][m][bj]);
                    *(u32x4*)(ob + (size_t)(ai * HALF + m * 16) * DM * 2 + bj * HALF * 2 + lo) = pack8(v0, v1);
                }
    }
};
}

template <bool INIT>
__device__ __forceinline__ void row_phase(const float* hin, float* h, const bf16_t* F, float cscale, const float* ga, const float* gb, bf16_t* HN, bool write_hn, const int tid, const int bid) {
    const int wid = tid >> 6, lane = tid & 63;
    constexpr int R = 4;
    f32x4 gav[4], gbv[4];
#pragma unroll
    for (int k = 0; k < 4; ++k) {
        gav[k] = INIT ? (f32x4){0.f, 0.f, 0.f, 0.f} : *(const f32x4*)(ga + 256 * k + 4 * lane);
        gbv[k] = write_hn ? *(const f32x4*)(gb + 256 * k + 4 * lane) : (f32x4){0.f, 0.f, 0.f, 0.f};
    }
    for (int row0 = (bid * 8 + wid) * R; row0 < MTOK; row0 += gridDim.x * 8 * R) {
        f32x4 hv[R][4]; u32x2 fw[R][4];
#pragma unroll
        for (int r = 0; r < R; ++r) { const size_t ro = (size_t)(row0 + r) * DM + 4 * lane;
#pragma unroll
            for (int k = 0; k < 4; ++k) {
                hv[r][k] = *(const f32x4*)(hin + ro + 256 * k);
                if (!INIT) fw[r][k] = *(const u32x2*)(F + ro + 256 * k);
            } }
#pragma unroll
        for (int r = 0; r < R; ++r) { const size_t ro = (size_t)(row0 + r) * DM + 4 * lane;
            if (!INIT) {
                f32x4 fv[4];
#pragma unroll
                for (int k = 0; k < 4; ++k) fv[k] = (f32x4){bf_lo(fw[r][k].x), bf_hi(fw[r][k].x), bf_lo(fw[r][k].y), bf_hi(fw[r][k].y)};
                float ss = 0.f;
#pragma unroll
                for (int i = 0; i < 4; ++i) ss += fv[i][0] * fv[i][0] + fv[i][1] * fv[i][1] + fv[i][2] * fv[i][2] + fv[i][3] * fv[i][3];
                ss = wave_sum(ss);
                const float rs = cscale * __builtin_amdgcn_rsqf(ss * (1.0f / DM) + EPS);
#pragma unroll
                for (int i = 0; i < 4; ++i) hv[r][i] += fv[i] * gav[i] * rs;
            }
            float s2 = 0.f;
#pragma unroll
            for (int i = 0; i < 4; ++i) s2 += hv[r][i][0] * hv[r][i][0] + hv[r][i][1] * hv[r][i][1] + hv[r][i][2] * hv[r][i][2] + hv[r][i][3] * hv[r][i][3];
            s2 = wave_sum(s2);
            const float rs2 = __builtin_amdgcn_rsqf(s2 * (1.0f / DM) + EPS);
            if (!INIT) { _Pragma("unroll") for (int k = 0; k < 4; ++k) *(f32x4*)(h + ro + 256 * k) = hv[r][k]; }
            if (write_hn) {
#pragma unroll
                for (int k = 0; k < 4; ++k) { const f32x4 o = hv[r][k] * gbv[k] * rs2; u32x2 w; w.x = cvt_pk_bf16(o[0], o[1]); w.y = cvt_pk_bf16(o[2], o[3]); *(u32x2*)(HN + ro + 256 * k) = w; }
            }
        }
    }
}

__device__ __forceinline__ f32x4 bf4(u32x2 w) { return (f32x4){bf_lo(w.x), bf_hi(w.x), bf_lo(w.y), bf_hi(w.y)}; }
__device__ __forceinline__ float sumsq16(const f32x4 (&v)[4]) { float s = 0.f;
#pragma unroll
    for (int i = 0; i < 4; ++i) s += v[i][0] * v[i][0] + v[i][1] * v[i][1] + v[i][2] * v[i][2] + v[i][3] * v[i][3];
    return s; }
template <bool FULL>
__device__ __forceinline__ void row_phase2(const float* hin, float* h, const bf16_t* F1, float c1, const float* ga1, const bf16_t* F2, float c2, const float* ga2, const float* gb, bf16_t* HN, bool write_hn, const int tid, const int bid) {
    const int wid = tid >> 6, lane = tid & 63;
    constexpr int R = 2;
    f32x4 g1v[4], g2v[4], gbv[4];
#pragma unroll
    for (int k = 0; k < 4; ++k) {
        g1v[k] = *(const f32x4*)(ga1 + 256 * k + 4 * lane);
        g2v[k] = FULL ? *(const f32x4*)(ga2 + 256 * k + 4 * lane) : (f32x4){0.f, 0.f, 0.f, 0.f};
        gbv[k] = write_hn ? *(const f32x4*)(gb + 256 * k + 4 * lane) : (f32x4){0.f, 0.f, 0.f, 0.f};
    }
    f32x4 hv[R][4], hn_[R][4]; u32x2 fa[R][4], fan[R][4], fb[R][4], fbn[R][4];
#define ROW_LOAD(HV, FA, FB, ROW0) do { _Pragma("unroll") for (int r = 0; r < R; ++r) { const size_t ro_ = (size_t)((ROW0) + r) * DM + 4 * lane; \
        _Pragma("unroll") for (int k = 0; k < 4; ++k) { HV[r][k] = *(const f32x4*)(hin + ro_ + 256 * k); FA[r][k] = *(const u32x2*)(F1 + ro_ + 256 * k); if (FULL) FB[r][k] = *(const u32x2*)(F2 + ro_ + 256 * k); } } } while (0)
    const int stride = (int)gridDim.x * 8 * R;
    int row0 = (bid * 8 + wid) * R;
    if (row0 < MTOK) ROW_LOAD(hv, fa, fb, row0);
    for (; row0 < MTOK; row0 += stride) {
        const bool more = row0 + stride < MTOK;
        if (more) ROW_LOAD(hn_, fan, fbn, row0 + stride);
#pragma unroll
        for (int r = 0; r < R; ++r) { const size_t ro = (size_t)(row0 + r) * DM + 4 * lane;
            {
                f32x4 fv[4];
#pragma unroll
                for (int k = 0; k < 4; ++k) fv[k] = bf4(fa[r][k]);
                const float rs = c1 * __builtin_amdgcn_rsqf(wave_sum(sumsq16(fv)) * (1.0f / DM) + EPS);
#pragma unroll
                for (int i = 0; i < 4; ++i) hv[r][i] += fv[i] * g1v[i] * rs;
            }
            if (FULL) {
                f32x4 fv[4];
#pragma unroll
                for (int k = 0; k < 4; ++k) fv[k] = bf4(fb[r][k]);
                const float rs = c2 * __builtin_amdgcn_rsqf(wave_sum(sumsq16(fv)) * (1.0f / DM) + EPS);
#pragma unroll
                for (int i = 0; i < 4; ++i) hv[r][i] += fv[i] * g2v[i] * rs;
#pragma unroll
                for (int k = 0; k < 4; ++k) *(f32x4*)(h + ro + 256 * k) = hv[r][k];
            }
            if (write_hn) {
                const float rs2 = __builtin_amdgcn_rsqf(wave_sum(sumsq16(hv[r])) * (1.0f / DM) + EPS);
#pragma unroll
                for (int k = 0; k < 4; ++k) { const f32x4 o = hv[r][k] * gbv[k] * rs2; u32x2 w; w.x = cvt_pk_bf16(o[0], o[1]); w.y = cvt_pk_bf16(o[2], o[3]); *(u32x2*)(HN + ro + 256 * k) = w; }
            }
        }
        if (more) {
#pragma unroll
            for (int r = 0; r < R; ++r)
#pragma unroll
                for (int k = 0; k < 4; ++k) { hv[r][k] = hn_[r][k]; fa[r][k] = fan[r][k]; if (FULL) fb[r][k] = fbn[r][k]; }
        }
    }
#undef ROW_LOAD
}

struct PrepJob { const float* src; bf16_t* dst; int ld, col0, k0, K, n0; };
__device__ __forceinline__ PrepJob prep_job(const Params& P, unsigned char* ws, int l, int tix) {
    constexpr int T_GU = (NGU / 64) * (DM / 64), T_D = (DM / 64) * (DFF / 64), T_IN = (NIN / 64) * (DM / 64), T_BR = (DM / 64) * (512 / 64), T_SQ = (DM / 64) * (DM / 64);
    int t = tix; const float* srcA; const float* srcB; int ld, mode, K; bf16_t* dst;
    if (t < T_GU) { srcA = PIN(3) + (size_t)l * DM * DFF; srcB = PIN(4) + (size_t)l * DM * DFF; ld = DFF; mode = 1; K = DM; dst = (bf16_t*)(ws + WS_WGU1); }
    else if ((t -= T_GU) < T_GU) { srcA = PIN(25) + (size_t)l * DM * DFF; srcB = PIN(26) + (size_t)l * DM * DFF; ld = DFF; mode = 1; K = DM; dst = (bf16_t*)(ws + WS_WGU2); }
    else if ((t -= T_GU) < T_D) { srcA = PIN(5) + (size_t)l * DFF * DM; srcB = srcA; ld = DM; mode = 0; K = DFF; dst = (bf16_t*)(ws + WS_WD1); }
    else if ((t -= T_D) < T_D) { srcA = PIN(27) + (size_t)l * DFF * DM; srcB = srcA; ld = DM; mode = 0; K = DFF; dst = (bf16_t*)(ws + WS_WD2); }
    else if ((t -= T_D) < T_IN) { srcA = PIN(8) + (size_t)l * DM * NIN; srcB = srcA; ld = NIN; mode = 2; K = DM; dst = (bf16_t*)(ws + WS_WIN); }
    else if ((t -= T_IN) < T_BR) { srcA = PIN(16) + (size_t)l * 512 * DM; srcB = srcA; ld = DM; mode = 0; K = 512; dst = (bf16_t*)(ws + WS_WBR) + (size_t)1 * DM * 512; }
    else if ((t -= T_BR) < T_BR) { srcA = PIN(21) + (size_t)l * 512 * DM; srcB = srcA; ld = DM; mode = 0; K = 512; dst = (bf16_t*)(ws + WS_WBR) + (size_t)2 * DM * 512; }
    else if ((t -= T_BR) < T_SQ) { srcA = PIN(22) + (size_t)l * DM * DM; srcB = srcA; ld = DM; mode = 0; K = DM; dst = (bf16_t*)(ws + WS_WOUT); }
    else if ((t -= T_SQ) < T_SQ) { srcA = PIN(31) + (size_t)l * DM * DM; srcB = srcA; ld = DM; mode = 0; K = DM; dst = (bf16_t*)(ws + WS_WPG); }
    else { t -= T_SQ; srcA = PIN(29) + (size_t)l * PLE * DM; srcB = srcA; ld = DM; mode = 0; K = PLE; dst = (bf16_t*)(ws + WS_WPP); }
    const int tk = K / 64, tn = t / tk, tkk = t - tn * tk, n0 = tn * 64, k0 = tkk * 64;
    const float* src = srcA; int col0 = n0;
    if (mode == 1) { const int tt = n0 >> 8, j = n0 & 255; if (j < 128) { col0 = 128 * tt + j; } else { src = srcB; col0 = 128 * tt + j - 128; } }
    else if (mode == 2) { if (n0 >= 1536 && n0 < 2560) { const int tt = (n0 - 1536) >> 8, j = (n0 - 1536) & 255; col0 = (j < 128) ? (1536 + 128 * tt + j) : (2048 + 128 * tt + j - 128); } }
    PrepJob J; J.src = src; J.dst = dst; J.ld = ld; J.col0 = col0; J.k0 = k0; J.K = K; J.n0 = n0; return J;
}

__device__ __forceinline__ void prep_weights(const Params& P, unsigned char* ws, int l, LAS unsigned char* lds, const int tid, const int bid) {
    LAS float* tile = (LAS float*)lds;
    constexpr int T_GU = (NGU / 64) * (DM / 64), T_D = (DM / 64) * (DFF / 64), T_IN = (NIN / 64) * (DM / 64), T_BR = (DM / 64) * (512 / 64), T_SQ = (DM / 64) * (DM / 64), T_PP = (DM / 64) * (PLE / 64);
    constexpr int TOTAL = 2 * T_GU + 2 * T_D + T_IN + 2 * T_BR + 2 * T_SQ + T_PP;
    {
        const int kk = tid >> 4, c4 = tid & 15, n = tid >> 3, k8 = tid & 7;
        f32x4 v0, v1; int tix = bid;
        if (tix < TOTAL) { const PrepJob J = prep_job(P, ws, l, tix); const float* sp = J.src + (size_t)(J.k0 + kk) * J.ld + J.col0 + 4 * c4; v0 = *(const f32x4*)sp; v1 = *(const f32x4*)(sp + (size_t)32 * J.ld); }
        for (; tix < TOTAL; tix += gridDim.x) {
            const PrepJob J = prep_job(P, ws, l, tix);
#pragma unroll
            for (int e = 0; e < 4; ++e) { tile[kk * 65 + 4 * c4 + e] = v0[e]; tile[(kk + 32) * 65 + 4 * c4 + e] = v1[e]; }
            __syncthreads();
            const int nx = tix + gridDim.x;
            if (nx < TOTAL) { const PrepJob Jn = prep_job(P, ws, l, nx); const float* sp = Jn.src + (size_t)(Jn.k0 + kk) * Jn.ld + Jn.col0 + 4 * c4; v0 = *(const f32x4*)sp; v1 = *(const f32x4*)(sp + (size_t)32 * Jn.ld); }
            float v[8];
#pragma unroll
            for (int i = 0; i < 8; ++i) v[i] = tile[(8 * k8 + i) * 65 + n];
            u32x4 w; w.x = cvt_pk_bf16(v[0], v[1]); w.y = cvt_pk_bf16(v[2], v[3]); w.z = cvt_pk_bf16(v[4], v[5]); w.w = cvt_pk_bf16(v[6], v[7]);
            *(u32x4*)(J.dst + (size_t)(J.n0 + n) * J.K + J.k0 + 8 * k8) = w;
            __syncthreads();
        }
    }
    {
        const float* pw = PIN(9) + (size_t)l * 4 * 128 * 128; const float* sc = PIN(10) + (size_t)l * 512; const float* wpo = PIN(11) + (size_t)l * 512 * DM;
        bf16_t* dst = (bf16_t*)(ws + WS_WBR);
        const int ol = tid & 63, i4 = __builtin_amdgcn_readfirstlane(tid >> 6);
        for (int tix = bid; tix < 16 * 16; tix += gridDim.x) {
            const int o = (tix >> 4) * 64 + ol, g = (tix >> 2) & 3, i0 = (tix & 3) * 32 + i4 * 4;
            float a[4] = {0.f, 0.f, 0.f, 0.f};
#pragma unroll 4
            for (int j = 0; j < 128; j += 4) {
                const f32x4 s4 = *(const f32x4*)(sc + g * 128 + j);
                float w[4];
#pragma unroll
                for (int jj = 0; jj < 4; ++jj) w[jj] = wpo[(size_t)(g * 128 + j + jj) * DM + o] * s4[jj];
#pragma unroll
                for (int ii = 0; ii < 4; ++ii) { const f32x4 p4 = *(const f32x4*)(pw + (size_t)(g * 128 + i0 + ii) * 128 + j);
                    a[ii] += p4[0] * w[0] + p4[1] * w[1] + p4[2] * w[2] + p4[3] * w[3]; }
            }
            u32x2 w2; w2.x = cvt_pk_bf16(a[0], a[1]); w2.y = cvt_pk_bf16(a[2], a[3]);
            *(u32x2*)(dst + (size_t)o * 512 + g * 128 + i0) = w2;
        }
    }
    {
        const float* wsrc = PIN(14) + (size_t)l * 4 * 128 * 128; bf16_t* dst = (bf16_t*)(ws + WS_WSPK);
        for (int idx = bid * 512 + tid; idx < 4 * 128 * 128 / 8; idx += gridDim.x * 512) {
            const int fq = idx & 3, kk = (idx >> 2) & 3, t = (idx >> 4) & 127, h = idx >> 11;
            float v[8];
#pragma unroll
            for (int i = 0; i < 8; ++i) { const int sp = 32 * kk + 4 * i + fq; v[i] = (sp <= t) ? wsrc[(size_t)(h * 128 + t) * 128 + sp] : 0.f; }
            u32x4 w4; w4.x = cvt_pk_bf16(v[0], v[1]); w4.y = cvt_pk_bf16(v[2], v[3]); w4.z = cvt_pk_bf16(v[4], v[5]); w4.w = cvt_pk_bf16(v[6], v[7]);
            *(u32x4*)(dst + (size_t)idx * 8) = w4;
        }
    }
}

__device__ __forceinline__ void convert_p(const float* p, bf16_t* PB, const int tid, const int bid) {
    for (size_t idx = (size_t)bid * 512 + tid; idx < (size_t)MTOK * PLE / 8; idx += (size_t)gridDim.x * 512) {
        const f32x4 a = *(const f32x4*)(p + idx * 8), b = *(const f32x4*)(p + idx * 8 + 4);
        *(u32x4*)(PB + idx * 8) = pack8(a, b);
    }
}

template <int W>
__device__ __forceinline__ void pool_run(const bf16_t* ZP, bf16_t* XP, const int oct, const int sub, const int bid) {
    for (int it = bid; it < MTOK / 32; it += gridDim.x) {
        const int tok0 = it * 32 + 4 * sub, t0 = tok0 & (SEQ - 1);
        const bf16_t* zp = ZP + (size_t)tok0 * 512 + 8 * oct;
        u32x4 row[W + 3];
#pragma unroll
        for (int j = 0; j < W + 3; ++j) { row[j] = (u32x4){0u, 0u, 0u, 0u}; if (t0 + 3 - j >= 0) row[j] = *(const u32x4*)(zp + (ptrdiff_t)(3 - j) * 512); }
        f32x4 s0 = (f32x4){0.f, 0.f, 0.f, 0.f}, s1 = s0;
#pragma unroll
        for (int j = 0; j < W; ++j) { s0 += unpack_lo4(row[j]); s1 += unpack_hi4(row[j]); }
        f32x4 o0[4], o1[4]; o0[3] = s0; o1[3] = s1;
#pragma unroll
        for (int d = 0; d < 3; ++d) { s0 += unpack_lo4(row[W + d]) - unpack_lo4(row[d]); s1 += unpack_hi4(row[W + d]) - unpack_hi4(row[d]); o0[2 - d] = s0; o1[2 - d] = s1; }
#pragma unroll
        for (int u = 0; u < 4; ++u) { const int t = t0 + u; const float inv = 1.0f / (float)((t + 1) < W ? (t + 1) : W);
            *(u32x4*)(XP + (size_t)(tok0 + u) * 512 + 8 * oct) = pack8(o0[u] * inv - unpack_lo4(row[3 - u]), o1[u] * inv - unpack_hi4(row[3 - u])); }
    }
}

__device__ __forceinline__ void mixer_phase(const Params& P, unsigned char* ws, int l, LAS unsigned char* lds, const int tid, const int bid) {
    unsigned char* big = ws + WS_BIG;
    const bf16_t* ZP = (const bf16_t*)(big + BIG_ZP); const bf16_t* U = (const bf16_t*)(big + BIG_U); const bf16_t* V = (const bf16_t*)(big + BIG_V); const bf16_t* XG = (const bf16_t*)(big + BIG_XG);
    bf16_t* X3 = (bf16_t*)(big + BIG_X3);
    const int wid = __builtin_amdgcn_readfirstlane(tid >> 6), lane = tid & 63;

    {
        const float* lng = PIN(12) + (size_t)l * 512; const float* lnb = PIN(13) + (size_t)l * 512; const float* bsp = PIN(15) + (size_t)l * 4 * 128;
        const bf16_t* WSPK = (const bf16_t*)(ws + WS_WSPK);
        bf16_t* XS = X3 + (size_t)1 * MTOK * 512;
        const int fr = lane & 15, fq = lane >> 4, h = wid >> 1, th = wid & 1;
        constexpr int VP = 528;
        for (int ch = bid; ch < MTOK / 128; ch += gridDim.x) {
            const size_t tok0 = (size_t)ch * 128;
            {
                const f32x4 g0 = *(const f32x4*)(lng + 8 * lane), g1 = *(const f32x4*)(lng + 8 * lane + 4), b0 = *(const f32x4*)(lnb + 8 * lane), b1 = *(const f32x4*)(lnb + 8 * lane + 4);
#pragma unroll
                for (int i0 = 0; i0 < 16; i0 += 8) {
                    u32x4 wv[8];
#pragma unroll
                    for (int i = 0; i < 8; ++i) wv[i] = *(const u32x4*)(V + (tok0 + wid * 16 + i0 + i) * 512 + 8 * lane);
#pragma unroll
                    for (int i = 0; i < 8; ++i) {
                        const int sp = wid * 16 + i0 + i;
                        f32x4 x0 = unpack_lo4(wv[i]), x1 = unpack_hi4(wv[i]);
                        float s = (x0[0] + x0[1]) + (x0[2] + x0[3]) + (x1[0] + x1[1]) + (x1[2] + x1[3]);
                        s = wave_sum(s); const float mu = s * (1.0f / 512.0f);
                        x0 -= mu; x1 -= mu;
                        float q = x0[0] * x0[0] + x0[1] * x0[1] + x0[2] * x0[2] + x0[3] * x0[3] + x1[0] * x1[0] + x1[1] * x1[1] + x1[2] * x1[2] + x1[3] * x1[3];
                        q = wave_sum(q); const float rs = __builtin_amdgcn_rsqf(q * (1.0f / 512.0f) + EPS);
                        x0 = x0 * rs * g0 + b0; x1 = x1 * rs * g1 + b1;
                        *(LAS u32x4*)(lds + (size_t)sp * (VP * 2) + 16 * lane) = pack8(x0, x1);
                    }
                }
            }
            __syncthreads();
            {
                bf16x8 Wf[4][4]; float bs[4];
#pragma unroll
                for (int m = 0; m < 4; ++m) { const int t = 64 * th + 16 * m + fr; bs[m] = bsp[h * 128 + t];
#pragma unroll
                    for (int kk = 0; kk < 4; ++kk) Wf[m][kk] = *(const bf16x8*)(WSPK + ((size_t)((h * 128 + t) * 4 + kk) * 4 + fq) * 8); }
                const size_t ubase = (tok0 + 64 * th + fr) * 512 + 128 * h + 4 * fq;
                u32x2 uw[2][4];
#pragma unroll
                for (int m = 0; m < 4; ++m) uw[0][m] = *(const u32x2*)(U + ubase + (size_t)(16 * m) * 512);
#pragma unroll
                for (int n = 0; n < 8; ++n) {
                    if (n + 1 < 8) {
#pragma unroll
                        for (int m = 0; m < 4; ++m) uw[(n + 1) & 1][m] = *(const u32x2*)(U + ubase + (size_t)(16 * m) * 512 + 16 * (n + 1));
                    }
                    f32x4 acc[4];
#pragma unroll
                    for (int m = 0; m < 4; ++m) acc[m] = (f32x4){0.f, 0.f, 0.f, 0.f};
#pragma unroll
                    for (int kk = 0; kk < 4; ++kk) {
                        bf16x8 X;
#pragma unroll
                        for (int i = 0; i < 8; ++i) X[i] = *(const LAS short*)(lds + (size_t)(32 * kk + 4 * i + fq) * (VP * 2) + 2 * (128 * h + 16 * n + fr));
#pragma unroll
                        for (int m = 0; m < 4; ++m) acc[m] = __builtin_amdgcn_mfma_f32_16x16x32_bf16(X, Wf[m][kk], acc[m], 0, 0, 0);
                    }
#pragma unroll
                    for (int m = 0; m < 4; ++m) {
                        const u32x2 u2 = uw[n & 1][m];
                        const f32x4 sv = acc[m] + bs[m];
                        u32x2 o; o.x = cvt_pk_bf16(bf_lo(u2.x) * sv[0], bf_hi(u2.x) * sv[1]); o.y = cvt_pk_bf16(bf_lo(u2.y) * sv[2], bf_hi(u2.y) * sv[3]);
                        *(u32x2*)(XS + ubase + (size_t)(16 * m) * 512 + 16 * n) = o;
                    }
                }
            }
            __syncthreads();
        }
    }

    {
        const float* dwk = PIN(17) + (size_t)l * 31 * 512; const float* dwb = PIN(18) + (size_t)l * 512; const float* lng = PIN(19) + (size_t)l * 512; const float* lnb = PIN(20) + (size_t)l * 512;
        bf16_t* XC = X3 + (size_t)2 * MTOK * 512;
        LAS unsigned char* xs = lds;
        LAS float* ys = (LAS float*)(lds + 65536);
        const int cp = tid & 255, hbq = __builtin_amdgcn_readfirstlane(tid >> 8);
        f32x2 wk[31];
#pragma unroll
        for (int k = 0; k < 31; ++k) wk[k] = *(const f32x2*)(dwk + k * 512 + 2 * cp);
        const f32x2 bias = *(const f32x2*)(dwb + 2 * cp);
        const f32x4 g0 = *(const f32x4*)(lng + 8 * lane), g1 = *(const f32x4*)(lng + 8 * lane + 4), b0 = *(const f32x4*)(lnb + 8 * lane), b1 = *(const f32x4*)(lnb + 8 * lane + 4);
        u32x4 pre[8];
#define CONV_LOAD(ct_) do { const int tok0_ = (ct_) * 32, t0_ = tok0_ & (SEQ - 1); _Pragma("unroll") for (int i = 0; i < 8; ++i) { const int idx = tid + 512 * i; const int r = idx >> 6, c8 = idx & 63; \
            pre[i] = (u32x4){0u, 0u, 0u, 0u}; if (idx < 62 * 64 && t0_ - 30 + r >= 0) pre[i] = *(const u32x4*)(XG + (size_t)(tok0_ - 30 + r) * 512 + 8 * c8); } } while (0)
        int ct = bid;
        if (ct < MTOK / 32) CONV_LOAD(ct);
        for (; ct < MTOK / 32; ct += gridDim.x) {
            const int tok0 = ct * 32;
#pragma unroll
            for (int i = 0; i < 8; ++i) { const int idx = tid + 512 * i; if (idx < 62 * 64) *(LAS u32x4*)(xs + (idx >> 6) * 1024 + 16 * (idx & 63)) = pre[i]; }
            __syncthreads();
            if (ct + (int)gridDim.x < MTOK / 32) CONV_LOAD(ct + gridDim.x);
            {
                f32x2 x[46];
#pragma unroll
                for (int r = 0; r < 46; ++r) { const unsigned w2 = *(const LAS unsigned*)(xs + (16 * hbq + r) * 1024 + 4 * cp); x[r] = (f32x2){bf_lo(w2), bf_hi(w2)}; }
#pragma unroll
                for (int t = 0; t < 16; ++t) { f32x2 y = bias;
#pragma unroll
                    for (int k = 0; k < 31; ++k) y += wk[k] * x[t + k];
                    *(LAS f32x2*)(ys + (16 * hbq + t) * 512 + 2 * cp) = y; }
            }
            __syncthreads();
#pragma unroll
            for (int i = 0; i < 4; ++i) { const int t = wid * 4 + i;
                f32x4 x0 = *(const LAS f32x4*)(ys + t * 512 + 8 * lane), x1 = *(const LAS f32x4*)(ys + t * 512 + 8 * lane + 4);
                float s = (x0[0] + x0[1]) + (x0[2] + x0[3]) + (x1[0] + x1[1]) + (x1[2] + x1[3]);
                s = wave_sum(s); const float mu = s * (1.0f / 512.0f);
                x0 -= mu; x1 -= mu;
                float q = x0[0] * x0[0] + x0[1] * x0[1] + x0[2] * x0[2] + x0[3] * x0[3] + x1[0] * x1[0] + x1[1] * x1[1] + x1[2] * x1[2] + x1[3] * x1[3];
                q = wave_sum(q); const float rs = __builtin_amdgcn_rsqf(q * (1.0f / 512.0f) + EPS);
                x0 = x0 * rs * g0 + b0; x1 = x1 * rs * g1 + b1;
                x0 = x0 * sigmoid4(x0); x1 = x1 * sigmoid4(x1);
                *(u32x4*)(XC + (size_t)(tok0 + t) * 512 + 8 * lane) = pack8(x0, x1); }
            __syncthreads();
        }
#undef CONV_LOAD
    }

    {
        const int g = wid & 3, oct = g * 16 + (lane & 15), sub = (wid >> 2) * 4 + (lane >> 4);
        switch (g) {
        case 0: pool_run<2>(ZP, X3, oct, sub, bid); break;
        case 1: pool_run<4>(ZP, X3, oct, sub, bid); break;
        case 2: pool_run<8>(ZP, X3, oct, sub, bid); break;
        default: pool_run<16>(ZP, X3, oct, sub, bid); break;
        }
    }
}

#define XB_TMO      128
#define XB_XCNT(j)  (256  + 64 * (j))
#define XB_XSUB(j)  (1280 + 64 * (j))
#define XB_XGEN(j)  (2304 + 64 * (j))
#define XB_TOP      3328
#define XB_TOPGEN   3392
#define XCD_BAR_WORDS 3456
#define XB_SPIN_CAP (1u << 18)
__device__ __forceinline__ unsigned xb_ld(unsigned* p)              { return __hip_atomic_load(p, __ATOMIC_RELAXED, __HIP_MEMORY_SCOPE_AGENT); }
__device__ __forceinline__ unsigned xb_add(unsigned* p, unsigned v) { return __hip_atomic_fetch_add(p, v, __ATOMIC_RELAXED, __HIP_MEMORY_SCOPE_AGENT); }
__device__ __forceinline__ unsigned xb_xcc_id() { return (unsigned)__builtin_amdgcn_s_getreg((3 << 11) | 20) & 0xFu; }
#define XB_SPIN(cond, bar) do { unsigned _sp = 0; while (cond) { __builtin_amdgcn_s_sleep(1); \
    if ((++_sp & 255u) == 0u) { if (xb_ld(&(bar)[XB_TMO])) break; if (_sp > XB_SPIN_CAP) { atomicAdd(&(bar)[XB_TMO], 1u); break; } } } } while (0)
struct XcdBarrier { unsigned* bar; unsigned x; volatile LAS unsigned* st; };
__device__ __forceinline__ XcdBarrier xcd_barrier_post(unsigned* bar, volatile LAS unsigned* st) {
    XcdBarrier b; b.bar = bar; b.x = xb_xcc_id(); b.st = st;
    if (threadIdx.x == 0) (void)xb_add(&bar[XB_XCNT(b.x)], 1u);
    return b;
}
__device__ __forceinline__ void xcd_barrier_complete(unsigned* bar, unsigned x, unsigned& nloc, unsigned& nx) {
    const unsigned G = gridDim.x * gridDim.y * gridDim.z;
    unsigned sum, cnt, mine, sp = 0u;
    for (;;) {
        sum = 0u; cnt = 0u; mine = 0u;
#pragma unroll
        for (unsigned j = 0; j < 16; ++j) { const unsigned c = xb_ld(&bar[XB_XCNT(j)]); sum += c; cnt += (c > 0u) ? 1u : 0u; mine = (j == x) ? c : mine; }
        if (sum == G) break;
        __builtin_amdgcn_s_sleep(1);
        if ((++sp & 255u) == 0u) { if (xb_ld(&bar[XB_TMO])) break; if (sp > XB_SPIN_CAP) { atomicAdd(&bar[XB_TMO], 1u); break; } }
    }
    nloc = mine > 0u ? mine : 1u; nx = cnt > 0u ? cnt : 1u;
}
__device__ __forceinline__ void xcd_barrier(const XcdBarrier& b) {
    asm volatile("s_waitcnt vmcnt(0)" ::: "memory");
    __syncthreads();
    if (threadIdx.x == 0) {
        unsigned* bar = b.bar;
        __builtin_amdgcn_s_waitcnt(0);
        unsigned nloc = b.st[0], nx = b.st[1];
        if (nloc == 0u) { xcd_barrier_complete(bar, b.x, nloc, nx); b.st[0] = nloc; b.st[1] = nx; }
        const unsigned old = xb_add(&bar[XB_XSUB(b.x)], 1u);
        const unsigned gen = old / nloc;
        if (old + 1u == (gen + 1u) * nloc) {
            __builtin_amdgcn_fence(__ATOMIC_RELEASE, "agent");
            asm volatile("s_waitcnt vmcnt(0)" ::: "memory");
            const unsigned og = xb_add(&bar[XB_TOP], 1u);
            const unsigned tg = og / nx;
            if (og + 1u == (tg + 1u) * nx) xb_add(&bar[XB_TOPGEN], 1u);
            else XB_SPIN(xb_ld(&bar[XB_TOPGEN]) == tg, bar);
            __builtin_amdgcn_fence(__ATOMIC_ACQUIRE, "agent");
            xb_add(&bar[XB_XGEN(b.x)], 1u);
            asm volatile("s_waitcnt vmcnt(0)" ::: "memory");
        } else {
            XB_SPIN(xb_ld(&bar[XB_XGEN(b.x)]) == gen, bar);
            __builtin_amdgcn_fence(__ATOMIC_ACQUIRE, "agent");
            asm volatile("s_waitcnt vmcnt(0)" ::: "memory");
        }
    }
    __syncthreads();
}

__device__ __forceinline__ void run_phase(const Params& P, int ph, LAS unsigned char* lds, const float rmul = 1.0f, const bool row_only = false) {
    GAS unsigned char* wsg = P.ws; GAS float* outg = P.out; int tid = threadIdx.x, bid = blockIdx.x;
    asm volatile("" : "+s"(wsg), "+s"(outg), "+v"(tid), "+s"(bid));
    unsigned char* ws = (unsigned char*)wsg; float* out = (float*)outg;
    unsigned char* big = ws + WS_BIG;
    bf16_t* HN = (bf16_t*)(ws + WS_HN); bf16_t* F = (bf16_t*)(ws + WS_F); bf16_t* F2 = (bf16_t*)(ws + WS_F2);
    const int G = gridDim.x, c = bid;
    constexpr unsigned PM = PHASE_MASK;
    if (ph == 0) {
        if (!(PM & (1u << 13))) return;
        prep_weights(P, ws, 0, lds, tid, bid);
        row_phase<true>(PIN(0), out, nullptr, 0.f, nullptr, PIN(2), HN, true, tid, bid);
        return;
    }
    const int l = (ph - 1) / 13, sub = (ph - 1) % 13;
    pg8::Order S;
    switch (sub) {
    case 0: case 8: if (PM & 1u) {
        pg8::Gemm g{HN, (const bf16_t*)(ws + (sub == 0 ? WS_WGU1 : WS_WGU2)), MTOK, NGU, DM}; S.init(MTOK, NGU, G, c, 1);
        pg8::EpiGLU E{(bf16_t*)(big + BIG_ACT)};
        pg8::gemm_phase(lds, g, S, E, tid);
        if (sub == 8) {
            pg8::Gemm g2{(const bf16_t*)(big + BIG_PB), (const bf16_t*)(ws + WS_WPP), MTOK, DM, PLE}; S.init(MTOK, DM, G, c, 1);
            pg8::EpiStore E2{(bf16_t*)(big + BIG_E)};
            pg8::gemm_phase(lds, g2, S, E2, tid);
        }
    } break;
    case 1: case 9: if (PM & 2u) {
        pg8::Gemm g{(const bf16_t*)(big + BIG_ACT), (const bf16_t*)(ws + (sub == 1 ? WS_WD1 : WS_WD2)), MTOK, DM, DFF}; S.init(MTOK, DM, G, c, 1);
        pg8::EpiStore E{F};
        pg8::gemm_phase(lds, g, S, E, tid);
    } break;
    case 2: if (PM & 4u) row_phase2<false>(l == 0 ? PIN(0) : (const float*)out, out, F, 0.5f, PIN(6) + l * DM, nullptr, 0.f, nullptr, PIN(7) + l * DM, HN, true, tid, bid); break;
    case 3: if (PM & 8u) {
        pg8::Gemm g{HN, (const bf16_t*)(ws + WS_WIN), MTOK, NIN, DM}; S.init(MTOK, NIN, G, c, 1);
        pg8::EpiIn E{(bf16_t*)(big + BIG_ZP), (bf16_t*)(big + BIG_U), (bf16_t*)(big + BIG_V), (bf16_t*)(big + BIG_XG), (bf16_t*)(big + BIG_GATES)};
        pg8::gemm_phase(lds, g, S, E, tid);
    } break;
    case 4: if (PM & 16u) mixer_phase(P, ws, l, lds, tid, bid); break;
    case 5: if (PM & 32u) {
        pg8::Gemm g{(const bf16_t*)(big + BIG_X3), (const bf16_t*)(ws + WS_WBR), MTOK, DM, 512}; S.init(MTOK, DM, G, c, 3);
        pg8::EpiBranch E{(const unsigned char*)(big + BIG_GATES), (bf16_t*)(big + BIG_MERGED)};
        pg8::gemm_phase(lds, g, S, E, tid);
    } break;
    case 6: if (PM & 64u) {
        pg8::Gemm g{(const bf16_t*)(big + BIG_MERGED), (const bf16_t*)(ws + WS_WOUT), MTOK, DM, DM}; S.init(MTOK, DM, G, c, 1);
        pg8::EpiStore E{F2};
        pg8::gemm_phase(lds, g, S, E, tid);
    } break;
    case 7: if (PM & 128u) {
        row_phase2<true>(l == 0 ? PIN(0) : (const float*)out, out, F, 0.5f, PIN(6) + l * DM, F2, 1.0f, PIN(23) + l * DM, PIN(24) + l * DM, HN, true, tid, bid);
        if (!row_only) convert_p(PIN(1) + (size_t)l * MTOK * PLE, (bf16_t*)(big + BIG_PB), tid, bid);
        } break;
    case 10: if (PM & 1024u) row_phase2<false>(out, out, F, 0.5f, PIN(28) + l * DM, nullptr, 0.f, nullptr, PIN(30) + l * DM, HN, true, tid, bid); break;
    case 11: if (PM & 2048u) {
        pg8::Gemm g{HN, (const bf16_t*)(ws + WS_WPG), MTOK, DM, DM}; S.init(MTOK, DM, G, c, 1);
        pg8::EpiPle E{(const bf16_t*)(big + BIG_E), F2};
        pg8::gemm_phase(lds, g, S, E, tid);
    } break;
    case 12: if (PM & 4096u) {
        row_phase2<true>(out, out, F, 0.5f, PIN(28) + l * DM, F2, 1.0f, PIN(32) + l * DM, PIN(2) + (l + 1 < NLAYER ? l + 1 : l) * DM, HN, l + 1 < NLAYER, tid, bid);
        if (l + 1 < NLAYER && !row_only) prep_weights(P, ws, l + 1, lds, tid, bid);
        } break;
    default: break;
    }
}

__global__ void __launch_bounds__(512, 2) mega(Params P) {
    extern __shared__ __attribute__((aligned(16))) unsigned char lds_raw[];
    LAS unsigned char* lds = (LAS unsigned char*)lds_raw;
    cg::grid_group grid = cg::this_grid();
#if !MULTI_LAUNCH
    volatile LAS unsigned* st = (volatile LAS unsigned*)(lds + LDS_BYTES - 16);
    if (threadIdx.x < 2) st[threadIdx.x] = 0u;
    __syncthreads();
    const XcdBarrier bar = xcd_barrier_post((unsigned*)((unsigned char*)P.ws + WS_BAR), st);
#endif
    for (int ph = P.ph_lo; ph < P.ph_hi; ++ph) {
        run_phase(P, ph, lds);
#if PROBE_DUP
        {
            const int sub = ph == 0 ? -1 : (ph - 1) % 13;
            const bool is_gemm = (sub == 0 || sub == 1 || sub == 3 || sub == 5 || sub == 6 || sub == 8 || sub == 9 || sub == 11);
            if (((PROBE_DUP & 1) && is_gemm) || ((PROBE_DUP & 2) && sub == 4)) { __syncthreads(); run_phase(P, ph, lds); }
#if !MULTI_LAUNCH
            if ((PROBE_DUP & 4) && ph > 0) xcd_barrier(bar);
#endif
        }
#endif
#if !MULTI_LAUNCH
        if (ph + 1 < P.ph_hi) { if (ph == 0) grid.sync(); else xcd_barrier(bar); }
#endif
    }
}

extern "C" void kernel_launch(void* const* d_in, const int* in_sizes, int n_in, void* d_out, int out_size, void* d_ws, size_t ws_size, hipStream_t stream) {
    static int grid = 0;
    if (grid == 0) {
        if (n_in != 33 || ws_size < WS_END) { fprintf(stderr, "kernel_launch: unexpected n_in %d or ws_size %zu (< %zu)\n", n_in, ws_size, (size_t)WS_END); grid = -1; return; }
        int dev = 0, cus = 0, per_cu = 0;
        hipGetDevice(&dev);
        hipDeviceGetAttribute(&cus, hipDeviceAttributeMultiprocessorCount, dev);
        if (hipFuncSetAttribute((const void*)mega, hipFuncAttributeMaxDynamicSharedMemorySize, LDS_BYTES) != hipSuccess) { fprintf(stderr, "kernel_launch: hipFuncSetAttribute failed\n"); grid = -1; return; }
        hipOccupancyMaxActiveBlocksPerMultiprocessor(&per_cu, (const void*)mega, 512, LDS_BYTES);
        if (per_cu < 1) per_cu = 1;
        (void)hipGetLastError();
        grid = cus * per_cu;
    }
    if (grid < 0) return;
    Params p{};
    for (int i = 0; i < 33; ++i) p.in[i] = (const GAS float*)d_in[i];
    p.out = (GAS float*)d_out; p.ws = (GAS unsigned char*)d_ws;
#if MULTI_LAUNCH
    for (int ph = 0; ph < NPHASE; ++ph) {
        p.ph_lo = ph; p.ph_hi = ph + 1;
        hipLaunchKernelGGL(mega, dim3(grid), dim3(512), LDS_BYTES, stream, p);
    }
#else
    p.ph_lo = 0; p.ph_hi = NPHASE;
    if (hipMemsetAsync((char*)d_ws + WS_BAR, 0, 16384, stream) != hipSuccess) { fprintf(stderr, "kernel_launch: memset of the barrier words failed\n"); return; }
    void* args[] = {&p};
    hipError_t e = hipLaunchCooperativeKernel((const void*)mega, dim3(grid), dim3(512), args, LDS_BYTES, stream);
    if (e != hipSuccess) fprintf(stderr, "cooperative launch failed: %s (grid %d)\n", hipGetErrorString(e), grid);
#endif
}
```

```cpp
#include <hip/hip_runtime.h>
#include <hip/hip_cooperative_groups.h>
#include <cstdio>
namespace cg = cooperative_groups;

#ifndef PHASE_MASK
#define PHASE_MASK 0xffffu
#endif
#ifndef PROBE_DUP
#define PROBE_DUP 0
#endif
#ifndef MULTI_LAUNCH
#define MULTI_LAUNCH 0
#endif

#define LAS __attribute__((address_space(3)))
typedef unsigned short bf16_t;
typedef short bf16x8 __attribute__((ext_vector_type(8)));
typedef float f32x4 __attribute__((ext_vector_type(4)));
typedef float f32x2 __attribute__((ext_vector_type(2)));
typedef unsigned u32x4 __attribute__((ext_vector_type(4)));
typedef unsigned u32x2 __attribute__((ext_vector_type(2)));

constexpr int MTOK = 32768, DM = 1024, DFF = 2816, SEQ = 4096, NLAYER = 4, PLE = 256;
constexpr int NGU = 2 * DFF;
constexpr int NIN = 5632;
constexpr float EPS = 1e-6f;
constexpr int LDS_BYTES = 147456;
constexpr int NPHASE = 1 + 13 * NLAYER;

constexpr size_t WS_WGU1 = 0;
constexpr size_t WS_WD1 = WS_WGU1 + (size_t)NGU * DM * 2;
constexpr size_t WS_WGU2 = WS_WD1 + (size_t)DM * DFF * 2;
constexpr size_t WS_WD2 = WS_WGU2 + (size_t)NGU * DM * 2;
constexpr size_t WS_WIN = WS_WD2 + (size_t)DM * DFF * 2;
constexpr size_t WS_WBR = WS_WIN + (size_t)NIN * DM * 2;
constexpr size_t WS_WOUT = WS_WBR + (size_t)3 * DM * 512 * 2;
constexpr size_t WS_WPG = WS_WOUT + (size_t)DM * DM * 2;
constexpr size_t WS_WPP = WS_WPG + (size_t)DM * DM * 2;
constexpr size_t WS_WSPK = WS_WPP + (size_t)DM * PLE * 2;
constexpr size_t WS_HN = WS_WSPK + (size_t)4 * 128 * 128 * 2;
constexpr size_t WS_F = WS_HN + (size_t)MTOK * DM * 2;
constexpr size_t WS_BIG = WS_F + (size_t)MTOK * DM * 2;
constexpr size_t BIG_ACT = 0;
constexpr size_t BIG_ZP = 0, BIG_U = (size_t)MTOK * 512 * 2, BIG_V = 2 * BIG_U, BIG_XG = 3 * BIG_U;
constexpr size_t BIG_GATES = 4 * BIG_U;
constexpr size_t BIG_X3 = BIG_GATES + (size_t)MTOK * 3072 * 2;
constexpr size_t BIG_MERGED = 0;
constexpr size_t BIG_E = (size_t)192 * 1024 * 1024;
constexpr size_t BIG_PB = BIG_X3;
constexpr size_t WS_BAR = WS_BIG + BIG_X3 + (size_t)3 * MTOK * 512 * 2;
constexpr size_t WS_F2 = WS_BAR + 16384;
constexpr size_t WS_END = WS_F2 + (size_t)MTOK * DM * 2;

#define GAS __attribute__((address_space(1)))
struct Params { const GAS float* in[33]; GAS float* out; GAS unsigned char* ws; int ph_lo, ph_hi; };
#define PIN(i) ((const float*)P.in[i])

typedef __bf16 bf16x2_t __attribute__((ext_vector_type(2)));
__device__ __forceinline__ unsigned cvt_pk_bf16(float lo, float hi) { const f32x2 v = {lo, hi}; return __builtin_bit_cast(unsigned, __builtin_convertvector(v, bf16x2_t)); }
__device__ __forceinline__ float bf_lo(unsigned w) { return __uint_as_float(w << 16); }
__device__ __forceinline__ float bf_hi(unsigned w) { return __uint_as_float(w & 0xffff0000u); }
__device__ __forceinline__ float sigmoid_f(float x) { return __builtin_amdgcn_rcpf(1.0f + __builtin_amdgcn_exp2f(-1.44269504f * x)); }
template <int CTRL> __device__ __forceinline__ float dpp_add(float v) { return v + __builtin_bit_cast(float, __builtin_amdgcn_update_dpp(0, __builtin_bit_cast(int, v), CTRL, 0xf, 0xf, false)); }
__device__ __forceinline__ float wave_sum(float v) {
    v = dpp_add<0xB1>(v);
    v = dpp_add<0x4E>(v);
    v = dpp_add<0x141>(v);
    v = dpp_add<0x140>(v);
    const int iv = __builtin_bit_cast(int, v);
    return (__builtin_bit_cast(float, __builtin_amdgcn_readlane(iv, 0)) + __builtin_bit_cast(float, __builtin_amdgcn_readlane(iv, 16)))
         + (__builtin_bit_cast(float, __builtin_amdgcn_readlane(iv, 32)) + __builtin_bit_cast(float, __builtin_amdgcn_readlane(iv, 48)));
}
__device__ __forceinline__ f32x2 gelu_pk(f32x2 v) {
    const f32x2 av = __builtin_elementwise_abs(v), d = av * 0.2316418882f + 1.0f;
    f32x2 t; t.x = __builtin_amdgcn_rcpf(d.x); t.y = __builtin_amdgcn_rcpf(d.y);
    f32x2 q = t * 0.5307027145f + (-0.7265760135f); q = q * t + 0.7107068705f; q = q * t + (-0.142248368f); q = q * t + 0.127414796f; q = q * t;
    const f32x2 s = (v * v) * (-0.72134752044f);
    f32x2 e; e.x = __builtin_amdgcn_exp2f(s.x); e.y = __builtin_amdgcn_exp2f(s.y);
    const f32x2 m = v * (q * e), r = v - m;
    f32x2 o; o.x = v.x < 0.f ? m.x : r.x; o.y = v.y < 0.f ? m.y : r.y; return o;
}
__device__ __forceinline__ f32x4 gelu4(f32x4 v) { f32x2 a = gelu_pk((f32x2){v[0], v[1]}), b = gelu_pk((f32x2){v[2], v[3]}); return (f32x4){a.x, a.y, b.x, b.y}; }
__device__ __forceinline__ f32x4 sigmoid4(f32x4 v) { return (f32x4){sigmoid_f(v[0]), sigmoid_f(v[1]), sigmoid_f(v[2]), sigmoid_f(v[3])}; }
__device__ __forceinline__ u32x4 pack8(f32x4 a, f32x4 b) { u32x4 w; w.x = cvt_pk_bf16(a[0], a[1]); w.y = cvt_pk_bf16(a[2], a[3]); w.z = cvt_pk_bf16(b[0], b[1]); w.w = cvt_pk_bf16(b[2], b[3]); return w; }
__device__ __forceinline__ f32x4 unpack_lo4(u32x4 w) { return (f32x4){bf_lo(w.x), bf_hi(w.x), bf_lo(w.y), bf_hi(w.y)}; }
__device__ __forceinline__ f32x4 unpack_hi4(u32x4 w) { return (f32x4){bf_lo(w.z), bf_hi(w.z), bf_lo(w.w), bf_hi(w.w)}; }

namespace pg8 {
constexpr int BM = 256, BK = 64, HALF = 128, HTB = HALF * BK * 2, STAGE_BYTES = 8 * HTB, NXCD = 8, WGM = 8;
__device__ __forceinline__ int lds_byte(int r, int c) { const int st = (r >> 4) * 2 + (c >> 5), rr = r & 15, cc = c & 31, ob = rr * 64 + cc * 2; return st * 1024 + (ob ^ (((ob >> 9) & 1) << 5)); }
__device__ __forceinline__ void stage_rc(int b, int& R, int& C) { const int st = b / 1024, sb = b % 1024, swz = sb ^ (((sb >> 9) & 1) << 5); R = (st >> 1) * 16 + swz / 64; C = (st & 1) * 32 + (swz % 64) / 2; }
__device__ __forceinline__ int perm32(int rho) { const int n = rho >> 4, i = rho & 15; return 8 * (i >> 2) + 4 * n + (i & 3); }

struct Unit { int pm, pn; };
struct Gemm { const bf16_t* A; const bf16_t* Bt; int M, N, K; };

struct Order {
    int nM, nN, nwg, G, c, zn;
    __device__ void init(int M, int N, int G_, int c_, int zn_) { nM = M / BM; nN = N / BM; nwg = nM * nN; G = G_; c = c_; zn = zn_; }
    __device__ bool next(int i, Unit& u) const {
        const int ti = i / zn, z = i - ti * zn;
        const long L = (long)ti * G + c; if (L >= nwg) return false;
        int wgid = (int)L; { const int q = nwg / NXCD, r = nwg % NXCD, xcd = wgid % NXCD, off = wgid / NXCD; wgid = (xcd < r ? xcd * (q + 1) : r * (q + 1) + (xcd - r) * q) + off; }
        const int nig = WGM * nN, gid = wgid / nig, fm = gid * WGM, gsz = (nM - fm) < WGM ? (nM - fm) : WGM;
        u.pm = z * nM + fm + ((wgid % nig) % gsz); u.pn = z * nN + (wgid % nig) / gsz; return true;
    }
};

template <class Epi>
__device__ __forceinline__ void gemm_phase(LAS unsigned char* lds, const Gemm g, const Order& S, const Epi& E, const int tid) {
    const int wid = __builtin_amdgcn_readfirstlane(tid >> 6), lane = tid & 63, wr = wid >> 2, wc = wid & 3, fr = lane & 15, fq = lane >> 4;
    const int K = g.K, nt = K / BK;
    unsigned voffA[2], voffB[2];
#pragma unroll
    for (int i = 0; i < 2; ++i) { int R, C; stage_rc(tid * 16 + i * 8192, R, C); const int Rb = (R & ~31) + perm32(R & 31);
        voffA[i] = (unsigned)(R * K + C) * 2u; voffB[i] = (unsigned)(Rb * K + C) * 2u; }
    const size_t kstep = (size_t)(BK * 2);
    const size_t hstep = (size_t)HALF * K * 2;
    const size_t tstep = 2 * hstep;
    const unsigned ldsw = (unsigned)wid * 1024u;
    const int aoff = lds_byte(wr * 64 + fr, fq * 8), boff = lds_byte(wc * 32 + fr, fq * 8);
#define PG8_SA(b, h) (((b) * 2 + (h)) * HTB)
#define PG8_SB(b, h) ((4 + (b) * 2 + (h)) * HTB)
#define PG8_STAGE(bufoff, gbase, voff) do { _Pragma("unroll") for (int _i = 0; _i < 2; ++_i) \
        __builtin_amdgcn_global_load_lds((const unsigned*)((const char*)(gbase) + (voff)[_i]), (LAS unsigned*)(lds + (bufoff) + ldsw + _i * 8192), 16, 0, 0); } while (0)
#define PG8_LDA(dst, b, h) do { _Pragma("unroll") for (int m = 0; m < 4; ++m) _Pragma("unroll") for (int k = 0; k < 2; ++k) dst[m][k] = *(const LAS bf16x8*)(lds + PG8_SA(b, h) + aoff + m * 2048 + k * 1024); } while (0)
#define PG8_LDB(dst, b, h) do { _Pragma("unroll") for (int n = 0; n < 2; ++n) _Pragma("unroll") for (int k = 0; k < 2; ++k) dst[n][k] = *(const LAS bf16x8*)(lds + PG8_SB(b, h) + boff + n * 2048 + k * 1024); } while (0)
#define PG8_MMA(ai, bj, At, Bt) do { __builtin_amdgcn_s_setprio(1); _Pragma("unroll") for (int m = 0; m < 4; ++m) _Pragma("unroll") for (int n = 0; n < 2; ++n) _Pragma("unroll") for (int k = 0; k < 2; ++k) \
        acc[ai][bj][m][n] = __builtin_amdgcn_mfma_f32_16x16x32_bf16(Bt[n][k], At[m][k], acc[ai][bj][m][n], 0, 0, 0); __builtin_amdgcn_s_setprio(0); } while (0)
#define PG8_WAIT_V(n) asm volatile("s_waitcnt vmcnt(" #n ")" ::: "memory")
#define PG8_WAIT_L(n) asm volatile("s_waitcnt lgkmcnt(" #n ")" ::: "memory")
#define PG8_BAR __builtin_amdgcn_s_barrier()
#define PG8_SCHED __builtin_amdgcn_sched_barrier(0)
    Unit cur, nxt; int ui = 0;
    if (!S.next(0, cur)) return;
    f32x4 acc[2][2][4][2];
#pragma unroll
    for (int a = 0; a < 2; ++a)
#pragma unroll
        for (int b = 0; b < 2; ++b)
#pragma unroll
            for (int m = 0; m < 4; ++m)
#pragma unroll
                for (int n = 0; n < 2; ++n) acc[a][b][m][n] = (f32x4){0.f, 0.f, 0.f, 0.f};
    bf16x8 At[4][2], B0[2][2], B1[2][2];
    const char* cA = (const char*)g.A + (size_t)cur.pm * tstep; const char* cB = (const char*)g.Bt + (size_t)cur.pn * tstep;
    PG8_STAGE(PG8_SB(0, 0), cB, voffB); PG8_STAGE(PG8_SA(0, 0), cA, voffA); PG8_STAGE(PG8_SB(0, 1), cB + hstep, voffB); PG8_STAGE(PG8_SA(0, 1), cA + hstep, voffA);
    PG8_STAGE(PG8_SB(1, 0), cB + kstep, voffB); PG8_STAGE(PG8_SA(1, 0), cA + kstep, voffA); PG8_STAGE(PG8_SB(1, 1), cB + hstep + kstep, voffB);
    PG8_WAIT_V(6);
    if (wr == 1) PG8_BAR;
    PG8_BAR;
    for (;;) {
        const bool has_next = S.next(ui + 1, nxt);
        const char* nA = has_next ? (const char*)g.A + (size_t)nxt.pm * tstep : cA; const char* nB = has_next ? (const char*)g.Bt + (size_t)nxt.pn * tstep : cB;
        for (int t = 0; t < nt; t += 2) {
            const bool last = (t == nt - 2);
            const char* a1 = cA + (size_t)(t + 1) * kstep;
            const char* a2 = last ? nA : cA + (size_t)(t + 2) * kstep; const char* b2 = last ? nB : cB + (size_t)(t + 2) * kstep;
            const char* a3 = a2 + kstep; const char* b3 = b2 + kstep;
            PG8_LDB(B0, 0, 0); PG8_SCHED; PG8_LDA(At, 0, 0); PG8_STAGE(PG8_SA(1, 1), a1 + hstep, voffA);
            PG8_WAIT_L(8); PG8_BAR; PG8_WAIT_L(0); PG8_MMA(0, 0, At, B0); PG8_BAR; PG8_SCHED;
            PG8_LDB(B1, 0, 1); PG8_STAGE(PG8_SB(0, 0), b2, voffB);
            PG8_BAR; PG8_WAIT_L(0); PG8_MMA(0, 1, At, B1); PG8_BAR;
            PG8_LDA(At, 0, 1); PG8_STAGE(PG8_SA(0, 0), a2, voffA);
            PG8_BAR; PG8_WAIT_L(0); PG8_MMA(1, 0, At, B0); PG8_BAR; PG8_SCHED;
            PG8_STAGE(PG8_SB(0, 1), b2 + hstep, voffB);
            PG8_WAIT_V(6); PG8_BAR; PG8_MMA(1, 1, At, B1); PG8_BAR;
            PG8_LDB(B0, 1, 0); PG8_SCHED; PG8_LDA(At, 1, 0); PG8_STAGE(PG8_SA(0, 1), a2 + hstep, voffA);
            PG8_WAIT_L(8); PG8_BAR; PG8_WAIT_L(0); PG8_MMA(0, 0, At, B0); PG8_BAR; PG8_SCHED;
            PG8_LDB(B1, 1, 1); PG8_STAGE(PG8_SB(1, 0), b3, voffB);
            PG8_BAR; PG8_WAIT_L(0); PG8_MMA(0, 1, At, B1); PG8_BAR;
            PG8_LDA(At, 1, 1); PG8_STAGE(PG8_SA(1, 0), a3, voffA);
            PG8_BAR; PG8_WAIT_L(0); PG8_MMA(1, 0, At, B0); PG8_BAR; PG8_SCHED;
            PG8_STAGE(PG8_SB(1, 1), b3 + hstep, voffB);
            PG8_WAIT_V(6); PG8_BAR; PG8_MMA(1, 1, At, B1); PG8_BAR;
        }
        bool zero_acc = true;
        if constexpr (Epi::CHAIN) zero_acc = E.chain(acc, cur, wr, wc, fr, fq);
        else E(acc, cur, wr, wc, fr, fq);
        if (!has_next) break;
        if (zero_acc)
#pragma unroll
        for (int a = 0; a < 2; ++a)
#pragma unroll
            for (int b = 0; b < 2; ++b)
#pragma unroll
                for (int m = 0; m < 4; ++m)
#pragma unroll
                    for (int n = 0; n < 2; ++n) acc[a][b][m][n] = (f32x4){0.f, 0.f, 0.f, 0.f};
        cur = nxt; cA = nA; cB = nB; ++ui;
    }
    PG8_WAIT_V(0);
    if (wr == 0) PG8_BAR;
    PG8_BAR;
#undef PG8_SA
#undef PG8_SB
#undef PG8_STAGE
#undef PG8_LDA
#undef PG8_LDB
#undef PG8_MMA
#undef PG8_WAIT_V
#undef PG8_WAIT_L
#undef PG8_BAR
#undef PG8_SCHED
}

typedef f32x4 Acc[2][2][4][2];
template <int ACT, int LDC> __device__ __forceinline__ void glu_store(const Acc& acc, char* ub, unsigned lane_off) {
#pragma unroll
    for (int ai = 0; ai < 2; ++ai)
#pragma unroll
        for (int m = 0; m < 4; ++m) {
            char* rp = ub + (size_t)(ai * HALF + m * 16) * LDC * 2;
            f32x4 v[2];
#pragma unroll
            for (int n = 0; n < 2; ++n) { const f32x4 a = acc[ai][0][m][n], b = acc[ai][1][m][n];
                if (ACT == 0) v[n] = a * sigmoid4(a) * b; else v[n] = a * sigmoid4(b); }
            *(u32x4*)(rp + lane_off) = pack8(v[0], v[1]);
        }
}
template <int LDC> __device__ __forceinline__ unsigned lane_off_of(int wr, int wc, int fr, int fq) { return (unsigned)((wr * 64 + fr) * LDC + wc * 32 + 8 * fq) * 2u; }
struct EpiGLU {
    static constexpr bool CHAIN = false;
    bf16_t* O;
    __device__ __forceinline__ void operator()(const Acc& acc, const Unit& u, int wr, int wc, int fr, int fq) const {
        glu_store<0, DFF>(acc, (char*)O + ((size_t)u.pm * BM * DFF + (size_t)u.pn * 128) * 2, lane_off_of<DFF>(wr, wc, fr, fq));
    }
};
template <int ACT, int LDC> __device__ __forceinline__ void plain_store(const Acc& acc, char* ub, unsigned lane_off) {
#pragma unroll
    for (int ai = 0; ai < 2; ++ai)
#pragma unroll
        for (int m = 0; m < 4; ++m) {
            char* rp = ub + (size_t)(ai * HALF + m * 16) * LDC * 2;
#pragma unroll
            for (int bj = 0; bj < 2; ++bj) { f32x4 v0 = acc[ai][bj][m][0], v1 = acc[ai][bj][m][1];
                if (ACT == 1) { v0 = gelu4(v0); v1 = gelu4(v1); }
                if (ACT == 2) { v0 = sigmoid4(v0); v1 = sigmoid4(v1); }
                *(u32x4*)(rp + bj * HALF * 2 + lane_off) = pack8(v0, v1); }
        }
}
struct EpiStore {
    static constexpr bool CHAIN = false;
    bf16_t* O;
    __device__ __forceinline__ void operator()(const Acc& acc, const Unit& u, int wr, int wc, int fr, int fq) const {
        plain_store<0, DM>(acc, (char*)O + ((size_t)u.pm * BM * DM + (size_t)u.pn * BM) * 2, lane_off_of<DM>(wr, wc, fr, fq));
    }
};
struct EpiIn {
    static constexpr bool CHAIN = false;
    bf16_t *ZP, *U, *V, *XG, *GATES;
    __device__ __forceinline__ void operator()(const Acc& acc, const Unit& u, int wr, int wc, int fr, int fq) const {
        const int pn = u.pn; const size_t rb = (size_t)u.pm * BM;
        if (pn >= 10) {
            char* ub = (char*)GATES + rb * 3072 + (size_t)(pn - 10) * 256; const unsigned lo = (unsigned)((wr * 64 + fr) * 3072 + wc * 32 + 8 * fq);
#pragma unroll
            for (int ai = 0; ai < 2; ++ai)
#pragma unroll
                for (int m = 0; m < 4; ++m)
#pragma unroll
                    for (int bj = 0; bj < 2; ++bj) {
                        const f32x4 v0 = sigmoid4(acc[ai][bj][m][0]) * 255.0f, v1 = sigmoid4(acc[ai][bj][m][1]) * 255.0f;
                        u32x2 w; w.x = 0u; w.y = 0u;
                        w.x = __builtin_amdgcn_cvt_pk_u8_f32(v0[0], 0, w.x); w.x = __builtin_amdgcn_cvt_pk_u8_f32(v0[1], 1, w.x); w.x = __builtin_amdgcn_cvt_pk_u8_f32(v0[2], 2, w.x); w.x = __builtin_amdgcn_cvt_pk_u8_f32(v0[3], 3, w.x);
                        w.y = __builtin_amdgcn_cvt_pk_u8_f32(v1[0], 0, w.y); w.y = __builtin_amdgcn_cvt_pk_u8_f32(v1[1], 1, w.y); w.y = __builtin_amdgcn_cvt_pk_u8_f32(v1[2], 2, w.y); w.y = __builtin_amdgcn_cvt_pk_u8_f32(v1[3], 3, w.y);
                        *(u32x2*)(ub + (size_t)(ai * HALF + m * 16) * 3072 + bj * HALF + lo) = w;
                    }
        }
        else {
            const unsigned lo = lane_off_of<512>(wr, wc, fr, fq);
            if (pn >= 6) glu_store<1, 512>(acc, (char*)XG + (rb * 512 + (size_t)(pn - 6) * 128) * 2, lo);
            else if (pn < 2) plain_store<0, 512>(acc, (char*)ZP + (rb * 512 + (size_t)pn * 256) * 2, lo);
            else { char* ub = (char*)(pn < 4 ? U : V) + (rb * 512 + (size_t)(pn & 1) * 256) * 2; plain_store<1, 512>(acc, ub, lo); }
        }
    }
};
struct EpiBranch {
    static constexpr bool CHAIN = true;
    const unsigned char* GATES; bf16_t* MG;
    static __device__ __forceinline__ f32x4 code4(unsigned w) { return (f32x4){__builtin_fmaxf((float)(w & 255u), 0.25f), __builtin_fmaxf((float)((w >> 8) & 255u), 0.25f), __builtin_fmaxf((float)((w >> 16) & 255u), 0.25f), __builtin_fmaxf((float)(w >> 24), 0.25f)}; }
    static __device__ __forceinline__ f32x4 rcp4(f32x4 v) { return (f32x4){__builtin_amdgcn_rcpf(v[0]), __builtin_amdgcn_rcpf(v[1]), __builtin_amdgcn_rcpf(v[2]), __builtin_amdgcn_rcpf(v[3])}; }
    __device__ __forceinline__ bool chain(Acc& acc, const Unit& u, int wr, int wc, int fr, int fq) const {
        const int z = u.pn >> 2, pn = u.pn & 3, pm = u.pm - z * 128;
        const bool fin = (z == 2);
        const char* gb = (const char*)GATES + (size_t)pm * BM * 3072 + (size_t)z * 1024 + (size_t)pn * BM;
        const char* gn = fin ? gb : gb + 1024;
        const unsigned glo = (unsigned)((wr * 64 + fr) * 3072 + wc * 32 + 8 * fq);
        char* mb = (char*)MG + ((size_t)pm * BM * DM + (size_t)pn * BM) * 2;
        const unsigned mlo = lane_off_of<DM>(wr, wc, fr, fq);
        constexpr float q = 1.0f / 255.0f;
        u32x2 g0[2][4][2], g1[2][4][2];
#pragma unroll
        for (int ai = 0; ai < 2; ++ai)
#pragma unroll
            for (int m = 0; m < 4; ++m)
#pragma unroll
                for (int bj = 0; bj < 2; ++bj) {
                    g0[ai][m][bj] = *(const u32x2*)(gb + (size_t)(ai * HALF + m * 16) * 3072 + bj * HALF + glo);
                    g1[ai][m][bj] = *(const u32x2*)(gn + (size_t)(ai * HALF + m * 16) * 3072 + bj * HALF + glo);
                }
#pragma unroll
        for (int ai = 0; ai < 2; ++ai)
#pragma unroll
            for (int m = 0; m < 4; ++m)
#pragma unroll
                for (int bj = 0; bj < 2; ++bj) {
                    const f32x4 d0 = rcp4(code4(g1[ai][m][bj].x)), d1 = rcp4(code4(g1[ai][m][bj].y));
                    acc[ai][bj][m][0] *= code4(g0[ai][m][bj].x) * (fin ? (f32x4){q, q, q, q} : d0);
                    acc[ai][bj][m][1] *= code4(g0[ai][m][bj].y) * (fin ? (f32x4){q, q, q, q} : d1);
                    if (fin) *(u32x4*)(mb + (size_t)(ai * HALF + m * 16) * DM * 2 + bj * HALF * 2 + mlo) = pack8(acc[ai][bj][m][0], acc[ai][bj][m][1]);
                }
        return fin;
    }
};
struct EpiPle {
    static constexpr bool CHAIN = false;
    const bf16_t* E; bf16_t* O;
    __device__ __forceinline__ void operator()(const Acc& acc, const Unit& u, int wr, int wc, int fr, int fq) const {
        const size_t uo = ((size_t)u.pm * BM * DM + (size_t)u.pn * BM) * 2;
        const char* eb = (const char*)E + uo; char* ob = (char*)O + uo;
        const unsigned lo = lane_off_of<DM>(wr, wc, fr, fq);
        u32x4 ew[2][4][2];
#pragma unroll
        for (int ai = 0; ai < 2; ++ai)
#pragma unroll
            for (int m = 0; m < 4; ++m)
#pragma unroll
                for (int bj = 0; bj < 2; ++bj) ew[ai][m][bj] = *(const u32x4*)(eb + (size_t)(ai * HALF + m * 16) * DM * 2 + bj * HALF * 2 + lo);
#pragma unroll
        for (int ai = 0; ai < 2; ++ai)
#pragma unroll
            for (int m = 0; m < 4; ++m)
#pragma unroll
                for (int bj = 0; bj < 2; ++bj) {
                    const f32x4 v0 = sigmoid4(acc[ai][bj][m][0]) * unpack_lo4(ew[ai][m][bj]), v1 = sigmoid4(acc[ai][bj][m][1]) * unpack_hi4(ew[ai][m][bj]);
                    *(u32x4*)(ob + (size_t)(ai * HALF + m * 16) * DM * 2 + bj * HALF * 2 + lo) = pack8(v0, v1);
                }
    }
};
}

template <bool INIT>
__device__ __forceinline__ void row_phase(const float* hin, float* h, const bf16_t* F, float cscale, const float* ga, const float* gb, bf16_t* HN, bool write_hn, const int tid, const int bid) {
    const int wid = tid >> 6, lane = tid & 63;
    constexpr int R = 4;
    f32x4 gav[4], gbv[4];
#pragma unroll
    for (int k = 0; k < 4; ++k) {
        gav[k] = INIT ? (f32x4){0.f, 0.f, 0.f, 0.f} : *(const f32x4*)(ga + 256 * k + 4 * lane);
        gbv[k] = write_hn ? *(const f32x4*)(gb + 256 * k + 4 * lane) : (f32x4){0.f, 0.f, 0.f, 0.f};
    }
    for (int row0 = (bid * 8 + wid) * R; row0 < MTOK; row0 += gridDim.x * 8 * R) {
        f32x4 hv[R][4]; u32x2 fw[R][4];
#pragma unroll
        for (int r = 0; r < R; ++r) { const size_t ro = (size_t)(row0 + r) * DM + 4 * lane;
#pragma unroll
            for (int k = 0; k < 4; ++k) {
                hv[r][k] = *(const f32x4*)(hin + ro + 256 * k);
                if (!INIT) fw[r][k] = *(const u32x2*)(F + ro + 256 * k);
            } }
#pragma unroll
        for (int r = 0; r < R; ++r) { const size_t ro = (size_t)(row0 + r) * DM + 4 * lane;
            if (!INIT) {
                f32x4 fv[4];
#pragma unroll
                for (int k = 0; k < 4; ++k) fv[k] = (f32x4){bf_lo(fw[r][k].x), bf_hi(fw[r][k].x), bf_lo(fw[r][k].y), bf_hi(fw[r][k].y)};
                float ss = 0.f;
#pragma unroll
                for (int i = 0; i < 4; ++i) ss += fv[i][0] * fv[i][0] + fv[i][1] * fv[i][1] + fv[i][2] * fv[i][2] + fv[i][3] * fv[i][3];
                ss = wave_sum(ss);
                const float rs = cscale * __builtin_amdgcn_rsqf(ss * (1.0f / DM) + EPS);
#pragma unroll
                for (int i = 0; i < 4; ++i) hv[r][i] += fv[i] * gav[i] * rs;
            }
            float s2 = 0.f;
#pragma unroll
            for (int i = 0; i < 4; ++i) s2 += hv[r][i][0] * hv[r][i][0] + hv[r][i][1] * hv[r][i][1] + hv[r][i][2] * hv[r][i][2] + hv[r][i][3] * hv[r][i][3];
            s2 = wave_sum(s2);
            const float rs2 = __builtin_amdgcn_rsqf(s2 * (1.0f / DM) + EPS);
            if (!INIT) { _Pragma("unroll") for (int k = 0; k < 4; ++k) *(f32x4*)(h + ro + 256 * k) = hv[r][k]; }
            if (write_hn) {
#pragma unroll
                for (int k = 0; k < 4; ++k) { const f32x4 o = hv[r][k] * gbv[k] * rs2; u32x2 w; w.x = cvt_pk_bf16(o[0], o[1]); w.y = cvt_pk_bf16(o[2], o[3]); *(u32x2*)(HN + ro + 256 * k) = w; }
            }
        }
    }
}

__device__ __forceinline__ f32x4 bf4(u32x2 w) { return (f32x4){bf_lo(w.x), bf_hi(w.x), bf_lo(w.y), bf_hi(w.y)}; }
__device__ __forceinline__ float sumsq16(const f32x4 (&v)[4]) { float s = 0.f;
#pragma unroll
    for (int i = 0; i < 4; ++i) s += v[i][0] * v[i][0] + v[i][1] * v[i][1] + v[i][2] * v[i][2] + v[i][3] * v[i][3];
    return s; }
template <bool FULL>
__device__ __forceinline__ void row_phase2(const float* hin, float* h, const bf16_t* F1, float c1, const float* ga1, const bf16_t* F2, float c2, const float* ga2, const float* gb, bf16_t* HN, bool write_hn, const int tid, const int bid) {
    const int wid = tid >> 6, lane = tid & 63;
    constexpr int R = 2;
    f32x4 g1v[4], g2v[4], gbv[4];
#pragma unroll
    for (int k = 0; k < 4; ++k) {
        g1v[k] = *(const f32x4*)(ga1 + 256 * k + 4 * lane);
        g2v[k] = FULL ? *(const f32x4*)(ga2 + 256 * k + 4 * lane) : (f32x4){0.f, 0.f, 0.f, 0.f};
        gbv[k] = write_hn ? *(const f32x4*)(gb + 256 * k + 4 * lane) : (f32x4){0.f, 0.f, 0.f, 0.f};
    }
    f32x4 hv[R][4], hn_[R][4]; u32x2 fa[R][4], fan[R][4], fb[R][4], fbn[R][4];
#define ROW_LOAD(HV, FA, FB, ROW0) do { _Pragma("unroll") for (int r = 0; r < R; ++r) { const size_t ro_ = (size_t)((ROW0) + r) * DM + 4 * lane; \
        _Pragma("unroll") for (int k = 0; k < 4; ++k) { HV[r][k] = *(const f32x4*)(hin + ro_ + 256 * k); FA[r][k] = *(const u32x2*)(F1 + ro_ + 256 * k); if (FULL) FB[r][k] = *(const u32x2*)(F2 + ro_ + 256 * k); } } } while (0)
    const int stride = (int)gridDim.x * 8 * R;
    int row0 = (bid * 8 + wid) * R;
    if (row0 < MTOK) ROW_LOAD(hv, fa, fb, row0);
    for (; row0 < MTOK; row0 += stride) {
        const bool more = row0 + stride < MTOK;
        if (more) ROW_LOAD(hn_, fan, fbn, row0 + stride);
#pragma unroll
        for (int r = 0; r < R; ++r) { const size_t ro = (size_t)(row0 + r) * DM + 4 * lane;
            {
                f32x4 fv[4];
#pragma unroll
                for (int k = 0; k < 4; ++k) fv[k] = bf4(fa[r][k]);
                const float rs = c1 * __builtin_amdgcn_rsqf(wave_sum(sumsq16(fv)) * (1.0f / DM) + EPS);
#pragma unroll
                for (int i = 0; i < 4; ++i) hv[r][i] += fv[i] * g1v[i] * rs;
            }
            if (FULL) {
                f32x4 fv[4];
#pragma unroll
                for (int k = 0; k < 4; ++k) fv[k] = bf4(fb[r][k]);
                const float rs = c2 * __builtin_amdgcn_rsqf(wave_sum(sumsq16(fv)) * (1.0f / DM) + EPS);
#pragma unroll
                for (int i = 0; i < 4; ++i) hv[r][i] += fv[i] * g2v[i] * rs;
#pragma unroll
                for (int k = 0; k < 4; ++k) *(f32x4*)(h + ro + 256 * k) = hv[r][k];
            }
            if (write_hn) {
                const float rs2 = __builtin_amdgcn_rsqf(wave_sum(sumsq16(hv[r])) * (1.0f / DM) + EPS);
#pragma unroll
                for (int k = 0; k < 4; ++k) { const f32x4 o = hv[r][k] * gbv[k] * rs2; u32x2 w; w.x = cvt_pk_bf16(o[0], o[1]); w.y = cvt_pk_bf16(o[2], o[3]); *(u32x2*)(HN + ro + 256 * k) = w; }
            }
        }
        if (more) {
#pragma unroll
            for (int r = 0; r < R; ++r)
#pragma unroll
                for (int k = 0; k < 4; ++k) { hv[r][k] = hn_[r][k]; fa[r][k] = fan[r][k]; if (FULL) fb[r][k] = fbn[r][k]; }
        }
    }
#undef ROW_LOAD
}

struct PrepJob { const float* src; bf16_t* dst; int ld, col0, k0, K, n0; };
__device__ __forceinline__ PrepJob prep_job(const Params& P, unsigned char* ws, int l, int tix) {
    constexpr int T_GU = (NGU / 64) * (DM / 64), T_D = (DM / 64) * (DFF / 64), T_IN = (NIN / 64) * (DM / 64), T_BR = (DM / 64) * (512 / 64), T_SQ = (DM / 64) * (DM / 64);
    int t = tix; const float* srcA; const float* srcB; int ld, mode, K; bf16_t* dst;
    if (t < T_GU) { srcA = PIN(3) + (size_t)l * DM * DFF; srcB = PIN(4) + (size_t)l * DM * DFF; ld = DFF; mode = 1; K = DM; dst = (bf16_t*)(ws + WS_WGU1); }
    else if ((t -= T_GU) < T_GU) { srcA = PIN(25) + (size_t)l * DM * DFF; srcB = PIN(26) + (size_t)l * DM * DFF; ld = DFF; mode = 1; K = DM; dst = (bf16_t*)(ws + WS_WGU2); }
    else if ((t -= T_GU) < T_D) { srcA = PIN(5) + (size_t)l * DFF * DM; srcB = srcA; ld = DM; mode = 0; K = DFF; dst = (bf16_t*)(ws + WS_WD1); }
    else if ((t -= T_D) < T_D) { srcA = PIN(27) + (size_t)l * DFF * DM; srcB = srcA; ld = DM; mode = 0; K = DFF; dst = (bf16_t*)(ws + WS_WD2); }
    else if ((t -= T_D) < T_IN) { srcA = PIN(8) + (size_t)l * DM * NIN; srcB = srcA; ld = NIN; mode = 2; K = DM; dst = (bf16_t*)(ws + WS_WIN); }
    else if ((t -= T_IN) < T_BR) { srcA = PIN(16) + (size_t)l * 512 * DM; srcB = srcA; ld = DM; mode = 0; K = 512; dst = (bf16_t*)(ws + WS_WBR) + (size_t)1 * DM * 512; }
    else if ((t -= T_BR) < T_BR) { srcA = PIN(21) + (size_t)l * 512 * DM; srcB = srcA; ld = DM; mode = 0; K = 512; dst = (bf16_t*)(ws + WS_WBR) + (size_t)2 * DM * 512; }
    else if ((t -= T_BR) < T_SQ) { srcA = PIN(22) + (size_t)l * DM * DM; srcB = srcA; ld = DM; mode = 0; K = DM; dst = (bf16_t*)(ws + WS_WOUT); }
    else if ((t -= T_SQ) < T_SQ) { srcA = PIN(31) + (size_t)l * DM * DM; srcB = srcA; ld = DM; mode = 0; K = DM; dst = (bf16_t*)(ws + WS_WPG); }
    else { t -= T_SQ; srcA = PIN(29) + (size_t)l * PLE * DM; srcB = srcA; ld = DM; mode = 0; K = PLE; dst = (bf16_t*)(ws + WS_WPP); }
    const int tk = K / 64, tn = t / tk, tkk = t - tn * tk, n0 = tn * 64, k0 = tkk * 64;
    const float* src = srcA; int col0 = n0;
    if (mode == 1) { const int tt = n0 >> 8, j = n0 & 255; if (j < 128) { col0 = 128 * tt + j; } else { src = srcB; col0 = 128 * tt + j - 128; } }
    else if (mode == 2) { if (n0 >= 1536 && n0 < 2560) { const int tt = (n0 - 1536) >> 8, j = (n0 - 1536) & 255; col0 = (j < 128) ? (1536 + 128 * tt + j) : (2048 + 128 * tt + j - 128); } }
    PrepJob J; J.src = src; J.dst = dst; J.ld = ld; J.col0 = col0; J.k0 = k0; J.K = K; J.n0 = n0; return J;
}

__device__ __forceinline__ void prep_weights(const Params& P, unsigned char* ws, int l, LAS unsigned char* lds, const int tid, const int bid) {
    LAS float* tile = (LAS float*)lds;
    constexpr int T_GU = (NGU / 64) * (DM / 64), T_D = (DM / 64) * (DFF / 64), T_IN = (NIN / 64) * (DM / 64), T_BR = (DM / 64) * (512 / 64), T_SQ = (DM / 64) * (DM / 64), T_PP = (DM / 64) * (PLE / 64);
    constexpr int TOTAL = 2 * T_GU + 2 * T_D + T_IN + 2 * T_BR + 2 * T_SQ + T_PP;
    {
        const int kk = tid >> 4, c4 = tid & 15, n = tid >> 3, k8 = tid & 7;
        f32x4 v0, v1; int tix = bid;
        if (tix < TOTAL) { const PrepJob J = prep_job(P, ws, l, tix); const float* sp = J.src + (size_t)(J.k0 + kk) * J.ld + J.col0 + 4 * c4; v0 = *(const f32x4*)sp; v1 = *(const f32x4*)(sp + (size_t)32 * J.ld); }
        for (; tix < TOTAL; tix += gridDim.x) {
            const PrepJob J = prep_job(P, ws, l, tix);
#pragma unroll
            for (int e = 0; e < 4; ++e) { tile[kk * 65 + 4 * c4 + e] = v0[e]; tile[(kk + 32) * 65 + 4 * c4 + e] = v1[e]; }
            __syncthreads();
            const int nx = tix + gridDim.x;
            if (nx < TOTAL) { const PrepJob Jn = prep_job(P, ws, l, nx); const float* sp = Jn.src + (size_t)(Jn.k0 + kk) * Jn.ld + Jn.col0 + 4 * c4; v0 = *(const f32x4*)sp; v1 = *(const f32x4*)(sp + (size_t)32 * Jn.ld); }
            float v[8];
#pragma unroll
            for (int i = 0; i < 8; ++i) v[i] = tile[(8 * k8 + i) * 65 + n];
            u32x4 w; w.x = cvt_pk_bf16(v[0], v[1]); w.y = cvt_pk_bf16(v[2], v[3]); w.z = cvt_pk_bf16(v[4], v[5]); w.w = cvt_pk_bf16(v[6], v[7]);
            *(u32x4*)(J.dst + (size_t)(J.n0 + n) * J.K + J.k0 + 8 * k8) = w;
            __syncthreads();
        }
    }
    {
        const float* pw = PIN(9) + (size_t)l * 4 * 128 * 128; const float* sc = PIN(10) + (size_t)l * 512; const float* wpo = PIN(11) + (size_t)l * 512 * DM;
        bf16_t* dst = (bf16_t*)(ws + WS_WBR);
        const int ol = tid & 63, i4 = __builtin_amdgcn_readfirstlane(tid >> 6);
        for (int tix = bid; tix < 16 * 16; tix += gridDim.x) {
            const int o = (tix >> 4) * 64 + ol, g = (tix >> 2) & 3, i0 = (tix & 3) * 32 + i4 * 4;
            float a[4] = {0.f, 0.f, 0.f, 0.f};
#pragma unroll 4
            for (int j = 0; j < 128; j += 4) {
                const f32x4 s4 = *(const f32x4*)(sc + g * 128 + j);
                float w[4];
#pragma unroll
                for (int jj = 0; jj < 4; ++jj) w[jj] = wpo[(size_t)(g * 128 + j + jj) * DM + o] * s4[jj];
#pragma unroll
                for (int ii = 0; ii < 4; ++ii) { const f32x4 p4 = *(const f32x4*)(pw + (size_t)(g * 128 + i0 + ii) * 128 + j);
                    a[ii] += p4[0] * w[0] + p4[1] * w[1] + p4[2] * w[2] + p4[3] * w[3]; }
            }
            u32x2 w2; w2.x = cvt_pk_bf16(a[0], a[1]); w2.y = cvt_pk_bf16(a[2], a[3]);
            *(u32x2*)(dst + (size_t)o * 512 + g * 128 + i0) = w2;
        }
    }
    {
        const float* wsrc = PIN(14) + (size_t)l * 4 * 128 * 128; bf16_t* dst = (bf16_t*)(ws + WS_WSPK);
        for (int idx = bid * 512 + tid; idx < 4 * 128 * 128 / 8; idx += gridDim.x * 512) {
            const int fq = idx & 3, kk = (idx >> 2) & 3, t = (idx >> 4) & 127, h = idx >> 11;
            float v[8];
#pragma unroll
            for (int i = 0; i < 8; ++i) { const int sp = 32 * kk + 4 * i + fq; v[i] = (sp <= t) ? wsrc[(size_t)(h * 128 + t) * 128 + sp] : 0.f; }
            u32x4 w4; w4.x = cvt_pk_bf16(v[0], v[1]); w4.y = cvt_pk_bf16(v[2], v[3]); w4.z = cvt_pk_bf16(v[4], v[5]); w4.w = cvt_pk_bf16(v[6], v[7]);
            *(u32x4*)(dst + (size_t)idx * 8) = w4;
        }
    }
}

__device__ __forceinline__ void convert_p(const float* p, bf16_t* PB, const int tid, const int bid) {
    for (size_t idx = (size_t)bid * 512 + tid; idx < (size_t)MTOK * PLE / 8; idx += (size_t)gridDim.x * 512) {
        const f32x4 a = *(const f32x4*)(p + idx * 8), b = *(const f32x4*)(p + idx * 8 + 4);
        *(u32x4*)(PB + idx * 8) = pack8(a, b);
    }
}

template <int W>
__device__ __forceinline__ void pool_run(const bf16_t* ZP, bf16_t* XP, const int oct, const int sub, const int bid) {
    for (int it = bid; it < MTOK / 32; it += gridDim.x) {
        const int tok0 = it * 32 + 4 * sub, t0 = tok0 & (SEQ - 1);
        const bf16_t* zp = ZP + (size_t)tok0 * 512 + 8 * oct;
        u32x4 row[W + 3];
#pragma unroll
        for (int j = 0; j < W + 3; ++j) { row[j] = (u32x4){0u, 0u, 0u, 0u}; if (t0 + 3 - j >= 0) row[j] = *(const u32x4*)(zp + (ptrdiff_t)(3 - j) * 512); }
        f32x4 s0 = (f32x4){0.f, 0.f, 0.f, 0.f}, s1 = s0;
#pragma unroll
        for (int j = 0; j < W; ++j) { s0 += unpack_lo4(row[j]); s1 += unpack_hi4(row[j]); }
        f32x4 o0[4], o1[4]; o0[3] = s0; o1[3] = s1;
#pragma unroll
        for (int d = 0; d < 3; ++d) { s0 += unpack_lo4(row[W + d]) - unpack_lo4(row[d]); s1 += unpack_hi4(row[W + d]) - unpack_hi4(row[d]); o0[2 - d] = s0; o1[2 - d] = s1; }
#pragma unroll
        for (int u = 0; u < 4; ++u) { const int t = t0 + u; const float inv = 1.0f / (float)((t + 1) < W ? (t + 1) : W);
            *(u32x4*)(XP + (size_t)(tok0 + u) * 512 + 8 * oct) = pack8(o0[u] * inv - unpack_lo4(row[3 - u]), o1[u] * inv - unpack_hi4(row[3 - u])); }
    }
}

__device__ __forceinline__ void mixer_phase(const Params& P, unsigned char* ws, int l, LAS unsigned char* lds, const int tid, const int bid) {
    unsigned char* big = ws + WS_BIG;
    const bf16_t* ZP = (const bf16_t*)(big + BIG_ZP); const bf16_t* U = (const bf16_t*)(big + BIG_U); const bf16_t* V = (const bf16_t*)(big + BIG_V); const bf16_t* XG = (const bf16_t*)(big + BIG_XG);
    bf16_t* X3 = (bf16_t*)(big + BIG_X3);
    const int wid = __builtin_amdgcn_readfirstlane(tid >> 6), lane = tid & 63;

    {
        const float* lng = PIN(12) + (size_t)l * 512; const float* lnb = PIN(13) + (size_t)l * 512; const float* bsp = PIN(15) + (size_t)l * 4 * 128;
        const bf16_t* WSPK = (const bf16_t*)(ws + WS_WSPK);
        bf16_t* XS = X3 + (size_t)1 * MTOK * 512;
        const int fr = lane & 15, fq = lane >> 4, h = wid >> 1, th = wid & 1;
        constexpr int VP = 528;
        for (int ch = bid; ch < MTOK / 128; ch += gridDim.x) {
            const size_t tok0 = (size_t)ch * 128;
            {
                const f32x4 g0 = *(const f32x4*)(lng + 8 * lane), g1 = *(const f32x4*)(lng + 8 * lane + 4), b0 = *(const f32x4*)(lnb + 8 * lane), b1 = *(const f32x4*)(lnb + 8 * lane + 4);
#pragma unroll
                for (int i0 = 0; i0 < 16; i0 += 8) {
                    u32x4 wv[8];
#pragma unroll
                    for (int i = 0; i < 8; ++i) wv[i] = *(const u32x4*)(V + (tok0 + wid * 16 + i0 + i) * 512 + 8 * lane);
#pragma unroll
                    for (int i = 0; i < 8; ++i) {
                        const int sp = wid * 16 + i0 + i;
                        f32x4 x0 = unpack_lo4(wv[i]), x1 = unpack_hi4(wv[i]);
                        float s = (x0[0] + x0[1]) + (x0[2] + x0[3]) + (x1[0] + x1[1]) + (x1[2] + x1[3]);
                        s = wave_sum(s); const float mu = s * (1.0f / 512.0f);
                        x0 -= mu; x1 -= mu;
                        float q = x0[0] * x0[0] + x0[1] * x0[1] + x0[2] * x0[2] + x0[3] * x0[3] + x1[0] * x1[0] + x1[1] * x1[1] + x1[2] * x1[2] + x1[3] * x1[3];
                        q = wave_sum(q); const float rs = __builtin_amdgcn_rsqf(q * (1.0f / 512.0f) + EPS);
                        x0 = x0 * rs * g0 + b0; x1 = x1 * rs * g1 + b1;
                        *(LAS u32x4*)(lds + (size_t)sp * (VP * 2) + 16 * lane) = pack8(x0, x1);
                    }
                }
            }
            __syncthreads();
            {
                bf16x8 Wf[4][4]; float bs[4];
#pragma unroll
                for (int m = 0; m < 4; ++m) { const int t = 64 * th + 16 * m + fr; bs[m] = bsp[h * 128 + t];
#pragma unroll
                    for (int kk = 0; kk < 4; ++kk) Wf[m][kk] = *(const bf16x8*)(WSPK + ((size_t)((h * 128 + t) * 4 + kk) * 4 + fq) * 8); }
                const size_t ubase = (tok0 + 64 * th + fr) * 512 + 128 * h + 4 * fq;
                u32x2 uw[2][4];
#pragma unroll
                for (int m = 0; m < 4; ++m) uw[0][m] = *(const u32x2*)(U + ubase + (size_t)(16 * m) * 512);
#pragma unroll
                for (int n = 0; n < 8; ++n) {
                    if (n + 1 < 8) {
#pragma unroll
                        for (int m = 0; m < 4; ++m) uw[(n + 1) & 1][m] = *(const u32x2*)(U + ubase + (size_t)(16 * m) * 512 + 16 * (n + 1));
                    }
                    f32x4 acc[4];
#pragma unroll
                    for (int m = 0; m < 4; ++m) acc[m] = (f32x4){0.f, 0.f, 0.f, 0.f};
#pragma unroll
                    for (int kk = 0; kk < 4; ++kk) {
                        bf16x8 X;
#pragma unroll
                        for (int i = 0; i < 8; ++i) X[i] = *(const LAS short*)(lds + (size_t)(32 * kk + 4 * i + fq) * (VP * 2) + 2 * (128 * h + 16 * n + fr));
#pragma unroll
                        for (int m = 0; m < 4; ++m) acc[m] = __builtin_amdgcn_mfma_f32_16x16x32_bf16(X, Wf[m][kk], acc[m], 0, 0, 0);
                    }
#pragma unroll
                    for (int m = 0; m < 4; ++m) {
                        const u32x2 u2 = uw[n & 1][m];
                        const f32x4 sv = acc[m] + bs[m];
                        u32x2 o; o.x = cvt_pk_bf16(bf_lo(u2.x) * sv[0], bf_hi(u2.x) * sv[1]); o.y = cvt_pk_bf16(bf_lo(u2.y) * sv[2], bf_hi(u2.y) * sv[3]);
                        *(u32x2*)(XS + ubase + (size_t)(16 * m) * 512 + 16 * n) = o;
                    }
                }
            }
            __syncthreads();
        }
    }

    {
        const float* dwk = PIN(17) + (size_t)l * 31 * 512; const float* dwb = PIN(18) + (size_t)l * 512; const float* lng = PIN(19) + (size_t)l * 512; const float* lnb = PIN(20) + (size_t)l * 512;
        bf16_t* XC = X3 + (size_t)2 * MTOK * 512;
        LAS unsigned char* xs = lds;
        LAS float* ys = (LAS float*)(lds + 65536);
        const int cp = tid & 255, hbq = __builtin_amdgcn_readfirstlane(tid >> 8);
        f32x2 wk[31];
#pragma unroll
        for (int k = 0; k < 31; ++k) wk[k] = *(const f32x2*)(dwk + k * 512 + 2 * cp);
        const f32x2 bias = *(const f32x2*)(dwb + 2 * cp);
        const f32x4 g0 = *(const f32x4*)(lng + 8 * lane), g1 = *(const f32x4*)(lng + 8 * lane + 4), b0 = *(const f32x4*)(lnb + 8 * lane), b1 = *(const f32x4*)(lnb + 8 * lane + 4);
        u32x4 pre[8];
#define CONV_LOAD(ct_) do { const int tok0_ = (ct_) * 32, t0_ = tok0_ & (SEQ - 1); _Pragma("unroll") for (int i = 0; i < 8; ++i) { const int idx = tid + 512 * i; const int r = idx >> 6, c8 = idx & 63; \
            pre[i] = (u32x4){0u, 0u, 0u, 0u}; if (idx < 62 * 64 && t0_ - 30 + r >= 0) pre[i] = *(const u32x4*)(XG + (size_t)(tok0_ - 30 + r) * 512 + 8 * c8); } } while (0)
        int ct = bid;
        if (ct < MTOK / 32) CONV_LOAD(ct);
        for (; ct < MTOK / 32; ct += gridDim.x) {
            const int tok0 = ct * 32;
#pragma unroll
            for (int i = 0; i < 8; ++i) { const int idx = tid + 512 * i; if (idx < 62 * 64) *(LAS u32x4*)(xs + (idx >> 6) * 1024 + 16 * (idx & 63)) = pre[i]; }
            __syncthreads();
            if (ct + (int)gridDim.x < MTOK / 32) CONV_LOAD(ct + gridDim.x);
            {
                f32x2 x[46];
#pragma unroll
                for (int r = 0; r < 46; ++r) { const unsigned w2 = *(const LAS unsigned*)(xs + (16 * hbq + r) * 1024 + 4 * cp); x[r] = (f32x2){bf_lo(w2), bf_hi(w2)}; }
#pragma unroll
                for (int t = 0; t < 16; ++t) { f32x2 y = bias;
#pragma unroll
                    for (int k = 0; k < 31; ++k) y += wk[k] * x[t + k];
                    *(LAS f32x2*)(ys + (16 * hbq + t) * 512 + 2 * cp) = y; }
            }
            __syncthreads();
#pragma unroll
            for (int i = 0; i < 4; ++i) { const int t = wid * 4 + i;
                f32x4 x0 = *(const LAS f32x4*)(ys + t * 512 + 8 * lane), x1 = *(const LAS f32x4*)(ys + t * 512 + 8 * lane + 4);
                float s = (x0[0] + x0[1]) + (x0[2] + x0[3]) + (x1[0] + x1[1]) + (x1[2] + x1[3]);
                s = wave_sum(s); const float mu = s * (1.0f / 512.0f);
                x0 -= mu; x1 -= mu;
                float q = x0[0] * x0[0] + x0[1] * x0[1] + x0[2] * x0[2] + x0[3] * x0[3] + x1[0] * x1[0] + x1[1] * x1[1] + x1[2] * x1[2] + x1[3] * x1[3];
                q = wave_sum(q); const float rs = __builtin_amdgcn_rsqf(q * (1.0f / 512.0f) + EPS);
                x0 = x0 * rs * g0 + b0; x1 = x1 * rs * g1 + b1;
                x0 = x0 * sigmoid4(x0); x1 = x1 * sigmoid4(x1);
                *(u32x4*)(XC + (size_t)(tok0 + t) * 512 + 8 * lane) = pack8(x0, x1); }
            __syncthreads();
        }
#undef CONV_LOAD
    }

    {
        const int g = wid & 3, oct = g * 16 + (lane & 15), sub = (wid >> 2) * 4 + (lane >> 4);
        switch (g) {
        case 0: pool_run<2>(ZP, X3, oct, sub, bid); break;
        case 1: pool_run<4>(ZP, X3, oct, sub, bid); break;
        case 2: pool_run<8>(ZP, X3, oct, sub, bid); break;
        default: pool_run<16>(ZP, X3, oct, sub, bid); break;
        }
    }
}

#define XB_TMO      128
#define XB_XCNT(j)  (256  + 64 * (j))
#define XB_XSUB(j)  (1280 + 64 * (j))
#define XB_XGEN(j)  (2304 + 64 * (j))
#define XB_TOP      3328
#define XB_TOPGEN   3392
#define XCD_BAR_WORDS 3456
#define XB_SPIN_CAP (1u << 18)
__device__ __forceinline__ unsigned xb_ld(unsigned* p)              { return __hip_atomic_load(p, __ATOMIC_RELAXED, __HIP_MEMORY_SCOPE_AGENT); }
__device__ __forceinline__ unsigned xb_add(unsigned* p, unsigned v) { return __hip_atomic_fetch_add(p, v, __ATOMIC_RELAXED, __HIP_MEMORY_SCOPE_AGENT); }
__device__ __forceinline__ unsigned xb_xcc_id() { return (unsigned)__builtin_amdgcn_s_getreg((3 << 11) | 20) & 0xFu; }
#define XB_SPIN(cond, bar) do { unsigned _sp = 0; while (cond) { __builtin_amdgcn_s_sleep(1); \
    if ((++_sp & 255u) == 0u) { if (xb_ld(&(bar)[XB_TMO])) break; if (_sp > XB_SPIN_CAP) { atomicAdd(&(bar)[XB_TMO], 1u); break; } } } } while (0)
struct XcdBarrier { unsigned* bar; unsigned x; volatile LAS unsigned* st; };
__device__ __forceinline__ XcdBarrier xcd_barrier_post(unsigned* bar, volatile LAS unsigned* st) {
    XcdBarrier b; b.bar = bar; b.x = xb_xcc_id(); b.st = st;
    if (threadIdx.x == 0) (void)xb_add(&bar[XB_XCNT(b.x)], 1u);
    return b;
}
__device__ __forceinline__ void xcd_barrier_complete(unsigned* bar, unsigned x, unsigned& nloc, unsigned& nx) {
    const unsigned G = gridDim.x * gridDim.y * gridDim.z;
    unsigned sum, cnt, mine, sp = 0u;
    for (;;) {
        sum = 0u; cnt = 0u; mine = 0u;
#pragma unroll
        for (unsigned j = 0; j < 16; ++j) { const unsigned c = xb_ld(&bar[XB_XCNT(j)]); sum += c; cnt += (c > 0u) ? 1u : 0u; mine = (j == x) ? c : mine; }
        if (sum == G) break;
        __builtin_amdgcn_s_sleep(1);
        if ((++sp & 255u) == 0u) { if (xb_ld(&bar[XB_TMO])) break; if (sp > XB_SPIN_CAP) { atomicAdd(&bar[XB_TMO], 1u); break; } }
    }
    nloc = mine > 0u ? mine : 1u; nx = cnt > 0u ? cnt : 1u;
}
__device__ __forceinline__ void xcd_barrier(const XcdBarrier& b) {
    asm volatile("s_waitcnt vmcnt(0)" ::: "memory");
    __syncthreads();
    if (threadIdx.x == 0) {
        unsigned* bar = b.bar;
        __builtin_amdgcn_s_waitcnt(0);
        unsigned nloc = b.st[0], nx = b.st[1];
        if (nloc == 0u) { xcd_barrier_complete(bar, b.x, nloc, nx); b.st[0] = nloc; b.st[1] = nx; }
        const unsigned old = xb_add(&bar[XB_XSUB(b.x)], 1u);
        const unsigned gen = old / nloc;
        if (old + 1u == (gen + 1u) * nloc) {
            __builtin_amdgcn_fence(__ATOMIC_RELEASE, "agent");
            asm volatile("s_waitcnt vmcnt(0)" ::: "memory");
            const unsigned og = xb_add(&bar[XB_TOP], 1u);
            const unsigned tg = og / nx;
            if (og + 1u == (tg + 1u) * nx) xb_add(&bar[XB_TOPGEN], 1u);
            else XB_SPIN(xb_ld(&bar[XB_TOPGEN]) == tg, bar);
            __builtin_amdgcn_fence(__ATOMIC_ACQUIRE, "agent");
            xb_add(&bar[XB_XGEN(b.x)], 1u);
            asm volatile("s_waitcnt vmcnt(0)" ::: "memory");
        } else {
            XB_SPIN(xb_ld(&bar[XB_XGEN(b.x)]) == gen, bar);
            __builtin_amdgcn_fence(__ATOMIC_ACQUIRE, "agent");
            asm volatile("s_waitcnt vmcnt(0)" ::: "memory");
        }
    }
    __syncthreads();
}

__device__ __forceinline__ void run_phase(const Params& P, int ph, LAS unsigned char* lds, const float rmul = 1.0f, const bool row_only = false) {
    GAS unsigned char* wsg = P.ws; GAS float* outg = P.out; int tid = threadIdx.x, bid = blockIdx.x;
    asm volatile("" : "+s"(wsg), "+s"(outg), "+v"(tid), "+s"(bid));
    unsigned char* ws = (unsigned char*)wsg; float* out = (float*)outg;
    unsigned char* big = ws + WS_BIG;
    bf16_t* HN = (bf16_t*)(ws + WS_HN); bf16_t* F = (bf16_t*)(ws + WS_F); bf16_t* F2 = (bf16_t*)(ws + WS_F2);
    const int G = gridDim.x, c = bid;
    constexpr unsigned PM = PHASE_MASK;
    if (ph == 0) {
        if (!(PM & (1u << 13))) return;
        prep_weights(P, ws, 0, lds, tid, bid);
        row_phase<true>(PIN(0), out, nullptr, 0.f, nullptr, PIN(2), HN, true, tid, bid);
        return;
    }
    const int l = (ph - 1) / 13, sub = (ph - 1) % 13;
    pg8::Order S;
    switch (sub) {
    case 0: case 8: if (PM & 1u) {
        pg8::Gemm g{HN, (const bf16_t*)(ws + (sub == 0 ? WS_WGU1 : WS_WGU2)), MTOK, NGU, DM}; S.init(MTOK, NGU, G, c, 1);
        pg8::EpiGLU E{(bf16_t*)(big + BIG_ACT)};
        pg8::gemm_phase(lds, g, S, E, tid);
        if (sub == 8) {
            pg8::Gemm g2{(const bf16_t*)(big + BIG_PB), (const bf16_t*)(ws + WS_WPP), MTOK, DM, PLE}; S.init(MTOK, DM, G, c, 1);
            pg8::EpiStore E2{(bf16_t*)(big + BIG_E)};
            pg8::gemm_phase(lds, g2, S, E2, tid);
        }
    } break;
    case 1: case 9: if (PM & 2u) {
        pg8::Gemm g{(const bf16_t*)(big + BIG_ACT), (const bf16_t*)(ws + (sub == 1 ? WS_WD1 : WS_WD2)), MTOK, DM, DFF}; S.init(MTOK, DM, G, c, 1);
        pg8::EpiStore E{F};
        pg8::gemm_phase(lds, g, S, E, tid);
    } break;
    case 2: if (PM & 4u) row_phase2<false>(l == 0 ? PIN(0) : (const float*)out, out, F, 0.5f, PIN(6) + l * DM, nullptr, 0.f, nullptr, PIN(7) + l * DM, HN, true, tid, bid); break;
    case 3: if (PM & 8u) {
        pg8::Gemm g{HN, (const bf16_t*)(ws + WS_WIN), MTOK, NIN, DM}; S.init(MTOK, NIN, G, c, 1);
        pg8::EpiIn E{(bf16_t*)(big + BIG_ZP), (bf16_t*)(big + BIG_U), (bf16_t*)(big + BIG_V), (bf16_t*)(big + BIG_XG), (bf16_t*)(big + BIG_GATES)};
        pg8::gemm_phase(lds, g, S, E, tid);
    } break;
    case 4: if (PM & 16u) mixer_phase(P, ws, l, lds, tid, bid); break;
    case 5: if (PM & 32u) {
        pg8::Gemm g{(const bf16_t*)(big + BIG_X3), (const bf16_t*)(ws + WS_WBR), MTOK, DM, 512}; S.init(MTOK, DM, G, c, 3);
        pg8::EpiBranch E{(const unsigned char*)(big + BIG_GATES), (bf16_t*)(big + BIG_MERGED)};
        pg8::gemm_phase(lds, g, S, E, tid);
    } break;
    case 6: if (PM & 64u) {
        pg8::Gemm g{(const bf16_t*)(big + BIG_MERGED), (const bf16_t*)(ws + WS_WOUT), MTOK, DM, DM}; S.init(MTOK, DM, G, c, 1);
        pg8::EpiStore E{F2};
        pg8::gemm_phase(lds, g, S, E, tid);
    } break;
    case 7: if (PM & 128u) {
        row_phase2<true>(l == 0 ? PIN(0) : (const float*)out, out, F, 0.5f, PIN(6) + l * DM, F2, 1.0f, PIN(23) + l * DM, PIN(24) + l * DM, HN, true, tid, bid);
        if (!row_only) convert_p(PIN(1) + (size_t)l * MTOK * PLE, (bf16_t*)(big + BIG_PB), tid, bid);
        } break;
    case 10: if (PM & 1024u) row_phase2<false>(out, out, F, 0.5f, PIN(28) + l * DM, nullptr, 0.f, nullptr, PIN(30) + l * DM, HN, true, tid, bid); break;
    case 11: if (PM & 2048u) {
        pg8::Gemm g{HN, (const bf16_t*)(ws + WS_WPG), MTOK, DM, DM}; S.init(MTOK, DM, G, c, 1);
        pg8::EpiPle E{(const bf16_t*)(big + BIG_E), F2};
        pg8::gemm_phase(lds, g, S, E, tid);
    } break;
    case 12: if (PM & 4096u) {
        row_phase2<true>(out, out, F, 0.5f, PIN(28) + l * DM, F2, 1.0f, PIN(32) + l * DM, PIN(2) + (l + 1 < NLAYER ? l + 1 : l) * DM, HN, l + 1 < NLAYER, tid, bid);
        if (l + 1 < NLAYER && !row_only) prep_weights(P, ws, l + 1, lds, tid, bid);
        } break;
    default: break;
    }
}

__global__ void __launch_bounds__(512, 2) mega(Params P) {
    extern __shared__ __attribute__((aligned(16))) unsigned char lds_raw[];
    LAS unsigned char* lds = (LAS unsigned char*)lds_raw;
    cg::grid_group grid = cg::this_grid();
#if !MULTI_LAUNCH
    volatile LAS unsigned* st = (volatile LAS unsigned*)(lds + LDS_BYTES - 16);
    if (threadIdx.x < 2) st[threadIdx.x] = 0u;
    __syncthreads();
    const XcdBarrier bar = xcd_barrier_post((unsigned*)((unsigned char*)P.ws + WS_BAR), st);
#endif
    for (int ph = P.ph_lo; ph < P.ph_hi; ++ph) {
        run_phase(P, ph, lds);
#if PROBE_DUP
        {
            const int sub = ph == 0 ? -1 : (ph - 1) % 13;
            const bool is_gemm = (sub == 0 || sub == 1 || sub == 3 || sub == 5 || sub == 6 || sub == 8 || sub == 9 || sub == 11);
            if (((PROBE_DUP & 1) && is_gemm) || ((PROBE_DUP & 2) && sub == 4)) { __syncthreads(); run_phase(P, ph, lds); }
#if !MULTI_LAUNCH
            if ((PROBE_DUP & 4) && ph > 0) xcd_barrier(bar);
#endif
        }
#endif
#if !MULTI_LAUNCH
        if (ph + 1 < P.ph_hi) { if (P.ph_hi > NPHASE) grid.sync(); else xcd_barrier(bar); }
#endif
    }
}

extern "C" void kernel_launch(void* const* d_in, const int* in_sizes, int n_in, void* d_out, int out_size, void* d_ws, size_t ws_size, hipStream_t stream) {
    static int grid = 0;
    if (grid == 0) {
        if (n_in != 33 || ws_size < WS_END) { fprintf(stderr, "kernel_launch: unexpected n_in %d or ws_size %zu (< %zu)\n", n_in, ws_size, (size_t)WS_END); grid = -1; return; }
        int dev = 0, cus = 0, per_cu = 0;
        hipGetDevice(&dev);
        hipDeviceGetAttribute(&cus, hipDeviceAttributeMultiprocessorCount, dev);
        if (hipFuncSetAttribute((const void*)mega, hipFuncAttributeMaxDynamicSharedMemorySize, LDS_BYTES) != hipSuccess) { fprintf(stderr, "kernel_launch: hipFuncSetAttribute failed\n"); grid = -1; return; }
        hipOccupancyMaxActiveBlocksPerMultiprocessor(&per_cu, (const void*)mega, 512, LDS_BYTES);
        if (per_cu < 1) per_cu = 1;
        (void)hipGetLastError();
        grid = cus * per_cu;
    }
    if (grid < 0) return;
    Params p{};
    for (int i = 0; i < 33; ++i) p.in[i] = (const GAS float*)d_in[i];
    p.out = (GAS float*)d_out; p.ws = (GAS unsigned char*)d_ws;
#if MULTI_LAUNCH
    for (int ph = 0; ph < NPHASE; ++ph) {
        p.ph_lo = ph; p.ph_hi = ph + 1;
        hipLaunchKernelGGL(mega, dim3(grid), dim3(512), LDS_BYTES, stream, p);
    }
#else
    p.ph_lo = 0; p.ph_hi = NPHASE;
    if (hipMemsetAsync((char*)d_ws + WS_BAR, 0, 16384, stream) != hipSuccess) { fprintf(stderr, "kernel_launch: memset of the barrier words failed\n"); return; }
    void* args[] = {&p};
    hipError_t e = hipLaunchCooperativeKernel((const void*)mega, dim3(grid), dim3(512), args, LDS_BYTES, stream);
    if (e != hipSuccess) fprintf(stderr, "cooperative launch failed: %s (grid %d)\n", hipGetErrorString(e), grid);
#endif
}
```
